# Optimizing an MI355X kernel written in HIP

```python
import jax, jax.numpy as jnp
from jax import lax
import numpy as np

D_MODEL = 1024
BATCH = 16
SEQ = 4096
DEPTH = 4
DEC_BATCH = 16
DEC_SEQ = 16
PAST_LEN = 1024

CHUNK = 64
HGRN_BLOCK = CHUNK // 4
A_HEADS = 4
A_DK = 128
A_DV = 128
A_WIDTH = A_HEADS * A_DV
B_WIDTH = D_MODEL // 2
CONV_W = 3
D_FF = 2816
N_IN = 4 * A_WIDTH + 3 * B_WIDTH
EPS = 1e-6

kernel_name = 'hybrid_hgrn2_shortconv_convffn_stream_step'


def rmsnorm(x, g):
    xf = x.astype(jnp.float32)
    y = xf * lax.rsqrt(jnp.mean(xf * xf, axis=-1, keepdims=True) + EPS)
    return (y * g.astype(jnp.float32)).astype(x.dtype)


def causal_dwconv(u, buf, w):
    L = u.shape[1]
    full = jnp.concatenate([buf.astype(u.dtype), u], axis=1)
    y = full[:, 0:L] * w[0]
    for k in range(1, CONV_W):
        y = y + full[:, k:k + L] * w[k]
    return y, full[:, -(CONV_W - 1):]


def hgrn_lower_bounds(lb_logits):
    p = jax.nn.softmax(lb_logits.astype(jnp.float32), axis=0)
    g = jnp.cumsum(p, axis=0)
    return g - g[0:1]


def hgrn_block(S, q, k, v, logf):
    L = q.shape[1]
    b = jnp.cumsum(logf, axis=1)
    o_inter = jnp.einsum('blhk,bhkv->blhv', q * jnp.exp(b), S)
    causal = (jnp.arange(L)[:, None] >= jnp.arange(L)[None, :])[None, :, :, None, None]
    decay = jnp.exp(jnp.where(causal, b[:, :, None] - b[:, None, :], -jnp.inf))
    A = jnp.einsum('btshk,bthk->btsh', decay * k[:, None], q)
    o_intra = jnp.einsum('btsh,bshv->bthv', A, v)
    b_last = b[:, -1]
    kd = k * jnp.exp(b_last[:, None] - b)
    S_new = jnp.exp(b_last)[..., None] * S + jnp.einsum('blhk,blhv->bhkv', kd, v)
    return S_new, o_inter + o_intra


def hgrn_scan(S0, q, k, v, logf):
    B, T = q.shape[:2]
    nb = T // HGRN_BLOCK

    def to_blocks(a):
        return a.reshape(B, nb, HGRN_BLOCK, *a.shape[2:]).swapaxes(0, 1)

    def step(S, blk):
        return hgrn_block(S, *blk)

    S, o = lax.scan(step, S0, (to_blocks(q), to_blocks(k), to_blocks(v), to_blocks(logf)))
    return S, o.swapaxes(0, 1).reshape(B, T, *o.shape[3:])


def token_mixer(h, S0, conv_buf, lb, w_in, a_norm, w_pa, conv_w, w_pb, w_bgate, w_o):
    B, L, _ = h.shape
    a, bw = A_WIDTH, B_WIDTH
    q, f, i, g, bg, cg, xv = jnp.split(h @ w_in, [a, 2 * a, 3 * a, 4 * a, 4 * a + bw, 4 * a + 2 * bw], axis=-1)
    shp = (B, L, A_HEADS, A_DK)
    qa = jax.nn.silu(q.astype(jnp.float32)).reshape(shp)
    z = f.astype(jnp.float32).reshape(shp)
    lbh = lb.reshape(A_HEADS, A_DK)
    logf = jnp.logaddexp(jnp.log(lbh), jnp.log1p(-lbh) + jax.nn.log_sigmoid(z))
    ka = (1.0 - lbh) * jax.nn.sigmoid(-z)
    va = i.astype(jnp.float32).reshape(B, L, A_HEADS, A_DV)
    S0 = S0.astype(jnp.float32)
    if L > CHUNK:
        S, o = hgrn_scan(S0, qa, ka, va, logf)
    else:
        S, o = hgrn_block(S0, qa, ka, va, logf)
    o = rmsnorm(o, a_norm) * jax.nn.silu(g.astype(jnp.float32).reshape(B, L, A_HEADS, A_DV))
    y_a = o.reshape(B, L, A_WIDTH).astype(h.dtype) @ w_pa
    u, new_buf = causal_dwconv(cg * xv, conv_buf, conv_w)
    y_b = (bg * u) @ w_pb
    ga, gb = jnp.split(jax.nn.sigmoid(h @ w_bgate), 2, axis=-1)
    return (ga * y_a + gb * y_b) @ w_o, S, new_buf


def conv_ffn(h, buf, w_up, conv_w, w_down):
    gate, val = jnp.split(h @ w_up, 2, axis=-1)
    gate, new_buf = causal_dwconv(gate, buf, conv_w)
    return (jax.nn.silu(gate) * val) @ w_down, new_buf


def trunk(x, c, S_in, cb_in, fb_in, lbs, params):
    (w_ada, b_ada, g_pre_mix, g_post_mix, g_pre_ffn, g_post_ffn, w_in, a_norm, w_pa,
     conv_w, w_pb, w_bgate, w_o, w_up, ffn_conv_w, w_down) = params
    cs = jax.nn.silu(c)
    new_S, new_cb, new_fb = [], [], []
    for l in range(DEPTH):
        ada = cs @ w_ada[l] + b_ada[l]
        sh1, sc1, gt1, sh2, sc2, gt2 = jnp.split(ada[:, None, :], 6, axis=-1)
        h = rmsnorm(x, g_pre_mix[l]) * (1.0 + sc1) + sh1
        m, S, cb = token_mixer(h, S_in[l], cb_in[l], lbs[l], w_in[l], a_norm[l], w_pa[l],
                               conv_w[l], w_pb[l], w_bgate[l], w_o[l])
        x = x + gt1 * rmsnorm(m, g_post_mix[l])
        h = rmsnorm(x, g_pre_ffn[l]) * (1.0 + sc2) + sh2
        ff, fb = conv_ffn(h, fb_in[l], w_up[l], ffn_conv_w[l], w_down[l])
        x = x + gt2 * rmsnorm(ff, g_post_ffn[l])
        new_S.append(S)
        new_cb.append(cb)
        new_fb.append(fb)
    return x, jnp.stack(new_S).astype(x.dtype), jnp.stack(new_cb), jnp.stack(new_fb)


def setup_inputs(seed: int = 0) -> dict:
    key = jax.random.key(seed)
    ks = jax.random.split(key, 32)
    D = D_MODEL

    def nrm(k, shape, scale):
        return jax.random.normal(k, shape, jnp.float32) * scale

    return {
        'x_prompt': nrm(ks[0], (BATCH, SEQ, D), 1.0),
        'x_sample': nrm(ks[1], (DEC_BATCH, DEC_SEQ, D), 1.0),
        'state_hgrn': nrm(ks[2], (DEPTH, DEC_BATCH, A_HEADS, A_DK, A_DV), 0.5),
        'state_conv': nrm(ks[3], (DEPTH, DEC_BATCH, CONV_W - 1, B_WIDTH), 1.0),
        'state_ffn_conv': nrm(ks[4], (DEPTH, DEC_BATCH, CONV_W - 1, D_FF), 1.0),
        'c_prompt': nrm(ks[5], (BATCH, D), 1.0),
        'c_sample': nrm(ks[6], (DEC_BATCH, D), 1.0),
        'w_ada': nrm(ks[7], (DEPTH, D, 6 * D), 0.5 * D ** -0.5),
        'b_ada': nrm(ks[8], (DEPTH, 6 * D), 0.02),
        'g_pre_mix': 1.0 + nrm(ks[9], (DEPTH, D), 0.05),
        'g_post_mix': 1.0 + nrm(ks[10], (DEPTH, D), 0.05),
        'g_pre_ffn': 1.0 + nrm(ks[11], (DEPTH, D), 0.05),
        'g_post_ffn': 1.0 + nrm(ks[12], (DEPTH, D), 0.05),
        'w_in': nrm(ks[13], (DEPTH, D, N_IN), D ** -0.5),
        'hgrn_lb_logits': nrm(ks[14], (DEPTH, A_WIDTH), 1.0),
        'hgrn_norm': 1.0 + nrm(ks[15], (DEPTH, A_DV), 0.05),
        'w_pa': nrm(ks[16], (DEPTH, A_WIDTH, D), A_WIDTH ** -0.5),
        'conv_w': nrm(ks[17], (DEPTH, CONV_W, B_WIDTH), CONV_W ** -0.5),
        'w_pb': nrm(ks[18], (DEPTH, B_WIDTH, D), B_WIDTH ** -0.5),
        'w_bgate': nrm(ks[19], (DEPTH, D, 2 * D), D ** -0.5),
        'w_o': nrm(ks[20], (DEPTH, D, D), D ** -0.5),
        'w_up': nrm(ks[21], (DEPTH, D, 2 * D_FF), D ** -0.5),
        'ffn_conv_w': nrm(ks[22], (DEPTH, CONV_W, D_FF), CONV_W ** -0.5),
        'w_down': nrm(ks[23], (DEPTH, D_FF, D), D_FF ** -0.5),
    }


def reference(x_prompt, x_sample, state_hgrn, state_conv, state_ffn_conv, c_prompt, c_sample,
              w_ada, b_ada, g_pre_mix, g_post_mix, g_pre_ffn, g_post_ffn, w_in, hgrn_lb_logits,
              hgrn_norm, w_pa, conv_w, w_pb, w_bgate, w_o, w_up, ffn_conv_w, w_down):
    params = (w_ada, b_ada, g_pre_mix, g_post_mix, g_pre_ffn, g_post_ffn, w_in, hgrn_norm, w_pa,
              conv_w, w_pb, w_bgate, w_o, w_up, ffn_conv_w, w_down)
    lbs = hgrn_lower_bounds(hgrn_lb_logits)
    B = x_prompt.shape[0]
    dt = x_prompt.dtype
    S0 = jnp.zeros((DEPTH, B, A_HEADS, A_DK, A_DV), jnp.float32)
    cb0 = jnp.zeros((DEPTH, B, CONV_W - 1, B_WIDTH), dt)
    fb0 = jnp.zeros((DEPTH, B, CONV_W - 1, D_FF), dt)
    y_prompt, s_hgrn_p, s_conv_p, s_ffn_p = trunk(x_prompt, c_prompt, S0, cb0, fb0, lbs, params)
    y_sample, s_hgrn_s, s_conv_s, s_ffn_s = trunk(x_sample, c_sample, state_hgrn, state_conv,
                                                  state_ffn_conv, lbs, params)
    return (y_prompt, y_sample, s_hgrn_p, s_conv_p, s_ffn_p, s_hgrn_s, s_conv_s, s_ffn_s)
```

```cpp
#include <hip/hip_runtime.h>
#include <hip/hip_cooperative_groups.h>
#include <cstdio>
#include <cstdint>
namespace cg = cooperative_groups;

#define LAS __attribute__((address_space(3)))
typedef unsigned short bf16_t;
typedef short bf16x8 __attribute__((ext_vector_type(8)));
typedef short bf16x4 __attribute__((ext_vector_type(4)));
typedef float f32x4 __attribute__((ext_vector_type(4)));
typedef unsigned u32x4 __attribute__((ext_vector_type(4)));
typedef unsigned u32x2 __attribute__((ext_vector_type(2)));

constexpr int D = 1024, SEQ = 4096, NBATCH = 16, DEPTH = 4, DSEQ = 16;
constexpr int AW = 512, BW = 512, DFF = 2816, NIN = 3584, N1 = 5632, NUP = 5632;
constexpr int MP = NBATCH * SEQ;
constexpr int MS = NBATCH * DSEQ;
constexpr int MG0 = 32768, MG1 = 33024, MGMAX = 33024;
constexpr float EPS = 1e-6f;
constexpr size_t O_YP = 0, O_YS = 67108864, O_SHP = 67371008, O_SCP = 71565312, O_SFP = 71630848, O_SHS = 71991296, O_SCS = 76185600, O_SFS = 76251136;
constexpr size_t MiB = 1u << 20;
constexpr size_t WS_ADA = 1 * MiB;
constexpr size_t WS_LB = 5 * MiB;
constexpr size_t WS_W = 8 * MiB;
constexpr size_t W1_OFF = 0, WPA_OFF = (size_t)N1 * D * 2, WPB_OFF = WPA_OFF + (size_t)D * AW * 2, WO_OFF = WPB_OFF + (size_t)D * BW * 2,
                 WUP_OFF = WO_OFF + (size_t)D * D * 2, WDN_OFF = WUP_OFF + (size_t)NUP * D * 2, LAYER_W = WDN_OFF + (size_t)D * DFF * 2;
constexpr size_t WS_H = 136 * MiB;
constexpr size_t WS_AB = 202 * MiB;
constexpr size_t WS_P = 268 * MiB;
constexpr size_t WS_ACT = 624 * MiB;
constexpr size_t WS_DS = 804 * MiB;
constexpr size_t WS_DD = 822 * MiB;
constexpr size_t WS_SS = 824 * MiB;
constexpr size_t WS_DUMMY = 840 * MiB;
constexpr size_t WS_XB = 842 * MiB;
constexpr size_t WS_END = 908 * MiB;
static_assert(WS_W + 4 * LAYER_W <= WS_H && WS_H + (size_t)MGMAX * D * 2 <= WS_AB && WS_AB + (size_t)MGMAX * D * 2 <= WS_P && WS_P + (size_t)MGMAX * N1 * 2 <= WS_ACT && WS_ACT + (size_t)MGMAX * DFF * 2 <= WS_DS && WS_DS + (size_t)32 * 8 * 16384 * 4 <= WS_DD, "ws map");
constexpr int LDS_BYTES = 147456;

__device__ __forceinline__ unsigned cvt_pk_bf16(float lo, float hi) { unsigned r; asm volatile("v_cvt_pk_bf16_f32 %0, %1, %2" : "=v"(r) : "v"(lo), "v"(hi)); return r; }
__device__ __forceinline__ float bf2f(unsigned short b) { return __uint_as_float(((unsigned)b) << 16); }
__device__ __forceinline__ float bflo(unsigned w) { return __uint_as_float(w << 16); }
__device__ __forceinline__ float bfhi(unsigned w) { return __uint_as_float(w & 0xffff0000u); }
__device__ __forceinline__ float fsigmoid(float x) { return __builtin_amdgcn_rcpf(1.f + __expf(-x)); }
__device__ __forceinline__ float wave_sum(float v) {
#pragma unroll
    for (int o = 1; o < 64; o <<= 1) v += __shfl_xor(v, o);
    return v;
}

namespace pg8 {
constexpr int BM = 256, BK = 64, HALF = 128, HTB = HALF * BK * 2, STAGE_BYTES = 8 * HTB, NXCD = 8, WGM = 8;
__host__ __device__ __forceinline__ int lds_byte(int r, int c) { const int st = (r >> 4) * 2 + (c >> 5), rr = r & 15, cc = c & 31, ob = rr * 64 + cc * 2; return st * 1024 + (ob ^ (((ob >> 9) & 1) << 5)); }
__host__ __device__ __forceinline__ void stage_rc(int b, int& R, int& C) { const int st = b / 1024, sb = b % 1024, swz = sb ^ (((sb >> 9) & 1) << 5); R = (st >> 1) * 16 + swz / 64; C = (st & 1) * 32 + (swz % 64) / 2; }
__host__ __device__ __forceinline__ int perm32(int rho) { const int n = rho >> 4, i = rho & 15; return 8 * (i >> 2) + 4 * n + (i & 3); }
struct Unit { int pm, pn; };
struct Gemm { const bf16_t* A; const bf16_t* Bt; int lda, ldb, K; int mstride = 256; int arow0 = 0; };
struct StaticOrder {
    int nM, nN, nwg, G, c;
    __device__ void init(int nM_, int nN_, int G_, int c_) { nM = nM_; nN = nN_; nwg = nM * nN; G = G_; c = c_; }
    __device__ bool next(int i, Unit& u) const {
        const long L = (long)i * G + c; if (L >= nwg) return false;
        int wgid = (int)L; { const int q = nwg / NXCD, r = nwg % NXCD, xcd = wgid % NXCD, off = wgid / NXCD; wgid = (xcd < r ? xcd * (q + 1) : r * (q + 1) + (xcd - r) * q) + off; }
        const int nig = WGM * nN, gid = wgid / nig, fm = gid * WGM, gsz = (nM - fm) < WGM ? (nM - fm) : WGM;
        u.pm = fm + ((wgid % nig) % gsz); u.pn = (wgid % nig) / gsz; return true;
    }
};
template <class Epi>
__device__ __forceinline__ void gemm_phase(LAS unsigned char* lds, const Gemm g, const StaticOrder& S, const Epi& E) {
    int tid = threadIdx.x; asm volatile("" : "+v"(tid));
    const int wid = __builtin_amdgcn_readfirstlane(tid >> 6), lane = tid & 63, wr = wid >> 2, wc = wid & 3, fr = lane & 15, fq = lane >> 4;
    const int K = g.K, nt = K / BK;
    unsigned voffA[2], voffB[2];
#pragma unroll
    for (int i = 0; i < 2; ++i) { int R, C; stage_rc(tid * 16 + i * 8192, R, C); const int Rb = (R & ~31) + perm32(R & 31);
        voffA[i] = (unsigned)(R * g.lda + C) * 2u; voffB[i] = (unsigned)(Rb * g.ldb + C) * 2u; }
    const size_t kstep = (size_t)(BK * 2);
    const size_t hstepA = (size_t)HALF * g.lda * 2, hstepB = (size_t)HALF * g.ldb * 2;
    const long tstepA = (long)g.mstride * g.lda * 2, tstepB = (long)(2 * hstepB); const long abase0 = (long)g.arow0 * g.lda * 2;
    const unsigned ldsw = (unsigned)wid * 1024u;
    const int aoff = lds_byte(wr * 64 + fr, fq * 8), boff = lds_byte(wc * 32 + fr, fq * 8);
#define PG8_SA(b, h) (((b) * 2 + (h)) * HTB)
#define PG8_SB(b, h) ((4 + (b) * 2 + (h)) * HTB)
#define PG8_STAGE(bufoff, gbase, voff) do { _Pragma("unroll") for (int _i = 0; _i < 2; ++_i) \
        __builtin_amdgcn_global_load_lds((const unsigned*)((const char*)(gbase) + (voff)[_i]), (LAS unsigned*)(lds + (bufoff) + ldsw + _i * 8192), 16, 0, 0); } while (0)
#define PG8_LDA(dst, b, h) do { _Pragma("unroll") for (int m = 0; m < 4; ++m) _Pragma("unroll") for (int k = 0; k < 2; ++k) dst[m][k] = *(const LAS bf16x8*)(lds + PG8_SA(b, h) + aoff + m * 2048 + k * 1024); } while (0)
#define PG8_LDB(dst, b, h) do { _Pragma("unroll") for (int n = 0; n < 2; ++n) _Pragma("unroll") for (int k = 0; k < 2; ++k) dst[n][k] = *(const LAS bf16x8*)(lds + PG8_SB(b, h) + boff + n * 2048 + k * 1024); } while (0)
#define PG8_MMA(ai, bj, At, Bt) do { __builtin_amdgcn_s_setprio(1); _Pragma("unroll") for (int m = 0; m < 4; ++m) _Pragma("unroll") for (int n = 0; n < 2; ++n) _Pragma("unroll") for (int k = 0; k < 2; ++k) \
        acc[ai][bj][m][n] = __builtin_amdgcn_mfma_f32_16x16x32_bf16(Bt[n][k], At[m][k], acc[ai][bj][m][n], 0, 0, 0); __builtin_amdgcn_s_setprio(0); } while (0)
#define PG8_WAIT_V(n) asm volatile("s_waitcnt vmcnt(" #n ")" ::: "memory")
#define PG8_WAIT_L(n) asm volatile("s_waitcnt lgkmcnt(" #n ")" ::: "memory")
#define PG8_BAR __builtin_amdgcn_s_barrier()
#define PG8_SCHED __builtin_amdgcn_sched_barrier(0)
    Unit cur, nxt; int ui = 0;
    if (!S.next(0, cur)) return;
    f32x4 acc[2][2][4][2];
#pragma unroll
    for (int a = 0; a < 2; ++a)
#pragma unroll
        for (int b = 0; b < 2; ++b)
#pragma unroll
            for (int m = 0; m < 4; ++m)
#pragma unroll
                for (int n = 0; n < 2; ++n) acc[a][b][m][n] = (f32x4){0.f, 0.f, 0.f, 0.f};
    bf16x8 At[4][2], B0[2][2], B1[2][2];
    const char* cA = (const char*)g.A + abase0 + (long)cur.pm * tstepA; const char* cB = (const char*)g.Bt + (long)cur.pn * tstepB;
    PG8_STAGE(PG8_SB(0, 0), cB, voffB); PG8_STAGE(PG8_SB(0, 1), cB + hstepB, voffB); PG8_STAGE(PG8_SA(0, 0), cA, voffA); PG8_STAGE(PG8_SA(0, 1), cA + hstepA, voffA);
    if (wr == 1) PG8_BAR;
    PG8_WAIT_V(2); PG8_BAR;
    PG8_STAGE(PG8_SB(1, 0), cB + kstep, voffB); PG8_STAGE(PG8_SA(1, 0), cA + kstep, voffA); PG8_STAGE(PG8_SB(1, 1), cB + hstepB + kstep, voffB);
    PG8_WAIT_V(6); PG8_BAR;
    for (;;) {
        const bool has_next = S.next(ui + 1, nxt);
        const char* nA = has_next ? (const char*)g.A + abase0 + (long)nxt.pm * tstepA : cA; const char* nB = has_next ? (const char*)g.Bt + (long)nxt.pn * tstepB : cB;
        for (int t = 0; t < nt; t += 2) {
            const bool last = (t == nt - 2);
            const char* a1 = cA + (size_t)(t + 1) * kstep;
            const char* a2 = last ? nA : cA + (size_t)(t + 2) * kstep; const char* b2 = last ? nB : cB + (size_t)(t + 2) * kstep;
            const char* a3 = a2 + kstep; const char* b3 = b2 + kstep;
            PG8_LDB(B0, 0, 0); PG8_LDB(B1, 0, 1); PG8_SCHED; PG8_LDA(At, 0, 0); PG8_STAGE(PG8_SA(1, 1), a1 + hstepA, voffA);
            PG8_WAIT_V(8); PG8_WAIT_L(0); PG8_BAR; PG8_MMA(0, 0, At, B0); PG8_MMA(0, 1, At, B1); PG8_BAR; PG8_SCHED;
            PG8_LDA(At, 0, 1); PG8_STAGE(PG8_SB(0, 0), b2, voffB); PG8_STAGE(PG8_SB(0, 1), b2 + hstepB, voffB); PG8_STAGE(PG8_SA(0, 0), a2, voffA);
            PG8_WAIT_V(8); PG8_WAIT_L(0); PG8_BAR; PG8_MMA(1, 0, At, B0); PG8_MMA(1, 1, At, B1); PG8_BAR; PG8_SCHED;
            PG8_LDB(B0, 1, 0); PG8_LDB(B1, 1, 1); PG8_SCHED; PG8_LDA(At, 1, 0); PG8_STAGE(PG8_SA(0, 1), a2 + hstepA, voffA);
            PG8_WAIT_V(8); PG8_WAIT_L(0); PG8_BAR; PG8_MMA(0, 0, At, B0); PG8_MMA(0, 1, At, B1); PG8_BAR; PG8_SCHED;
            PG8_LDA(At, 1, 1); PG8_STAGE(PG8_SB(1, 0), b3, voffB); PG8_STAGE(PG8_SB(1, 1), b3 + hstepB, voffB); PG8_STAGE(PG8_SA(1, 0), a3, voffA);
            PG8_WAIT_V(8); PG8_WAIT_L(0); PG8_BAR; PG8_MMA(1, 0, At, B0); PG8_MMA(1, 1, At, B1); PG8_BAR; PG8_SCHED;
        }
        if (wr == 0) PG8_BAR;
        E(acc, cur, wr, wc, fr, fq);
        if (!has_next) break;
#pragma unroll
        for (int a = 0; a < 2; ++a)
#pragma unroll
            for (int b = 0; b < 2; ++b)
#pragma unroll
                for (int m = 0; m < 4; ++m)
#pragma unroll
                    for (int n = 0; n < 2; ++n) acc[a][b][m][n] = (f32x4){0.f, 0.f, 0.f, 0.f};
        cur = nxt; cA = nA; cB = nB; ++ui;
        if (wr == 1) PG8_BAR;
    }
    PG8_WAIT_V(0);
    PG8_BAR;
#undef PG8_SA
#undef PG8_SB
#undef PG8_STAGE
#undef PG8_LDA
#undef PG8_LDB
#undef PG8_MMA
#undef PG8_WAIT_V
#undef PG8_WAIT_L
#undef PG8_BAR
#undef PG8_SCHED
}

struct EpiStore {
    bf16_t* O; int ldc; int kind;
    __device__ __forceinline__ void operator()(const f32x4 (&acc)[2][2][4][2], const Unit& u, int wr, int wc, int fr, int fq) const {
        const int row0 = u.pm * BM + wr * 64 + fr, col0 = u.pn * BM + wc * 32 + 8 * fq;
        int act = 0;
        if (kind == 1) { const int pn = u.pn; act = (pn < 2 || pn == 6 || pn == 7) ? 1 : (pn >= 14 ? 2 : 0); }
#pragma unroll
        for (int ai = 0; ai < 2; ++ai)
#pragma unroll
            for (int m = 0; m < 4; ++m) { bf16_t* rowp = O + (size_t)(row0 + ai * HALF + m * 16) * ldc + col0;
#pragma unroll
                for (int bj = 0; bj < 2; ++bj) { f32x4 v0 = acc[ai][bj][m][0], v1 = acc[ai][bj][m][1];
                    if (act) {
#pragma unroll
                        for (int e = 0; e < 4; ++e) { const float s0 = fsigmoid(v0[e]), s1 = fsigmoid(v1[e]); v0[e] = (act == 1) ? v0[e] * s0 : s0; v1[e] = (act == 1) ? v1[e] * s1 : s1; }
                    }
                    u32x4 o; o.x = cvt_pk_bf16(v0[0], v0[1]); o.y = cvt_pk_bf16(v0[2], v0[3]); o.z = cvt_pk_bf16(v1[0], v1[1]); o.w = cvt_pk_bf16(v1[2], v1[3]);
                    *(u32x4*)(rowp + bj * HALF) = o; } }
    }
};
struct EpiGate {
    bf16_t* O; const bf16_t* Gt; int accum;
    __device__ __forceinline__ void operator()(const f32x4 (&acc)[2][2][4][2], const Unit& u, int wr, int wc, int fr, int fq) const {
        const int row0 = u.pm * BM + wr * 64 + fr, col0 = u.pn * BM + wc * 32 + 8 * fq;
#pragma unroll
        for (int ai = 0; ai < 2; ++ai) {
            u32x4 gv[4][2], ov[4][2];
#pragma unroll
            for (int m = 0; m < 4; ++m)
#pragma unroll
                for (int bj = 0; bj < 2; ++bj) { const size_t r = (size_t)(row0 + ai * HALF + m * 16); const int c = col0 + bj * HALF;
                    gv[m][bj] = *(const u32x4*)(Gt + r * N1 + c); ov[m][bj] = accum ? *(const u32x4*)(O + r * D + c) : (u32x4){0u, 0u, 0u, 0u}; }
#pragma unroll
            for (int m = 0; m < 4; ++m)
#pragma unroll
                for (int bj = 0; bj < 2; ++bj) { const size_t r = (size_t)(row0 + ai * HALF + m * 16); const int c = col0 + bj * HALF;
                    const u32x4 g = gv[m][bj], o0 = ov[m][bj];
                    f32x4 v0 = acc[ai][bj][m][0], v1 = acc[ai][bj][m][1];
                    v0[0] = v0[0] * bflo(g.x) + bflo(o0.x); v0[1] = v0[1] * bfhi(g.x) + bfhi(o0.x); v0[2] = v0[2] * bflo(g.y) + bflo(o0.y); v0[3] = v0[3] * bfhi(g.y) + bfhi(o0.y);
                    v1[0] = v1[0] * bflo(g.z) + bflo(o0.z); v1[1] = v1[1] * bfhi(g.z) + bfhi(o0.z); v1[2] = v1[2] * bflo(g.w) + bflo(o0.w); v1[3] = v1[3] * bfhi(g.w) + bfhi(o0.w);
                    u32x4 o; o.x = cvt_pk_bf16(v0[0], v0[1]); o.y = cvt_pk_bf16(v0[2], v0[3]); o.z = cvt_pk_bf16(v1[0], v1[1]); o.w = cvt_pk_bf16(v1[2], v1[3]);
                    *(u32x4*)(O + r * D + c) = o; }
        }
    }
};

struct EpiFfn {
    bf16_t* ACT; const float* cw; const float* stin; float* stout_p; float* stout_s; int R0, MG, l; LAS float* halo;
    __device__ __forceinline__ void operator()(const f32x4 (&acc)[2][2][4][2], const Unit& u, int wr, int wc, int fr, int fq) const {
        const int colg = u.pn * 128 + wc * 32 + 8 * fq;
        if (fr >= 14) {
#pragma unroll
            for (int ai = 0; ai < 2; ++ai) { LAS float* hp = halo + ((ai * 2 + wr) * 2 + (fr - 14)) * 128 + wc * 32 + 8 * fq; *(LAS f32x4*)hp = acc[ai][0][3][0]; *(LAS f32x4*)(hp + 4) = acc[ai][0][3][1]; }
        }
        asm volatile("s_waitcnt lgkmcnt(0)" ::: "memory"); __builtin_amdgcn_s_barrier(); asm volatile("" ::: "memory");
        const int lane = fq * 16 + fr, src1 = (lane & 48) | ((fr + 15) & 15), src2 = (lane & 48) | ((fr + 14) & 15);
#pragma unroll
        for (int n = 0; n < 2; ++n) {
            const int col = colg + 4 * n;
            const f32x4 w0 = *(const f32x4*)(cw + col), w1 = *(const f32x4*)(cw + DFF + col), w2 = *(const f32x4*)(cw + 2 * DFF + col);
#pragma unroll
            for (int ai = 0; ai < 2; ++ai)
#pragma unroll
                for (int m = 0; m < 4; ++m) {
                    const int rho = 128 * ai + 64 * wr + 16 * m + fr, Rl = u.pm * 254 - 2 + rho, R = R0 + Rl;
                    const bool valid = (rho >= 2) && (Rl < MG);
                    int t, Lq, sq; const bool smp = (R >= MP);
                    if (!smp) { t = R & (SEQ - 1); Lq = SEQ; sq = R >> 12; } else { const int Rs = R - MP; t = Rs & 15; Lq = DSEQ; sq = Rs >> 4; }
                    const f32x4 g4 = acc[ai][0][m][n];
                    const f32x4 gm = acc[ai][0][m > 0 ? m - 1 : 0][n];
                    f32x4 p1, p2;
#pragma unroll
                    for (int e = 0; e < 4; ++e) { const float s1 = (m > 0 && fr == 15) ? gm[e] : g4[e], s2 = (m > 0 && fr >= 14) ? gm[e] : g4[e]; p1[e] = __shfl(s1, src1); p2[e] = __shfl(s2, src2); }
                    if (m == 0) { const int pb = ai * 2 + wr - 1;
                        if (pb >= 0 && fr < 2) { const LAS float* h0 = halo + (pb * 2) * 128 + wc * 32 + 8 * fq + 4 * n;
                            const f32x4 x0 = *(const LAS f32x4*)h0, y0 = *(const LAS f32x4*)(h0 + 128);
                            if (fr == 0) { p1 = y0; p2 = x0; } else { p2 = y0; } } }
                    if (valid && t < 2) {
                        f32x4 s0v = (f32x4){0.f, 0.f, 0.f, 0.f}, s1v = s0v;
                        if (smp) { const float* sp = stin + (size_t)((l * 16 + sq) * 2) * DFF + col; s0v = *(const f32x4*)sp; s1v = *(const f32x4*)(sp + DFF); }
                        if (t == 0) { p1 = s1v; p2 = s0v; } else { p2 = s1v; }
                    }
                    if (valid) {
                        const f32x4 v4 = acc[ai][1][m][n];
                        float o[4];
#pragma unroll
                        for (int e = 0; e < 4; ++e) { const float y = w0[e] * p2[e] + w1[e] * p1[e] + w2[e] * g4[e]; o[e] = y * fsigmoid(y) * v4[e]; }
                        u32x2 ov; ov.x = cvt_pk_bf16(o[0], o[1]); ov.y = cvt_pk_bf16(o[2], o[3]);
                        *(u32x2*)(ACT + (size_t)Rl * DFF + col) = ov;
                        if (t >= Lq - 2) *(f32x4*)((smp ? stout_s : stout_p) + (size_t)((l * 16 + sq) * 2 + (t - (Lq - 2))) * DFF + col) = g4;
                    }
                }
        }
    }
};
}

struct Args { const float* in[24]; float* out; unsigned char* ws; };

__device__ __forceinline__ void transpose_item(const float* W, int K, int N, bf16_t* WT, int row_off, LAS float* scr, int item, int lane) {
    const int nblk = N / 32, kb = item / nblk, nb = item % nblk, k0 = 64 * kb, n0 = 32 * nb;
#pragma unroll 8
    for (int i = 0; i < 32; ++i) { const int kk = 2 * i + (lane >> 5); scr[kk * 33 + (lane & 31)] = W[(size_t)(k0 + kk) * N + n0 + (lane & 31)]; }
    asm volatile("s_waitcnt lgkmcnt(0)" ::: "memory");
    const int c = lane & 7;
#pragma unroll
    for (int j = 0; j < 4; ++j) { const int n = (lane >> 3) + 8 * j; const LAS float* s = scr + (8 * c) * 33 + n;
        u32x4 o; o.x = cvt_pk_bf16(s[0 * 33], s[1 * 33]); o.y = cvt_pk_bf16(s[2 * 33], s[3 * 33]); o.z = cvt_pk_bf16(s[4 * 33], s[5 * 33]); o.w = cvt_pk_bf16(s[6 * 33], s[7 * 33]);
        *(u32x4*)(WT + (size_t)(row_off + n0 + n) * K + k0 + 8 * c) = o; }
    asm volatile("s_waitcnt lgkmcnt(0)" ::: "memory");
}

__device__ __forceinline__ void row_pass(const bf16_t* mrow  , const float* xin, const bf16_t* xin_b, float* xout, bf16_t* xout_b, const float* gpost, const float* gate,
                                         bf16_t* hrow  , const float* gpre, const float* sc, const float* sh, int lane) {
    float xv[2][8];
    if (xin_b) {
#pragma unroll
        for (int j = 0; j < 2; ++j) { const u32x4 w = *(const u32x4*)(xin_b + 512 * j + 8 * lane);
            xv[j][0] = bflo(w.x); xv[j][1] = bfhi(w.x); xv[j][2] = bflo(w.y); xv[j][3] = bfhi(w.y); xv[j][4] = bflo(w.z); xv[j][5] = bfhi(w.z); xv[j][6] = bflo(w.w); xv[j][7] = bfhi(w.w); }
    } else {
#pragma unroll
        for (int j = 0; j < 2; ++j) { const int c0 = 512 * j + 8 * lane; const f32x4 a = *(const f32x4*)(xin + c0), b = *(const f32x4*)(xin + c0 + 4);
            xv[j][0] = a[0]; xv[j][1] = a[1]; xv[j][2] = a[2]; xv[j][3] = a[3]; xv[j][4] = b[0]; xv[j][5] = b[1]; xv[j][6] = b[2]; xv[j][7] = b[3]; }
    }
    if (mrow) {
        float mv[2][8]; float ss = 0.f;
#pragma unroll
        for (int j = 0; j < 2; ++j) { const u32x4 w = *(const u32x4*)(mrow + 512 * j + 8 * lane);
            mv[j][0] = bflo(w.x); mv[j][1] = bfhi(w.x); mv[j][2] = bflo(w.y); mv[j][3] = bfhi(w.y); mv[j][4] = bflo(w.z); mv[j][5] = bfhi(w.z); mv[j][6] = bflo(w.w); mv[j][7] = bfhi(w.w);
#pragma unroll
            for (int e = 0; e < 8; ++e) ss += mv[j][e] * mv[j][e]; }
        const float rstd = rsqrtf(wave_sum(ss) * (1.f / D) + EPS);
#pragma unroll
        for (int j = 0; j < 2; ++j) { const int c0 = 512 * j + 8 * lane;
            const f32x4 g0 = *(const f32x4*)(gpost + c0), g1 = *(const f32x4*)(gpost + c0 + 4), t0 = *(const f32x4*)(gate + c0), t1 = *(const f32x4*)(gate + c0 + 4);
#pragma unroll
            for (int e = 0; e < 4; ++e) { xv[j][e] += t0[e] * (mv[j][e] * rstd * g0[e]); xv[j][4 + e] += t1[e] * (mv[j][4 + e] * rstd * g1[e]); }
            if (xout_b) { u32x4 o; o.x = cvt_pk_bf16(xv[j][0], xv[j][1]); o.y = cvt_pk_bf16(xv[j][2], xv[j][3]); o.z = cvt_pk_bf16(xv[j][4], xv[j][5]); o.w = cvt_pk_bf16(xv[j][6], xv[j][7]); *(u32x4*)(xout_b + c0) = o;
            } else { *(f32x4*)(xout + c0) = (f32x4){xv[j][0], xv[j][1], xv[j][2], xv[j][3]}; *(f32x4*)(xout + c0 + 4) = (f32x4){xv[j][4], xv[j][5], xv[j][6], xv[j][7]}; } }
    }
    if (hrow) {
        float ss = 0.f;
#pragma unroll
        for (int j = 0; j < 2; ++j)
#pragma unroll
            for (int e = 0; e < 8; ++e) ss += xv[j][e] * xv[j][e];
        const float rstd = rsqrtf(wave_sum(ss) * (1.f / D) + EPS);
#pragma unroll
        for (int j = 0; j < 2; ++j) { const int c0 = 512 * j + 8 * lane; float hv[8];
            const f32x4 g0 = *(const f32x4*)(gpre + c0), g1 = *(const f32x4*)(gpre + c0 + 4), s0 = *(const f32x4*)(sc + c0), s1 = *(const f32x4*)(sc + c0 + 4), h0 = *(const f32x4*)(sh + c0), h1 = *(const f32x4*)(sh + c0 + 4);
#pragma unroll
            for (int e = 0; e < 4; ++e) { hv[e] = xv[j][e] * rstd * g0[e] * (1.f + s0[e]) + h0[e]; hv[4 + e] = xv[j][4 + e] * rstd * g1[e] * (1.f + s1[e]) + h1[e]; }
            u32x4 o; o.x = cvt_pk_bf16(hv[0], hv[1]); o.y = cvt_pk_bf16(hv[2], hv[3]); o.z = cvt_pk_bf16(hv[4], hv[5]); o.w = cvt_pk_bf16(hv[6], hv[7]);
            *(u32x4*)(hrow + c0) = o; }
    }
}
__device__ __forceinline__ int row_batch(int R) { return R < MP ? (R >> 12) : 16 + ((R - MP) >> 4); }

template <int CTRL> __device__ __forceinline__ float dpp_rot(float v) { return __builtin_bit_cast(float, __builtin_amdgcn_update_dpp(0, __builtin_bit_cast(int, v), CTRL, 0xf, 0xf, true)); }
__device__ __forceinline__ float sum16(float x) { x += dpp_rot<0x128>(x); x += dpp_rot<0x124>(x); x += dpp_rot<0x122>(x); x += dpp_rot<0x121>(x); return x; }
template <bool FULL>
__device__ __forceinline__ void hgrn_item(LAS unsigned char* lds, const bf16_t* P, bf16_t* AB, int L, int hd, const float* lbv, const float* anorm, const float* S0, const float* Dd, int ns, float* Sout, float* Dout) {
    int tid = threadIdx.x; asm volatile("" : "+v"(tid));
    const int w = tid >> 6, lane = tid & 63, q4 = lane >> 4, c16 = lane & 15;
    const int k = tid & 127, tq = tid >> 7;
    LAS bf16_t* Qt = (LAS bf16_t*)lds;
    LAS bf16_t* Kt = Qt + 16 * 136;
    LAS bf16_t* KhT = Kt + 16 * 136;
    LAS bf16_t* VsT = KhT + 128 * 20;
    LAS float* dvec = (LAS float*)(VsT + 128 * 20);
    LAS float* qsum = dvec + 128;
    LAS float* ssq = qsum + 512;
    const float lb = lbv[k], oml = 1.f - lb;
    const float an = FULL ? anorm[16 * w + c16] : 0.f;
    f32x4 accS[8];
#pragma unroll
    for (int mt = 0; mt < 8; ++mt) accS[mt] = (f32x4){0.f, 0.f, 0.f, 0.f};
    for (int c = 0; c < ns; ++c) { const float* sc = S0 + (size_t)c * 16384 + 16 * w + c16;
#pragma unroll
        for (int mt = 0; mt < 8; ++mt) { f32x4 d4 = (f32x4){0.f, 0.f, 0.f, 0.f}; if (Dd) d4 = *(const f32x4*)(Dd + c * 128 + 16 * mt + 4 * q4);
#pragma unroll
            for (int j = 0; j < 4; ++j) accS[mt][j] = accS[mt][j] * d4[j] + sc[(size_t)(16 * mt + 4 * q4 + j) * 128]; } }
    const bf16_t* pq = P + 128 * hd + k + (size_t)(4 * tq) * N1;
    const bf16_t* pz = pq + 512;
    const int vt = (tid >> 4) & 15, vc = tid & 15;
    const bf16_t* pv = P + 1024 + 128 * hd + 8 * vc + (size_t)vt * N1;
    const bf16_t* pg = P + 1536 + 128 * hd + 16 * w + c16 + (size_t)(4 * q4) * N1;
    bf16_t* po = AB + 128 * hd + 16 * w + c16 + (size_t)(4 * q4) * D;
    const int nsteps = L >> 4;
    float btot = 0.f;
    unsigned short zr[4], qr[4], grn[4]; u32x4 vr = (u32x4){0u, 0u, 0u, 0u};
#pragma unroll
    for (int i = 0; i < 4; ++i) { zr[i] = pz[(size_t)i * N1]; qr[i] = pq[(size_t)i * N1]; grn[i] = pg[(size_t)i * N1]; }
    if (tid < 256) vr = *(const u32x4*)pv;
    for (int n = 0; n < nsteps; ++n) {
        unsigned short zc[4], qc[4], gr[4]; const u32x4 vcur = vr;
#pragma unroll
        for (int i = 0; i < 4; ++i) { zc[i] = zr[i]; qc[i] = qr[i]; gr[i] = grn[i]; }
        const size_t roff = (size_t)(16 * n) * N1;
        {
            const size_t nro = (size_t)(16 * (n + 1 < nsteps ? n + 1 : n)) * N1;
#pragma unroll
            for (int i = 0; i < 4; ++i) { zr[i] = pz[nro + (size_t)i * N1]; qr[i] = pq[nro + (size_t)i * N1]; grn[i] = pg[nro + (size_t)i * N1]; }
            if (tid < 256) vr = *(const u32x4*)(pv + nro);
        }
        float cs[4], kk[4], qv[4];
        {
            float run = 0.f;
#pragma unroll
            for (int i = 0; i < 4; ++i) { float z = bf2f(zc[i]); z = fminf(fmaxf(z, -30.f), 30.f); const float e = __expf(-z), sg = __builtin_amdgcn_rcpf(1.f + e), sn = e * sg;
                const float f = lb + oml * sg; run += __logf(f); cs[i] = run; kk[i] = oml * sn; qv[i] = bf2f(qc[i]); }
            qsum[tq * 128 + k] = run;
        }
        __syncthreads();
        {
            float pre = 0.f, tot = 0.f;
#pragma unroll
            for (int j = 0; j < 4; ++j) { const float v = qsum[j * 128 + k]; tot += v; pre += (j < tq) ? v : 0.f; }
            btot += tot;
            float kh[4];
#pragma unroll
            for (int i = 0; i < 4; ++i) { const float b = pre + cs[i]; const float qt = qv[i] * __expf(b), kt = kk[i] * __expf(fminf(-b, 80.f)); kh[i] = kk[i] * __expf(tot - b);
                Qt[(4 * tq + i) * 136 + k] = (bf16_t)(cvt_pk_bf16(qt, 0.f) & 0xffffu); Kt[(4 * tq + i) * 136 + k] = (bf16_t)(cvt_pk_bf16(kt, 0.f) & 0xffffu); }
            u32x2 kp; kp.x = cvt_pk_bf16(kh[0], kh[1]); kp.y = cvt_pk_bf16(kh[2], kh[3]);
            *(LAS u32x2*)(KhT + k * 20 + 4 * tq) = kp;
            if (tq == 0) dvec[k] = __expf(tot);
            if (tid < 256) {
                VsT[(8 * vc + 0) * 20 + vt] = (bf16_t)(vcur.x & 0xffffu); VsT[(8 * vc + 1) * 20 + vt] = (bf16_t)(vcur.x >> 16);
                VsT[(8 * vc + 2) * 20 + vt] = (bf16_t)(vcur.y & 0xffffu); VsT[(8 * vc + 3) * 20 + vt] = (bf16_t)(vcur.y >> 16);
                VsT[(8 * vc + 4) * 20 + vt] = (bf16_t)(vcur.z & 0xffffu); VsT[(8 * vc + 5) * 20 + vt] = (bf16_t)(vcur.z >> 16);
                VsT[(8 * vc + 6) * 20 + vt] = (bf16_t)(vcur.w & 0xffffu); VsT[(8 * vc + 7) * 20 + vt] = (bf16_t)(vcur.w >> 16);
            }
        }
        __syncthreads();
        f32x4 acco = (f32x4){0.f, 0.f, 0.f, 0.f};
        {
            const u32x2 vv = *(const LAS u32x2*)(VsT + (16 * w + c16) * 20 + 4 * q4);
            const bf16x4 vf = __builtin_bit_cast(bf16x4, vv);
            if (FULL) {
            bf16x8 qf[4], kf[4];
#pragma unroll
            for (int kq = 0; kq < 4; ++kq) {
                const u32x2 a0 = *(const LAS u32x2*)(Qt + c16 * 136 + 32 * kq + 4 * q4), a1 = *(const LAS u32x2*)(Qt + c16 * 136 + 32 * kq + 16 + 4 * q4);
                const u32x2 b0 = *(const LAS u32x2*)(Kt + c16 * 136 + 32 * kq + 4 * q4), b1 = *(const LAS u32x2*)(Kt + c16 * 136 + 32 * kq + 16 + 4 * q4);
                u32x4 qa = (u32x4){a0.x, a0.y, a1.x, a1.y}, ka = (u32x4){b0.x, b0.y, b1.x, b1.y};
                qf[kq] = __builtin_bit_cast(bf16x8, qa); kf[kq] = __builtin_bit_cast(bf16x8, ka);
            }
            f32x4 accA = (f32x4){0.f, 0.f, 0.f, 0.f};
#pragma unroll
            for (int kq = 0; kq < 4; ++kq) accA = __builtin_amdgcn_mfma_f32_16x16x32_bf16(kf[kq], qf[kq], accA, 0, 0, 0);
#pragma unroll
            for (int j = 0; j < 4; ++j) accA[j] = (c16 >= 4 * q4 + j) ? accA[j] : 0.f;
            u32x2 pa; pa.x = cvt_pk_bf16(accA[0], accA[1]); pa.y = cvt_pk_bf16(accA[2], accA[3]);
            const bf16x4 pA = __builtin_bit_cast(bf16x4, pa);
            acco = __builtin_amdgcn_mfma_f32_16x16x16bf16_1k(pA, vf, (f32x4){0.f, 0.f, 0.f, 0.f}, 0, 0, 0);
#pragma unroll
            for (int kq = 0; kq < 4; ++kq) {
                u32x4 sp; sp.x = cvt_pk_bf16(accS[2 * kq][0], accS[2 * kq][1]); sp.y = cvt_pk_bf16(accS[2 * kq][2], accS[2 * kq][3]);
                sp.z = cvt_pk_bf16(accS[2 * kq + 1][0], accS[2 * kq + 1][1]); sp.w = cvt_pk_bf16(accS[2 * kq + 1][2], accS[2 * kq + 1][3]);
                acco = __builtin_amdgcn_mfma_f32_16x16x32_bf16(qf[kq], __builtin_bit_cast(bf16x8, sp), acco, 0, 0, 0);
            }
            }
#pragma unroll
            for (int mt = 0; mt < 8; ++mt) {
                const u32x2 kh2 = *(const LAS u32x2*)(KhT + (16 * mt + c16) * 20 + 4 * q4);
                const f32x4 d4 = *(const LAS f32x4*)(dvec + 16 * mt + 4 * q4);
                accS[mt] = accS[mt] * d4;
                accS[mt] = __builtin_amdgcn_mfma_f32_16x16x16bf16_1k(__builtin_bit_cast(bf16x4, kh2), vf, accS[mt], 0, 0, 0);
            }
            if (FULL) {
            const float s0 = sum16(acco[0] * acco[0]), s1 = sum16(acco[1] * acco[1]), s2 = sum16(acco[2] * acco[2]), s3 = sum16(acco[3] * acco[3]);
            if (c16 == 0) { *(LAS f32x4*)(ssq + w * 16 + 4 * q4) = (f32x4){s0, s1, s2, s3}; }
            }
        }
        __syncthreads();
        if (FULL) {
            f32x4 tot = (f32x4){0.f, 0.f, 0.f, 0.f};
#pragma unroll
            for (int ww = 0; ww < 8; ++ww) tot += *(const LAS f32x4*)(ssq + ww * 16 + 4 * q4);
#pragma unroll
            for (int j = 0; j < 4; ++j) { const float rstd = rsqrtf(tot[j] * (1.f / 128.f) + EPS); const float o = acco[j] * rstd * an * bf2f(gr[j]);
                po[(size_t)(16 * n + j) * D] = (bf16_t)(cvt_pk_bf16(o, 0.f) & 0xffffu); }
        }
    }
    if (Sout) {
#pragma unroll
        for (int mt = 0; mt < 8; ++mt)
#pragma unroll
            for (int j = 0; j < 4; ++j) Sout[(size_t)(16 * mt + 4 * q4 + j) * 128 + 16 * w + c16] = accS[mt][j];
    }
    if (Dout && tid < 128) Dout[tid] = __expf(btot);
    __syncthreads();
}

__device__ __forceinline__ void unpack8(const u32x4 w, float (&v)[8]) { v[0] = bflo(w.x); v[1] = bfhi(w.x); v[2] = bflo(w.y); v[3] = bfhi(w.y); v[4] = bflo(w.z); v[5] = bfhi(w.z); v[6] = bflo(w.w); v[7] = bfhi(w.w); }
__device__ __forceinline__ u32x4 pack8(const float (&v)[8]) { u32x4 o; o.x = cvt_pk_bf16(v[0], v[1]); o.y = cvt_pk_bf16(v[2], v[3]); o.z = cvt_pk_bf16(v[4], v[5]); o.w = cvt_pk_bf16(v[6], v[7]); return o; }
__device__ __forceinline__ void load8f(const float* p, float (&v)[8]) { const f32x4 a = *(const f32x4*)p, b = *(const f32x4*)(p + 4); v[0] = a[0]; v[1] = a[1]; v[2] = a[2]; v[3] = a[3]; v[4] = b[0]; v[5] = b[1]; v[6] = b[2]; v[7] = b[3]; }
__device__ __forceinline__ void store8f(float* p, const float (&v)[8]) { *(f32x4*)p = (f32x4){v[0], v[1], v[2], v[3]}; *(f32x4*)(p + 4) = (f32x4){v[4], v[5], v[6], v[7]}; }

__device__ __forceinline__ void shortconv_phase(const Args& a, int l, int R0, int MG, const bf16_t* P, bf16_t* AB, unsigned* ctr, volatile LAS unsigned* bcast) {
    const float* cw = a.in[17] + (size_t)l * 3 * BW;
    int tidc = threadIdx.x; asm volatile("" : "+v"(tidc));
    const int nconv = (MG / 8) * 64;
    for (;;) {
        __syncthreads();
        if (tidc == 0) *bcast = __hip_atomic_fetch_add(ctr, 512u, __ATOMIC_RELAXED, __HIP_MEMORY_SCOPE_AGENT);
        __syncthreads();
        const int it = (int)*bcast + tidc;
        if (it - tidc >= nconv) break;
        if (it >= nconv) continue;
        const int rb = it >> 6, ch = (it & 63) * 8, r0 = rb * 8, R = R0 + r0;
        int t0, Lq; const float* st_in = nullptr; float* st_out;
        if (R < MP) { t0 = R & (SEQ - 1); Lq = SEQ; st_out = a.out + O_SCP + (size_t)((l * 16 + (R >> 12)) * 2) * BW; }
        else { const int Rs = R - MP; t0 = Rs & 15; Lq = DSEQ; const int sq = Rs >> 4; st_in = a.in[3] + (size_t)((l * 16 + sq) * 2) * BW; st_out = a.out + O_SCS + (size_t)((l * 16 + sq) * 2) * BW; }
        float w0[8], w1[8], w2[8], p2[8], p1[8];
        load8f(cw + ch, w0); load8f(cw + BW + ch, w1); load8f(cw + 2 * BW + ch, w2);
        if (t0 == 0) {
            if (st_in) { load8f(st_in + ch, p2); load8f(st_in + BW + ch, p1); }
            else {
#pragma unroll
                for (int e = 0; e < 8; ++e) { p2[e] = 0.f; p1[e] = 0.f; } }
        } else {
            float c8[8], v8[8];
            unpack8(*(const u32x4*)(P + (size_t)(r0 - 2) * N1 + 2560 + ch), c8); unpack8(*(const u32x4*)(P + (size_t)(r0 - 2) * N1 + 3072 + ch), v8);
#pragma unroll
            for (int e = 0; e < 8; ++e) p2[e] = c8[e] * v8[e];
            unpack8(*(const u32x4*)(P + (size_t)(r0 - 1) * N1 + 2560 + ch), c8); unpack8(*(const u32x4*)(P + (size_t)(r0 - 1) * N1 + 3072 + ch), v8);
#pragma unroll
            for (int e = 0; e < 8; ++e) p1[e] = c8[e] * v8[e];
        }
#pragma unroll 2
        for (int i = 0; i < 8; ++i) {
            const bf16_t* pr = P + (size_t)(r0 + i) * N1;
            float b8[8], c8[8], v8[8], o8[8];
            unpack8(*(const u32x4*)(pr + 2048 + ch), b8); unpack8(*(const u32x4*)(pr + 2560 + ch), c8); unpack8(*(const u32x4*)(pr + 3072 + ch), v8);
#pragma unroll
            for (int e = 0; e < 8; ++e) { const float cv = c8[e] * v8[e]; o8[e] = b8[e] * (w0[e] * p2[e] + w1[e] * p1[e] + w2[e] * cv); p2[e] = p1[e]; p1[e] = cv; }
            *(u32x4*)(AB + (size_t)(r0 + i) * D + 512 + ch) = pack8(o8);
        }
        if (t0 + 8 == Lq) { store8f(st_out + ch, p2); store8f(st_out + BW + ch, p1); }
    }
}
#define XB_TMO      128
#define XB_XCNT(j)  (256  + 64 * (j))
#define XB_XSUB(j)  (1280 + 64 * (j))
#define XB_XGEN(j)  (2304 + 64 * (j))
#define XB_TOP      3328
#define XB_TOPGEN   3392
#define XCD_BAR_WORDS 3456
#define XB_SPIN_CAP (1u << 22)
__device__ __forceinline__ unsigned xb_ld(unsigned* p)              { return __hip_atomic_load(p, __ATOMIC_RELAXED, __HIP_MEMORY_SCOPE_AGENT); }
__device__ __forceinline__ unsigned xb_add(unsigned* p, unsigned v) { return __hip_atomic_fetch_add(p, v, __ATOMIC_RELAXED, __HIP_MEMORY_SCOPE_AGENT); }
__device__ __forceinline__ unsigned xb_xcc_id() { return (unsigned)__builtin_amdgcn_s_getreg((3 << 11) | 20) & 0xFu; }
#define XB_SPIN(cond, bar) do { unsigned _sp = 0; while (cond) { __builtin_amdgcn_s_sleep(1); \
    if ((++_sp & 255u) == 0u) { if (xb_ld(&(bar)[XB_TMO])) break; if (_sp > XB_SPIN_CAP) { atomicAdd(&(bar)[XB_TMO], 1u); break; } } } } while (0)
struct XcdBarrier { unsigned* bar; unsigned x; volatile LAS unsigned* st; };
__device__ __forceinline__ XcdBarrier xcd_barrier_post(unsigned* bar, volatile LAS unsigned* st) {
    XcdBarrier b; b.bar = bar; b.x = xb_xcc_id(); b.st = st;
    if (threadIdx.x == 0) (void)xb_add(&bar[XB_XCNT(b.x)], 1u);
    return b;
}
__device__ __forceinline__ void xcd_barrier_complete(unsigned* bar, unsigned x, unsigned& nloc, unsigned& nx) {
    const unsigned G = gridDim.x * gridDim.y * gridDim.z;
    unsigned sum, cnt, mine, sp = 0u;
    for (;;) {
        sum = 0u; cnt = 0u; mine = 0u;
#pragma unroll
        for (unsigned j = 0; j < 16; ++j) { const unsigned c = xb_ld(&bar[XB_XCNT(j)]); sum += c; cnt += (c > 0u) ? 1u : 0u; mine = (j == x) ? c : mine; }
        if (sum == G) break;
        __builtin_amdgcn_s_sleep(1);
        if ((++sp & 255u) == 0u) { if (xb_ld(&bar[XB_TMO])) break; if (sp > XB_SPIN_CAP) { atomicAdd(&bar[XB_TMO], 1u); break; } }
    }
    nloc = mine > 0u ? mine : 1u; nx = cnt > 0u ? cnt : 1u;
}
__device__ __forceinline__ void xcd_barrier(const XcdBarrier& b) {
    asm volatile("s_waitcnt vmcnt(0) lgkmcnt(0)" ::: "memory");
    __syncthreads();
    if (threadIdx.x == 0) {
        unsigned* bar = b.bar;
        __builtin_amdgcn_s_waitcnt(0);
        unsigned nloc = b.st[0], nx = b.st[1];
        if (nloc == 0u) { xcd_barrier_complete(bar, b.x, nloc, nx); b.st[0] = nloc; b.st[1] = nx; }
        const unsigned old = xb_add(&bar[XB_XSUB(b.x)], 1u);
        const unsigned gen = old / nloc;
        if (old + 1u == (gen + 1u) * nloc) {
            __builtin_amdgcn_fence(__ATOMIC_RELEASE, "agent");
            asm volatile("s_waitcnt vmcnt(0)" ::: "memory");
            const unsigned og = xb_add(&bar[XB_TOP], 1u);
            const unsigned tg = og / nx;
            if (og + 1u == (tg + 1u) * nx) xb_add(&bar[XB_TOPGEN], 1u);
            else XB_SPIN(xb_ld(&bar[XB_TOPGEN]) == tg, bar);
            __builtin_amdgcn_fence(__ATOMIC_ACQUIRE, "agent");
            xb_add(&bar[XB_XGEN(b.x)], 1u);
            asm volatile("s_waitcnt vmcnt(0)" ::: "memory");
        } else {
            XB_SPIN(xb_ld(&bar[XB_XGEN(b.x)]) == gen, bar);
            __builtin_amdgcn_fence(__ATOMIC_ACQUIRE, "agent");
            asm volatile("s_waitcnt vmcnt(0)" ::: "memory");
        }
    }
    __syncthreads();
}

#define GSYNC_CG() do { asm volatile("s_waitcnt vmcnt(0) lgkmcnt(0)" ::: "memory"); grid.sync(); } while (0)
#define GSYNC() xcd_barrier(xbar)
__global__ void __launch_bounds__(512, 2) fwd_megakernel(Args a) {
    extern __shared__ __attribute__((aligned(16))) unsigned char lds_raw[];
    LAS unsigned char* lds = (LAS unsigned char*)lds_raw;
    cg::grid_group grid = cg::this_grid();
    const int tid = threadIdx.x, lane = tid & 63, wave = __builtin_amdgcn_readfirstlane(tid >> 6);
    const int G = gridDim.x, wg = blockIdx.x;
    unsigned char* ws = a.ws;
    volatile LAS unsigned* MISC = (volatile LAS unsigned*)(lds + 131072 + 320);
    if (tid < 32) MISC[tid] = 0u;
    __syncthreads();
    const XcdBarrier xbar = xcd_barrier_post((unsigned*)ws + 4096, MISC + 8);
    float* ADA = (float*)(ws + WS_ADA);
    float* LB = (float*)(ws + WS_LB);
    bf16_t* Hb = (bf16_t*)(ws + WS_H);
    bf16_t* ABb = (bf16_t*)(ws + WS_AB);
    bf16_t* Pb = (bf16_t*)(ws + WS_P);
    bf16_t* ACTb = (bf16_t*)(ws + WS_ACT);
    bf16_t* XBb = (bf16_t*)(ws + WS_XB);

    if (wg < 192) {
        LAS float* csT = (LAS float*)lds;
        for (int i = tid; i < 32 * 1024; i += 512) { const int b = i >> 10, kx = i & 1023; const float c = (b < 16) ? a.in[5][(size_t)b * D + kx] : a.in[6][(size_t)(b - 16) * D + kx]; csT[kx * 32 + b] = c * fsigmoid(c); }
        __syncthreads();
        const int cc = tid & 127, kq = tid >> 7;
        const int col = wg * 128 + cc;
        const int l = col / 6144, n = col - l * 6144;
        const float* wp = a.in[7] + (size_t)l * D * 6144 + n;
        float acc[32];
#pragma unroll
        for (int b = 0; b < 32; ++b) acc[b] = 0.f;
#pragma unroll 4
        for (int kx = 256 * kq; kx < 256 * kq + 256; ++kx) { const float wv = wp[(size_t)kx * 6144];
#pragma unroll
            for (int b4 = 0; b4 < 8; ++b4) { const f32x4 c4 = *(const LAS f32x4*)(csT + kx * 32 + 4 * b4); acc[4 * b4] += c4[0] * wv; acc[4 * b4 + 1] += c4[1] * wv; acc[4 * b4 + 2] += c4[2] * wv; acc[4 * b4 + 3] += c4[3] * wv; } }
        __syncthreads();
        LAS float* red = (LAS float*)lds;
#pragma unroll
        for (int b = 0; b < 32; ++b) red[(kq * 32 + b) * 128 + cc] = acc[b];
        __syncthreads();
#pragma unroll
        for (int i = 0; i < 8; ++i) { const int o = tid + 512 * i, b = o >> 7, c2 = o & 127; const int col2 = wg * 128 + c2, n2 = col2 - l * 6144;
            const float v = red[(0 * 32 + b) * 128 + c2] + red[(1 * 32 + b) * 128 + c2] + red[(2 * 32 + b) * 128 + c2] + red[(3 * 32 + b) * 128 + c2];
            ADA[((size_t)l * 32 + b) * 6144 + n2] = v + a.in[8][(size_t)l * 6144 + n2]; }
        __syncthreads();
    }
    if (wg == 192) {
        const float x0 = a.in[14][tid], x1 = a.in[14][512 + tid], x2 = a.in[14][1024 + tid], x3 = a.in[14][1536 + tid];
        const float mx = fmaxf(fmaxf(x0, x1), fmaxf(x2, x3));
        const float e0 = __expf(x0 - mx), e1 = __expf(x1 - mx), e2 = __expf(x2 - mx), e3 = __expf(x3 - mx), inv = 1.f / (e0 + e1 + e2 + e3);
        LB[tid] = 0.f; LB[512 + tid] = e1 * inv; LB[1024 + tid] = (e1 + e2) * inv; LB[1536 + tid] = (e1 + e2 + e3) * inv;
    }
    {
        LAS float* scr = (LAS float*)(lds + wave * 16384);
        const int gw = wg * 8 + wave, NGW = G * 8;
        constexpr int I_IN = 16 * (NIN / 32), I_BG = 16 * (2048 / 32), I_PA = 8 * 32, I_PB = 8 * 32, I_O = 16 * 32, I_UP = 16 * (NUP / 32), I_DN = (DFF / 64) * 32;
        constexpr int I_LAYER = I_IN + I_BG + I_PA + I_PB + I_O + I_UP + I_DN;
        for (int it = gw; it < 4 * I_LAYER; it += NGW) {
            const int l = it / I_LAYER; int r = it - l * I_LAYER;
            bf16_t* wl = (bf16_t*)(ws + WS_W + (size_t)l * LAYER_W);
            if (r < I_IN) { transpose_item(a.in[13] + (size_t)l * D * NIN, D, NIN, wl + W1_OFF / 2, 0, scr, r, lane); continue; } r -= I_IN;
            if (r < I_BG) { transpose_item(a.in[19] + (size_t)l * D * 2048, D, 2048, wl + W1_OFF / 2, NIN, scr, r, lane); continue; } r -= I_BG;
            if (r < I_PA) { transpose_item(a.in[16] + (size_t)l * AW * D, AW, D, wl + WPA_OFF / 2, 0, scr, r, lane); continue; } r -= I_PA;
            if (r < I_PB) { transpose_item(a.in[18] + (size_t)l * BW * D, BW, D, wl + WPB_OFF / 2, 0, scr, r, lane); continue; } r -= I_PB;
            if (r < I_O) { transpose_item(a.in[20] + (size_t)l * D * D, D, D, wl + WO_OFF / 2, 0, scr, r, lane); continue; } r -= I_O;
            if (r < I_UP) { const int n0 = 32 * (r % (NUP / 32));
                const int jj = n0 < DFF ? n0 : n0 - DFF, rowb = 256 * (jj >> 7) + (n0 < DFF ? 0 : 128) + (jj & 127);
                transpose_item(a.in[21] + (size_t)l * D * NUP, D, NUP, wl + WUP_OFF / 2, rowb - n0, scr, r, lane); continue; } r -= I_UP;
            transpose_item(a.in[23] + (size_t)l * DFF * D, DFF, D, wl + WDN_OFF / 2, 0, scr, r, lane);
        }
    }
    GSYNC_CG();

    for (int grp = 0; grp < 2; ++grp) {
        const int R0 = grp ? MG0 : 0, MG = grp ? MG1 : MG0, nM = MG / 256;
        int tid = threadIdx.x; asm volatile("" : "+v"(tid));
        const int lane = tid & 63, wave = __builtin_amdgcn_readfirstlane(tid >> 6);
        for (int r = wg * 8 + wave; r < MG; r += G * 8) {
            const int R = R0 + r; const float* xin = (R < MP) ? a.in[0] + (size_t)R * D : a.in[1] + (size_t)(R - MP) * D;
            const float* ad = ADA + (size_t)row_batch(R) * 6144;
            row_pass(nullptr, xin, nullptr, nullptr, nullptr, nullptr, nullptr, Hb + (size_t)r * D, a.in[9], ad + 1024, ad, lane);
        }
        GSYNC();
        for (int l = 0; l < DEPTH; ++l) {
            int tid = threadIdx.x; asm volatile("" : "+v"(tid));
            const int lane = tid & 63, wave = __builtin_amdgcn_readfirstlane(tid >> 6);
            const bf16_t* wl = (const bf16_t*)(ws + WS_W + (size_t)l * LAYER_W);
            { pg8::Gemm g{Hb, wl + W1_OFF / 2, D, D, D}; pg8::StaticOrder S; S.init(nM, N1 / 256, G, wg); pg8::EpiStore E{Pb, N1, 1}; pg8::gemm_phase(lds, g, S, E); }
            GSYNC();
            {
                int tidb = threadIdx.x; asm volatile("" : "+v"(tidb));
                const int chain = wg >> 3, chunk = wg & 7, sqg = chain >> 2, hd = chain & 3;
                const int lrow = sqg * SEQ + chunk * 512;
                float* DS = (float*)(ws + WS_DS) + (size_t)(chain * 8) * 16384;
                float* DD = (float*)(ws + WS_DD) + (size_t)(chain * 8) * 128;
                float* SS = (float*)(ws + WS_SS) + (size_t)wg * 16384;
                const float* lbv = LB + l * 512 + hd * 128;
                const float* anv = a.in[15] + l * 128;
                if (wg < 256 && chunk < 7)
                    hgrn_item<false>(lds, Pb + (size_t)lrow * N1, ABb + (size_t)lrow * D, 512, hd, lbv, anv, nullptr, nullptr, 0, DS + (size_t)chunk * 16384, DD + chunk * 128);
                shortconv_phase(a, l, R0, MG, Pb, ABb, (unsigned*)ws + 1024 + 64 * (grp * 4 + l), MISC + 16);
                GSYNC();
                if (wg < 256)
                    hgrn_item<true>(lds, Pb + (size_t)lrow * N1, ABb + (size_t)lrow * D, 512, hd, lbv, anv, DS, DD, chunk,
                              chunk == 7 ? a.out + O_SHP + (size_t)((l * 16 + 8 * grp + sqg) * 4 + hd) * 16384 : nullptr, nullptr);
                if (grp == 1 && wg < 64) {
                    const int sq = wg >> 2, hs = wg & 3; const int srow = MG0 + sq * DSEQ;
                    hgrn_item<true>(lds, Pb + (size_t)srow * N1, ABb + (size_t)srow * D, DSEQ, hs, LB + l * 512 + hs * 128, anv,
                              a.in[2] + (size_t)((l * 16 + sq) * 4 + hs) * 16384, nullptr, 1, a.out + O_SHS + (size_t)((l * 16 + sq) * 4 + hs) * 16384, nullptr);
                }
            }
            GSYNC();
            { pg8::Gemm g{ABb, wl + WPA_OFF / 2, D, AW, AW}; pg8::StaticOrder S; S.init(nM, D / 256, G, wg); pg8::EpiGate E{Hb, Pb + NIN, 0}; pg8::gemm_phase(lds, g, S, E); }
            { pg8::Gemm g{ABb + AW, wl + WPB_OFF / 2, D, BW, BW}; pg8::StaticOrder S; S.init(nM, D / 256, G, wg); pg8::EpiGate E{Hb, Pb + NIN + D, 1}; pg8::gemm_phase(lds, g, S, E); }
            GSYNC();
            { pg8::Gemm g{Hb, wl + WO_OFF / 2, D, D, D}; pg8::StaticOrder S; S.init(nM, D / 256, G, wg); pg8::EpiStore E{ABb, D, 0}; pg8::gemm_phase(lds, g, S, E); }
            GSYNC();
            for (int r = wg * 8 + wave; r < MG; r += G * 8) {
                const int R = R0 + r; const float* xin = (R < MP) ? a.in[0] + (size_t)R * D : a.in[1] + (size_t)(R - MP) * D;
                const float* ad = ADA + ((size_t)l * 32 + row_batch(R)) * 6144;
                row_pass(ABb + (size_t)r * D, xin, (l == 0) ? nullptr : XBb + (size_t)r * D, nullptr, XBb + (size_t)r * D, a.in[10] + l * D, ad + 2048, Hb + (size_t)r * D, a.in[11] + l * D, ad + 4096, ad + 3072, lane);
            }
            GSYNC();
            { pg8::Gemm g{Hb, wl + WUP_OFF / 2, D, D, D, 254, -2}; pg8::StaticOrder S; S.init((MG + 253) / 254, NUP / 256, G, wg);
              pg8::EpiFfn E{ACTb, a.in[22] + (size_t)l * 3 * DFF, a.in[4], a.out + O_SFP, a.out + O_SFS, R0, MG, l, (LAS float*)(lds + 131072 + 1024)};
              pg8::gemm_phase(lds, g, S, E); }
            GSYNC();
            { pg8::Gemm g{ACTb, wl + WDN_OFF / 2, DFF, DFF, DFF}; pg8::StaticOrder S; S.init(nM, D / 256, G, wg); pg8::EpiStore E{ABb, D, 0}; pg8::gemm_phase(lds, g, S, E); }
            GSYNC();
            for (int r = wg * 8 + wave; r < MG; r += G * 8) {
                const int R = R0 + r;
                const float* ad = ADA + ((size_t)l * 32 + row_batch(R)) * 6144;
                const float* adn = ADA + ((size_t)(l + 1 < DEPTH ? l + 1 : l) * 32 + row_batch(R)) * 6144;
                row_pass(ABb + (size_t)r * D, nullptr, XBb + (size_t)r * D, a.out + (size_t)R * D, (l + 1 < DEPTH) ? XBb + (size_t)r * D : nullptr, a.in[12] + l * D, ad + 5120, (l + 1 < DEPTH) ? Hb + (size_t)r * D : nullptr,
                         a.in[9] + (l + 1 < DEPTH ? l + 1 : l) * D, adn + 1024, adn, lane);
            }
            GSYNC();
        }
    }
}

extern "C" void kernel_launch(void* const* d_in, const int* in_sizes, int n_in, void* d_out, int out_size, void* d_ws, size_t ws_size, hipStream_t stream) {
    static int grid = 0;
    if (grid == 0) {
        if (n_in != 24 || ws_size < WS_END) { fprintf(stderr, "kernel_launch: unexpected n_in %d / ws_size %zu (need %zu)\n", n_in, ws_size, (size_t)WS_END); grid = -1; return; }
        int dev = 0, cus = 0, per_cu = 0;
        hipGetDevice(&dev);
        hipDeviceGetAttribute(&cus, hipDeviceAttributeMultiprocessorCount, dev);
        if (hipFuncSetAttribute((const void*)fwd_megakernel, hipFuncAttributeMaxDynamicSharedMemorySize, LDS_BYTES) != hipSuccess) { fprintf(stderr, "kernel_launch: hipFuncSetAttribute failed\n"); }
        if (hipOccupancyMaxActiveBlocksPerMultiprocessor(&per_cu, (const void*)fwd_megakernel, 512, LDS_BYTES) != hipSuccess || per_cu < 1) { fprintf(stderr, "kernel_launch: occupancy query says %d\n", per_cu); per_cu = 1; }
        (void)hipGetLastError();
        grid = cus;
    }
    if (grid < 0) return;
    if (hipMemsetAsync(d_ws, 0, 65536, stream) != hipSuccess) { fprintf(stderr, "kernel_launch: hipMemsetAsync failed\n"); return; }
    Args a{};
    for (int i = 0; i < 24; ++i) a.in[i] = (const float*)d_in[i];
    a.out = (float*)d_out; a.ws = (unsigned char*)d_ws;
    void* args[] = {&a};
    hipError_t e = hipLaunchCooperativeKernel((const void*)fwd_megakernel, dim3(grid), dim3(512), args, LDS_BYTES, stream);
    if (e != hipSuccess) fprintf(stderr, "kernel_launch: cooperative launch failed: %s (grid %d)\n", hipGetErrorString(e), grid);
}
```

```cpp
#include <hip/hip_runtime.h>
#include <hip/hip_cooperative_groups.h>
#include <cstdio>
#include <cstdint>
namespace cg = cooperative_groups;

#define LAS __attribute__((address_space(3)))
typedef unsigned short bf16_t;
typedef short bf16x8 __attribute__((ext_vector_type(8)));
typedef short bf16x4 __attribute__((ext_vector_type(4)));
typedef float f32x4 __attribute__((ext_vector_type(4)));
typedef unsigned u32x4 __attribute__((ext_vector_type(4)));
typedef unsigned u32x2 __attribute__((ext_vector_type(2)));

constexpr int D = 1024, SEQ = 4096, NBATCH = 16, DEPTH = 4, DSEQ = 16;
constexpr int AW = 512, BW = 512, DFF = 2816, NIN = 3584, N1 = 5632, NUP = 5632;
constexpr int MP = NBATCH * SEQ;
constexpr int MS = NBATCH * DSEQ;
constexpr int MG0 = 32768, MG1 = 33024, MGMAX = 33024;
constexpr float EPS = 1e-6f;
constexpr size_t O_YP = 0, O_YS = 67108864, O_SHP = 67371008, O_SCP = 71565312, O_SFP = 71630848, O_SHS = 71991296, O_SCS = 76185600, O_SFS = 76251136;
constexpr size_t MiB = 1u << 20;
constexpr size_t WS_ADA = 1 * MiB;
constexpr size_t WS_LB = 5 * MiB;
constexpr size_t WS_W = 8 * MiB;
constexpr size_t W1_OFF = 0, WPA_OFF = (size_t)N1 * D * 2, WPB_OFF = WPA_OFF + (size_t)D * AW * 2, WO_OFF = WPB_OFF + (size_t)D * BW * 2,
                 WUP_OFF = WO_OFF + (size_t)D * D * 2, WDN_OFF = WUP_OFF + (size_t)NUP * D * 2, LAYER_W = WDN_OFF + (size_t)D * DFF * 2;
constexpr size_t WS_H = 136 * MiB;
constexpr size_t WS_AB = 202 * MiB;
constexpr size_t WS_P = 268 * MiB;
constexpr size_t WS_ACT = 624 * MiB;
constexpr size_t WS_DS = 804 * MiB;
constexpr size_t WS_DD = 822 * MiB;
constexpr size_t WS_SS = 824 * MiB;
constexpr size_t WS_DUMMY = 840 * MiB;
constexpr size_t WS_XB = 842 * MiB;
constexpr size_t WS_END = 908 * MiB;
static_assert(WS_W + 4 * LAYER_W <= WS_H && WS_H + (size_t)MGMAX * D * 2 <= WS_AB && WS_AB + (size_t)MGMAX * D * 2 <= WS_P && WS_P + (size_t)MGMAX * N1 * 2 <= WS_ACT && WS_ACT + (size_t)MGMAX * DFF * 2 <= WS_DS && WS_DS + (size_t)32 * 8 * 16384 * 4 <= WS_DD, "ws map");
constexpr int LDS_BYTES = 147456;

__device__ __forceinline__ unsigned cvt_pk_bf16(float lo, float hi) { unsigned r; asm volatile("v_cvt_pk_bf16_f32 %0, %1, %2" : "=v"(r) : "v"(lo), "v"(hi)); return r; }
__device__ __forceinline__ float bf2f(unsigned short b) { return __uint_as_float(((unsigned)b) << 16); }
__device__ __forceinline__ float bflo(unsigned w) { return __uint_as_float(w << 16); }
__device__ __forceinline__ float bfhi(unsigned w) { return __uint_as_float(w & 0xffff0000u); }
__device__ __forceinline__ float fsigmoid(float x) { return __builtin_amdgcn_rcpf(1.f + __expf(-x)); }
__device__ __forceinline__ float wave_sum(float v) {
#pragma unroll
    for (int o = 1; o < 64; o <<= 1) v += __shfl_xor(v, o);
    return v;
}

namespace pg8 {
constexpr int BM = 256, BK = 64, HALF = 128, HTB = HALF * BK * 2, STAGE_BYTES = 8 * HTB, NXCD = 8, WGM = 8;
__host__ __device__ __forceinline__ int lds_byte(int r, int c) { const int st = (r >> 4) * 2 + (c >> 5), rr = r & 15, cc = c & 31, ob = rr * 64 + cc * 2; return st * 1024 + (ob ^ (((ob >> 9) & 1) << 5)); }
__host__ __device__ __forceinline__ void stage_rc(int b, int& R, int& C) { const int st = b / 1024, sb = b % 1024, swz = sb ^ (((sb >> 9) & 1) << 5); R = (st >> 1) * 16 + swz / 64; C = (st & 1) * 32 + (swz % 64) / 2; }
__host__ __device__ __forceinline__ int perm32(int rho) { const int n = rho >> 4, i = rho & 15; return 8 * (i >> 2) + 4 * n + (i & 3); }
struct Unit { int pm, pn; };
struct Gemm { const bf16_t* A; const bf16_t* Bt; int lda, ldb, K; int mstride = 256; int arow0 = 0; };
struct StaticOrder {
    int nM, nN, nwg, G, c;
    __device__ void init(int nM_, int nN_, int G_, int c_) { nM = nM_; nN = nN_; nwg = nM * nN; G = G_; c = c_; }
    __device__ bool next(int i, Unit& u) const {
        const long L = (long)i * G + c; if (L >= nwg) return false;
        int wgid = (int)L; { const int q = nwg / NXCD, r = nwg % NXCD, xcd = wgid % NXCD, off = wgid / NXCD; wgid = (xcd < r ? xcd * (q + 1) : r * (q + 1) + (xcd - r) * q) + off; }
        const int nig = WGM * nN, gid = wgid / nig, fm = gid * WGM, gsz = (nM - fm) < WGM ? (nM - fm) : WGM;
        u.pm = fm + ((wgid % nig) % gsz); u.pn = (wgid % nig) / gsz; return true;
    }
};
template <class Epi>
__device__ __forceinline__ void gemm_phase(LAS unsigned char* lds, const Gemm g, const StaticOrder& S, const Epi& E) {
    int tid = threadIdx.x; asm volatile("" : "+v"(tid));
    const int wid = __builtin_amdgcn_readfirstlane(tid >> 6), lane = tid & 63, wr = wid >> 2, wc = wid & 3, fr = lane & 15, fq = lane >> 4;
    const int K = g.K, nt = K / BK;
    unsigned voffA[2], voffB[2];
#pragma unroll
    for (int i = 0; i < 2; ++i) { int R, C; stage_rc(tid * 16 + i * 8192, R, C); const int Rb = (R & ~31) + perm32(R & 31);
        voffA[i] = (unsigned)(R * g.lda + C) * 2u; voffB[i] = (unsigned)(Rb * g.ldb + C) * 2u; }
    const size_t kstep = (size_t)(BK * 2);
    const size_t hstepA = (size_t)HALF * g.lda * 2, hstepB = (size_t)HALF * g.ldb * 2;
    const long tstepA = (long)g.mstride * g.lda * 2, tstepB = (long)(2 * hstepB); const long abase0 = (long)g.arow0 * g.lda * 2;
    const unsigned ldsw = (unsigned)wid * 1024u;
    const int aoff = lds_byte(wr * 64 + fr, fq * 8), boff = lds_byte(wc * 32 + fr, fq * 8);
#define PG8_SA(b, h) (((b) * 2 + (h)) * HTB)
#define PG8_SB(b, h) ((4 + (b) * 2 + (h)) * HTB)
#define PG8_STAGE(bufoff, gbase, voff) do { _Pragma("unroll") for (int _i = 0; _i < 2; ++_i) \
        __builtin_amdgcn_global_load_lds((const unsigned*)((const char*)(gbase) + (voff)[_i]), (LAS unsigned*)(lds + (bufoff) + ldsw + _i * 8192), 16, 0, 0); } while (0)
#define PG8_LDA(dst, b, h) do { _Pragma("unroll") for (int m = 0; m < 4; ++m) _Pragma("unroll") for (int k = 0; k < 2; ++k) dst[m][k] = *(const LAS bf16x8*)(lds + PG8_SA(b, h) + aoff + m * 2048 + k * 1024); } while (0)
#define PG8_LDB(dst, b, h) do { _Pragma("unroll") for (int n = 0; n < 2; ++n) _Pragma("unroll") for (int k = 0; k < 2; ++k) dst[n][k] = *(const LAS bf16x8*)(lds + PG8_SB(b, h) + boff + n * 2048 + k * 1024); } while (0)
#define PG8_MMA(ai, bj, At, Bt) do { __builtin_amdgcn_s_setprio(1); _Pragma("unroll") for (int m = 0; m < 4; ++m) _Pragma("unroll") for (int n = 0; n < 2; ++n) _Pragma("unroll") for (int k = 0; k < 2; ++k) \
        acc[ai][bj][m][n] = __builtin_amdgcn_mfma_f32_16x16x32_bf16(Bt[n][k], At[m][k], acc[ai][bj][m][n], 0, 0, 0); __builtin_amdgcn_s_setprio(0); } while (0)
#define PG8_WAIT_V(n) asm volatile("s_waitcnt vmcnt(" #n ")" ::: "memory")
#define PG8_WAIT_L(n) asm volatile("s_waitcnt lgkmcnt(" #n ")" ::: "memory")
#define PG8_BAR __builtin_amdgcn_s_barrier()
#define PG8_SCHED __builtin_amdgcn_sched_barrier(0)
    Unit cur, nxt; int ui = 0;
    if (!S.next(0, cur)) return;
    f32x4 acc[2][2][4][2];
#pragma unroll
    for (int a = 0; a < 2; ++a)
#pragma unroll
        for (int b = 0; b < 2; ++b)
#pragma unroll
            for (int m = 0; m < 4; ++m)
#pragma unroll
                for (int n = 0; n < 2; ++n) acc[a][b][m][n] = (f32x4){0.f, 0.f, 0.f, 0.f};
    bf16x8 At[4][2], B0[2][2], B1[2][2];
    const char* cA = (const char*)g.A + abase0 + (long)cur.pm * tstepA; const char* cB = (const char*)g.Bt + (long)cur.pn * tstepB;
    PG8_STAGE(PG8_SB(0, 0), cB, voffB); PG8_STAGE(PG8_SB(0, 1), cB + hstepB, voffB); PG8_STAGE(PG8_SA(0, 0), cA, voffA); PG8_STAGE(PG8_SA(0, 1), cA + hstepA, voffA);
    if (wr == 1) PG8_BAR;
    PG8_WAIT_V(2); PG8_BAR;
    PG8_STAGE(PG8_SB(1, 0), cB + kstep, voffB); PG8_STAGE(PG8_SA(1, 0), cA + kstep, voffA); PG8_STAGE(PG8_SB(1, 1), cB + hstepB + kstep, voffB);
    PG8_WAIT_V(6); PG8_BAR;
    for (;;) {
        const bool has_next = S.next(ui + 1, nxt);
        const char* nA = has_next ? (const char*)g.A + abase0 + (long)nxt.pm * tstepA : cA; const char* nB = has_next ? (const char*)g.Bt + (long)nxt.pn * tstepB : cB;
        for (int t = 0; t < nt; t += 2) {
            const bool last = (t == nt - 2);
            const char* a1 = cA + (size_t)(t + 1) * kstep;
            const char* a2 = last ? nA : cA + (size_t)(t + 2) * kstep; const char* b2 = last ? nB : cB + (size_t)(t + 2) * kstep;
            const char* a3 = a2 + kstep; const char* b3 = b2 + kstep;
            PG8_LDB(B0, 0, 0); PG8_LDB(B1, 0, 1); PG8_SCHED; PG8_LDA(At, 0, 0); PG8_STAGE(PG8_SA(1, 1), a1 + hstepA, voffA);
            PG8_WAIT_V(8); PG8_WAIT_L(0); PG8_BAR; PG8_MMA(0, 0, At, B0); PG8_MMA(0, 1, At, B1); PG8_BAR; PG8_SCHED;
            PG8_LDA(At, 0, 1); PG8_STAGE(PG8_SB(0, 0), b2, voffB); PG8_STAGE(PG8_SB(0, 1), b2 + hstepB, voffB); PG8_STAGE(PG8_SA(0, 0), a2, voffA);
            PG8_WAIT_V(8); PG8_WAIT_L(0); PG8_BAR; PG8_MMA(1, 0, At, B0); PG8_MMA(1, 1, At, B1); PG8_BAR; PG8_SCHED;
            PG8_LDB(B0, 1, 0); PG8_LDB(B1, 1, 1); PG8_SCHED; PG8_LDA(At, 1, 0); PG8_STAGE(PG8_SA(0, 1), a2 + hstepA, voffA);
            PG8_WAIT_V(8); PG8_WAIT_L(0); PG8_BAR; PG8_MMA(0, 0, At, B0); PG8_MMA(0, 1, At, B1); PG8_BAR; PG8_SCHED;
            PG8_LDA(At, 1, 1); PG8_STAGE(PG8_SB(1, 0), b3, voffB); PG8_STAGE(PG8_SB(1, 1), b3 + hstepB, voffB); PG8_STAGE(PG8_SA(1, 0), a3, voffA);
            PG8_WAIT_V(8); PG8_WAIT_L(0); PG8_BAR; PG8_MMA(1, 0, At, B0); PG8_MMA(1, 1, At, B1); PG8_BAR; PG8_SCHED;
        }
        if (wr == 0) PG8_BAR;
        E(acc, cur, wr, wc, fr, fq);
        if (!has_next) break;
#pragma unroll
        for (int a = 0; a < 2; ++a)
#pragma unroll
            for (int b = 0; b < 2; ++b)
#pragma unroll
                for (int m = 0; m < 4; ++m)
#pragma unroll
                    for (int n = 0; n < 2; ++n) acc[a][b][m][n] = (f32x4){0.f, 0.f, 0.f, 0.f};
        cur = nxt; cA = nA; cB = nB; ++ui;
        if (wr == 1) PG8_BAR;
    }
    PG8_WAIT_V(0);
    PG8_BAR;
#undef PG8_SA
#undef PG8_SB
#undef PG8_STAGE
#undef PG8_LDA
#undef PG8_LDB
#undef PG8_MMA
#undef PG8_WAIT_V
#undef PG8_WAIT_L
#undef PG8_BAR
#undef PG8_SCHED
}

struct EpiStore {
    bf16_t* O; int ldc; int kind;
    __device__ __forceinline__ void operator()(const f32x4 (&acc)[2][2][4][2], const Unit& u, int wr, int wc, int fr, int fq) const {
        const int row0 = u.pm * BM + wr * 64 + fr, col0 = u.pn * BM + wc * 32 + 8 * fq;
        int act = 0;
        if (kind == 1) { const int pn = u.pn; act = (pn < 2 || pn == 6 || pn == 7) ? 1 : (pn >= 14 ? 2 : 0); }
#pragma unroll
        for (int ai = 0; ai < 2; ++ai)
#pragma unroll
            for (int m = 0; m < 4; ++m) { bf16_t* rowp = O + (size_t)(row0 + ai * HALF + m * 16) * ldc + col0;
#pragma unroll
                for (int bj = 0; bj < 2; ++bj) { f32x4 v0 = acc[ai][bj][m][0], v1 = acc[ai][bj][m][1];
                    if (act) {
#pragma unroll
                        for (int e = 0; e < 4; ++e) { const float s0 = fsigmoid(v0[e]), s1 = fsigmoid(v1[e]); v0[e] = (act == 1) ? v0[e] * s0 : s0; v1[e] = (act == 1) ? v1[e] * s1 : s1; }
                    }
                    u32x4 o; o.x = cvt_pk_bf16(v0[0], v0[1]); o.y = cvt_pk_bf16(v0[2], v0[3]); o.z = cvt_pk_bf16(v1[0], v1[1]); o.w = cvt_pk_bf16(v1[2], v1[3]);
                    *(u32x4*)(rowp + bj * HALF) = o; } }
    }
};
struct EpiGate {
    bf16_t* O; const bf16_t* Gt; int accum;
    __device__ __forceinline__ void operator()(const f32x4 (&acc)[2][2][4][2], const Unit& u, int wr, int wc, int fr, int fq) const {
        const int row0 = u.pm * BM + wr * 64 + fr, col0 = u.pn * BM + wc * 32 + 8 * fq;
#pragma unroll
        for (int ai = 0; ai < 2; ++ai) {
            u32x4 gv[4][2], ov[4][2];
#pragma unroll
            for (int m = 0; m < 4; ++m)
#pragma unroll
                for (int bj = 0; bj < 2; ++bj) { const size_t r = (size_t)(row0 + ai * HALF + m * 16); const int c = col0 + bj * HALF;
                    gv[m][bj] = *(const u32x4*)(Gt + r * N1 + c); ov[m][bj] = accum ? *(const u32x4*)(O + r * D + c) : (u32x4){0u, 0u, 0u, 0u}; }
#pragma unroll
            for (int m = 0; m < 4; ++m)
#pragma unroll
                for (int bj = 0; bj < 2; ++bj) { const size_t r = (size_t)(row0 + ai * HALF + m * 16); const int c = col0 + bj * HALF;
                    const u32x4 g = gv[m][bj], o0 = ov[m][bj];
                    f32x4 v0 = acc[ai][bj][m][0], v1 = acc[ai][bj][m][1];
                    v0[0] = v0[0] * bflo(g.x) + bflo(o0.x); v0[1] = v0[1] * bfhi(g.x) + bfhi(o0.x); v0[2] = v0[2] * bflo(g.y) + bflo(o0.y); v0[3] = v0[3] * bfhi(g.y) + bfhi(o0.y);
                    v1[0] = v1[0] * bflo(g.z) + bflo(o0.z); v1[1] = v1[1] * bfhi(g.z) + bfhi(o0.z); v1[2] = v1[2] * bflo(g.w) + bflo(o0.w); v1[3] = v1[3] * bfhi(g.w) + bfhi(o0.w);
                    u32x4 o; o.x = cvt_pk_bf16(v0[0], v0[1]); o.y = cvt_pk_bf16(v0[2], v0[3]); o.z = cvt_pk_bf16(v1[0], v1[1]); o.w = cvt_pk_bf16(v1[2], v1[3]);
                    *(u32x4*)(O + r * D + c) = o; }
        }
    }
};

struct EpiFfn {
    bf16_t* ACT; const float* cw; const float* stin; float* stout_p; float* stout_s; int R0, MG, l; LAS float* halo;
    __device__ __forceinline__ void operator()(const f32x4 (&acc)[2][2][4][2], const Unit& u, int wr, int wc, int fr, int fq) const {
        const int colg = u.pn * 128 + wc * 32 + 8 * fq;
        if (fr >= 14) {
#pragma unroll
            for (int ai = 0; ai < 2; ++ai) { LAS float* hp = halo + ((ai * 2 + wr) * 2 + (fr - 14)) * 128 + wc * 32 + 8 * fq; *(LAS f32x4*)hp = acc[ai][0][3][0]; *(LAS f32x4*)(hp + 4) = acc[ai][0][3][1]; }
        }
        asm volatile("s_waitcnt lgkmcnt(0)" ::: "memory"); __builtin_amdgcn_s_barrier(); asm volatile("" ::: "memory");
        const int lane = fq * 16 + fr, src1 = (lane & 48) | ((fr + 15) & 15), src2 = (lane & 48) | ((fr + 14) & 15);
#pragma unroll
        for (int n = 0; n < 2; ++n) {
            const int col = colg + 4 * n;
            const f32x4 w0 = *(const f32x4*)(cw + col), w1 = *(const f32x4*)(cw + DFF + col), w2 = *(const f32x4*)(cw + 2 * DFF + col);
#pragma unroll
            for (int ai = 0; ai < 2; ++ai)
#pragma unroll
                for (int m = 0; m < 4; ++m) {
                    const int rho = 128 * ai + 64 * wr + 16 * m + fr, Rl = u.pm * 254 - 2 + rho, R = R0 + Rl;
                    const bool valid = (rho >= 2) && (Rl < MG);
                    int t, Lq, sq; const bool smp = (R >= MP);
                    if (!smp) { t = R & (SEQ - 1); Lq = SEQ; sq = R >> 12; } else { const int Rs = R - MP; t = Rs & 15; Lq = DSEQ; sq = Rs >> 4; }
                    const f32x4 g4 = acc[ai][0][m][n];
                    const f32x4 gm = acc[ai][0][m > 0 ? m - 1 : 0][n];
                    f32x4 p1, p2;
#pragma unroll
                    for (int e = 0; e < 4; ++e) { const float s1 = (m > 0 && fr == 15) ? gm[e] : g4[e], s2 = (m > 0 && fr >= 14) ? gm[e] : g4[e]; p1[e] = __shfl(s1, src1); p2[e] = __shfl(s2, src2); }
                    if (m == 0) { const int pb = ai * 2 + wr - 1;
                        if (pb >= 0 && fr < 2) { const LAS float* h0 = halo + (pb * 2) * 128 + wc * 32 + 8 * fq + 4 * n;
                            const f32x4 x0 = *(const LAS f32x4*)h0, y0 = *(const LAS f32x4*)(h0 + 128);
                            if (fr == 0) { p1 = y0; p2 = x0; } else { p2 = y0; } } }
                    if (valid && t < 2) {
                        f32x4 s0v = (f32x4){0.f, 0.f, 0.f, 0.f}, s1v = s0v;
                        if (smp) { const float* sp = stin + (size_t)((l * 16 + sq) * 2) * DFF + col; s0v = *(const f32x4*)sp; s1v = *(const f32x4*)(sp + DFF); }
                        if (t == 0) { p1 = s1v; p2 = s0v; } else { p2 = s1v; }
                    }
                    if (valid) {
                        const f32x4 v4 = acc[ai][1][m][n];
                        float o[4];
#pragma unroll
                        for (int e = 0; e < 4; ++e) { const float y = w0[e] * p2[e] + w1[e] * p1[e] + w2[e] * g4[e]; o[e] = y * fsigmoid(y) * v4[e]; }
                        u32x2 ov; ov.x = cvt_pk_bf16(o[0], o[1]); ov.y = cvt_pk_bf16(o[2], o[3]);
                        *(u32x2*)(ACT + (size_t)Rl * DFF + col) = ov;
                        if (t >= Lq - 2) *(f32x4*)((smp ? stout_s : stout_p) + (size_t)((l * 16 + sq) * 2 + (t - (Lq - 2))) * DFF + col) = g4;
                    }
                }
        }
    }
};
}

struct Args { const float* in[24]; float* out; unsigned char* ws; };

__device__ __forceinline__ void transpose_item(const float* W, int K, int N, bf16_t* WT, int row_off, LAS float* scr, int item, int lane) {
    const int nblk = N / 32, kb = item / nblk, nb = item % nblk, k0 = 64 * kb, n0 = 32 * nb;
#pragma unroll 8
    for (int i = 0; i < 32; ++i) { const int kk = 2 * i + (lane >> 5); scr[kk * 33 + (lane & 31)] = W[(size_t)(k0 + kk) * N + n0 + (lane & 31)]; }
    asm volatile("s_waitcnt lgkmcnt(0)" ::: "memory");
    const int c = lane & 7;
#pragma unroll
    for (int j = 0; j < 4; ++j) { const int n = (lane >> 3) + 8 * j; const LAS float* s = scr + (8 * c) * 33 + n;
        u32x4 o; o.x = cvt_pk_bf16(s[0 * 33], s[1 * 33]); o.y = cvt_pk_bf16(s[2 * 33], s[3 * 33]); o.z = cvt_pk_bf16(s[4 * 33], s[5 * 33]); o.w = cvt_pk_bf16(s[6 * 33], s[7 * 33]);
        *(u32x4*)(WT + (size_t)(row_off + n0 + n) * K + k0 + 8 * c) = o; }
    asm volatile("s_waitcnt lgkmcnt(0)" ::: "memory");
}

__device__ __forceinline__ void row_pass(const bf16_t* mrow  , const float* xin, const bf16_t* xin_b, float* xout, bf16_t* xout_b, const float* gpost, const float* gate,
                                         bf16_t* hrow  , const float* gpre, const float* sc, const float* sh, int lane) {
    float xv[2][8];
    if (xin_b) {
#pragma unroll
        for (int j = 0; j < 2; ++j) { const u32x4 w = *(const u32x4*)(xin_b + 512 * j + 8 * lane);
            xv[j][0] = bflo(w.x); xv[j][1] = bfhi(w.x); xv[j][2] = bflo(w.y); xv[j][3] = bfhi(w.y); xv[j][4] = bflo(w.z); xv[j][5] = bfhi(w.z); xv[j][6] = bflo(w.w); xv[j][7] = bfhi(w.w); }
    } else {
#pragma unroll
        for (int j = 0; j < 2; ++j) { const int c0 = 512 * j + 8 * lane; const f32x4 a = *(const f32x4*)(xin + c0), b = *(const f32x4*)(xin + c0 + 4);
            xv[j][0] = a[0]; xv[j][1] = a[1]; xv[j][2] = a[2]; xv[j][3] = a[3]; xv[j][4] = b[0]; xv[j][5] = b[1]; xv[j][6] = b[2]; xv[j][7] = b[3]; }
    }
    if (mrow) {
        float mv[2][8]; float ss = 0.f;
#pragma unroll
        for (int j = 0; j < 2; ++j) { const u32x4 w = *(const u32x4*)(mrow + 512 * j + 8 * lane);
            mv[j][0] = bflo(w.x); mv[j][1] = bfhi(w.x); mv[j][2] = bflo(w.y); mv[j][3] = bfhi(w.y); mv[j][4] = bflo(w.z); mv[j][5] = bfhi(w.z); mv[j][6] = bflo(w.w); mv[j][7] = bfhi(w.w);
#pragma unroll
            for (int e = 0; e < 8; ++e) ss += mv[j][e] * mv[j][e]; }
        const float rstd = rsqrtf(wave_sum(ss) * (1.f / D) + EPS);
#pragma unroll
        for (int j = 0; j < 2; ++j) { const int c0 = 512 * j + 8 * lane;
            const f32x4 g0 = *(const f32x4*)(gpost + c0), g1 = *(const f32x4*)(gpost + c0 + 4), t0 = *(const f32x4*)(gate + c0), t1 = *(const f32x4*)(gate + c0 + 4);
#pragma unroll
            for (int e = 0; e < 4; ++e) { xv[j][e] += t0[e] * (mv[j][e] * rstd * g0[e]); xv[j][4 + e] += t1[e] * (mv[j][4 + e] * rstd * g1[e]); }
            if (xout_b) { u32x4 o; o.x = cvt_pk_bf16(xv[j][0], xv[j][1]); o.y = cvt_pk_bf16(xv[j][2], xv[j][3]); o.z = cvt_pk_bf16(xv[j][4], xv[j][5]); o.w = cvt_pk_bf16(xv[j][6], xv[j][7]); *(u32x4*)(xout_b + c0) = o;
            } else { *(f32x4*)(xout + c0) = (f32x4){xv[j][0], xv[j][1], xv[j][2], xv[j][3]}; *(f32x4*)(xout + c0 + 4) = (f32x4){xv[j][4], xv[j][5], xv[j][6], xv[j][7]}; } }
    }
    if (hrow) {
        float ss = 0.f;
#pragma unroll
        for (int j = 0; j < 2; ++j)
#pragma unroll
            for (int e = 0; e < 8; ++e) ss += xv[j][e] * xv[j][e];
        const float rstd = rsqrtf(wave_sum(ss) * (1.f / D) + EPS);
#pragma unroll
        for (int j = 0; j < 2; ++j) { const int c0 = 512 * j + 8 * lane; float hv[8];
            const f32x4 g0 = *(const f32x4*)(gpre + c0), g1 = *(const f32x4*)(gpre + c0 + 4), s0 = *(const f32x4*)(sc + c0), s1 = *(const f32x4*)(sc + c0 + 4), h0 = *(const f32x4*)(sh + c0), h1 = *(const f32x4*)(sh + c0 + 4);
#pragma unroll
            for (int e = 0; e < 4; ++e) { hv[e] = xv[j][e] * rstd * g0[e] * (1.f + s0[e]) + h0[e]; hv[4 + e] = xv[j][4 + e] * rstd * g1[e] * (1.f + s1[e]) + h1[e]; }
            u32x4 o; o.x = cvt_pk_bf16(hv[0], hv[1]); o.y = cvt_pk_bf16(hv[2], hv[3]); o.z = cvt_pk_bf16(hv[4], hv[5]); o.w = cvt_pk_bf16(hv[6], hv[7]);
            *(u32x4*)(hrow + c0) = o; }
    }
}
__device__ __forceinline__ int row_batch(int R) { return R < MP ? (R >> 12) : 16 + ((R - MP) >> 4); }

template <int CTRL> __device__ __forceinline__ float dpp_rot(float v) { return __builtin_bit_cast(float, __builtin_amdgcn_update_dpp(0, __builtin_bit_cast(int, v), CTRL, 0xf, 0xf, true)); }
__device__ __forceinline__ float sum16(float x) { x += dpp_rot<0x128>(x); x += dpp_rot<0x124>(x); x += dpp_rot<0x122>(x); x += dpp_rot<0x121>(x); return x; }
template <bool FULL>
__device__ __forceinline__ void hgrn_item(LAS unsigned char* lds, const bf16_t* P, bf16_t* AB, int L, int hd, const float* lbv, const float* anorm, const float* S0, const float* Dd, int ns, float* Sout, float* Dout) {
    int tid = threadIdx.x; asm volatile("" : "+v"(tid));
    const int w = tid >> 6, lane = tid & 63, q4 = lane >> 4, c16 = lane & 15;
    const int k = tid & 127, tq = tid >> 7;
    LAS bf16_t* Qt = (LAS bf16_t*)lds;
    LAS bf16_t* Kt = Qt + 16 * 136;
    LAS bf16_t* KhT = Kt + 16 * 136;
    LAS bf16_t* VsT = KhT + 128 * 20;
    LAS float* dvec = (LAS float*)(VsT + 128 * 20);
    LAS float* qsum = dvec + 128;
    LAS float* ssq = qsum + 512;
    const float lb = lbv[k], oml = 1.f - lb;
    const float an = FULL ? anorm[16 * w + c16] : 0.f;
    f32x4 accS[8];
#pragma unroll
    for (int mt = 0; mt < 8; ++mt) accS[mt] = (f32x4){0.f, 0.f, 0.f, 0.f};
    for (int c = 0; c < ns; ++c) { const float* sc = S0 + (size_t)c * 16384 + 16 * w + c16;
#pragma unroll
        for (int mt = 0; mt < 8; ++mt) { f32x4 d4 = (f32x4){0.f, 0.f, 0.f, 0.f}; if (Dd) d4 = *(const f32x4*)(Dd + c * 128 + 16 * mt + 4 * q4);
#pragma unroll
            for (int j = 0; j < 4; ++j) accS[mt][j] = accS[mt][j] * d4[j] + sc[(size_t)(16 * mt + 4 * q4 + j) * 128]; } }
    const bf16_t* pq = P + 128 * hd + k + (size_t)(4 * tq) * N1;
    const bf16_t* pz = pq + 512;
    const int vt = (tid >> 4) & 15, vc = tid & 15;
    const bf16_t* pv = P + 1024 + 128 * hd + 8 * vc + (size_t)vt * N1;
    const bf16_t* pg = P + 1536 + 128 * hd + 16 * w + c16 + (size_t)(4 * q4) * N1;
    bf16_t* po = AB + 128 * hd + 16 * w + c16 + (size_t)(4 * q4) * D;
    const int nsteps = L >> 4;
    float btot = 0.f;
    unsigned short zr[4], qr[4], grn[4]; u32x4 vr = (u32x4){0u, 0u, 0u, 0u};
#pragma unroll
    for (int i = 0; i < 4; ++i) { zr[i] = pz[(size_t)i * N1]; qr[i] = pq[(size_t)i * N1]; grn[i] = pg[(size_t)i * N1]; }
    if (tid < 256) vr = *(const u32x4*)pv;
    for (int n = 0; n < nsteps; ++n) {
        unsigned short zc[4], qc[4], gr[4]; const u32x4 vcur = vr;
#pragma unroll
        for (int i = 0; i < 4; ++i) { zc[i] = zr[i]; qc[i] = qr[i]; gr[i] = grn[i]; }
        const size_t roff = (size_t)(16 * n) * N1;
        {
            const size_t nro = (size_t)(16 * (n + 1 < nsteps ? n + 1 : n)) * N1;
#pragma unroll
            for (int i = 0; i < 4; ++i) { zr[i] = pz[nro + (size_t)i * N1]; qr[i] = pq[nro + (size_t)i * N1]; grn[i] = pg[nro + (size_t)i * N1]; }
            if (tid < 256) vr = *(const u32x4*)(pv + nro);
        }
        float cs[4], kk[4], qv[4];
        {
            float run = 0.f;
#pragma unroll
            for (int i = 0; i < 4; ++i) { float z = bf2f(zc[i]); z = fminf(fmaxf(z, -30.f), 30.f); const float e = __expf(-z), sg = __builtin_amdgcn_rcpf(1.f + e), sn = e * sg;
                const float f = lb + oml * sg; run += __builtin_amdgcn_logf(f) * 0.69314718056f; cs[i] = run; kk[i] = oml * sn; qv[i] = bf2f(qc[i]); }
            qsum[tq * 128 + k] = run;
        }
        __syncthreads();
        {
            float pre = 0.f, tot = 0.f;
#pragma unroll
            for (int j = 0; j < 4; ++j) { const float v = qsum[j * 128 + k]; tot += v; pre += (j < tq) ? v : 0.f; }
            btot += tot;
            float kh[4];
#pragma unroll
            for (int i = 0; i < 4; ++i) { const float b = pre + cs[i]; const float qt = qv[i] * __expf(b), kt = kk[i] * __expf(fminf(-b, 80.f)); kh[i] = kk[i] * __expf(tot - b);
                Qt[(4 * tq + i) * 136 + k] = (bf16_t)(cvt_pk_bf16(qt, 0.f) & 0xffffu); Kt[(4 * tq + i) * 136 + k] = (bf16_t)(cvt_pk_bf16(kt, 0.f) & 0xffffu); }
            u32x2 kp; kp.x = cvt_pk_bf16(kh[0], kh[1]); kp.y = cvt_pk_bf16(kh[2], kh[3]);
            *(LAS u32x2*)(KhT + k * 20 + 4 * tq) = kp;
            if (tq == 0) dvec[k] = __expf(tot);
            if (tid < 256) {
                VsT[(8 * vc + 0) * 20 + vt] = (bf16_t)(vcur.x & 0xffffu); VsT[(8 * vc + 1) * 20 + vt] = (bf16_t)(vcur.x >> 16);
                VsT[(8 * vc + 2) * 20 + vt] = (bf16_t)(vcur.y & 0xffffu); VsT[(8 * vc + 3) * 20 + vt] = (bf16_t)(vcur.y >> 16);
                VsT[(8 * vc + 4) * 20 + vt] = (bf16_t)(vcur.z & 0xffffu); VsT[(8 * vc + 5) * 20 + vt] = (bf16_t)(vcur.z >> 16);
                VsT[(8 * vc + 6) * 20 + vt] = (bf16_t)(vcur.w & 0xffffu); VsT[(8 * vc + 7) * 20 + vt] = (bf16_t)(vcur.w >> 16);
            }
        }
        __syncthreads();
        f32x4 acco = (f32x4){0.f, 0.f, 0.f, 0.f};
        {
            const u32x2 vv = *(const LAS u32x2*)(VsT + (16 * w + c16) * 20 + 4 * q4);
            const bf16x4 vf = __builtin_bit_cast(bf16x4, vv);
            if (FULL) {
            bf16x8 qf[4], kf[4];
#pragma unroll
            for (int kq = 0; kq < 4; ++kq) {
                const u32x2 a0 = *(const LAS u32x2*)(Qt + c16 * 136 + 32 * kq + 4 * q4), a1 = *(const LAS u32x2*)(Qt + c16 * 136 + 32 * kq + 16 + 4 * q4);
                const u32x2 b0 = *(const LAS u32x2*)(Kt + c16 * 136 + 32 * kq + 4 * q4), b1 = *(const LAS u32x2*)(Kt + c16 * 136 + 32 * kq + 16 + 4 * q4);
                u32x4 qa = (u32x4){a0.x, a0.y, a1.x, a1.y}, ka = (u32x4){b0.x, b0.y, b1.x, b1.y};
                qf[kq] = __builtin_bit_cast(bf16x8, qa); kf[kq] = __builtin_bit_cast(bf16x8, ka);
            }
            f32x4 accA = (f32x4){0.f, 0.f, 0.f, 0.f};
#pragma unroll
            for (int kq = 0; kq < 4; ++kq) accA = __builtin_amdgcn_mfma_f32_16x16x32_bf16(kf[kq], qf[kq], accA, 0, 0, 0);
#pragma unroll
            for (int j = 0; j < 4; ++j) accA[j] = (c16 >= 4 * q4 + j) ? accA[j] : 0.f;
            u32x2 pa; pa.x = cvt_pk_bf16(accA[0], accA[1]); pa.y = cvt_pk_bf16(accA[2], accA[3]);
            const bf16x4 pA = __builtin_bit_cast(bf16x4, pa);
            acco = __builtin_amdgcn_mfma_f32_16x16x16bf16_1k(pA, vf, (f32x4){0.f, 0.f, 0.f, 0.f}, 0, 0, 0);
#pragma unroll
            for (int kq = 0; kq < 4; ++kq) {
                u32x4 sp; sp.x = cvt_pk_bf16(accS[2 * kq][0], accS[2 * kq][1]); sp.y = cvt_pk_bf16(accS[2 * kq][2], accS[2 * kq][3]);
                sp.z = cvt_pk_bf16(accS[2 * kq + 1][0], accS[2 * kq + 1][1]); sp.w = cvt_pk_bf16(accS[2 * kq + 1][2], accS[2 * kq + 1][3]);
                acco = __builtin_amdgcn_mfma_f32_16x16x32_bf16(qf[kq], __builtin_bit_cast(bf16x8, sp), acco, 0, 0, 0);
            }
            }
#pragma unroll
            for (int mt = 0; mt < 8; ++mt) {
                const u32x2 kh2 = *(const LAS u32x2*)(KhT + (16 * mt + c16) * 20 + 4 * q4);
                const f32x4 d4 = *(const LAS f32x4*)(dvec + 16 * mt + 4 * q4);
                accS[mt] = accS[mt] * d4;
                accS[mt] = __builtin_amdgcn_mfma_f32_16x16x16bf16_1k(__builtin_bit_cast(bf16x4, kh2), vf, accS[mt], 0, 0, 0);
            }
            if (FULL) {
            const float s0 = sum16(acco[0] * acco[0]), s1 = sum16(acco[1] * acco[1]), s2 = sum16(acco[2] * acco[2]), s3 = sum16(acco[3] * acco[3]);
            if (c16 == 0) { *(LAS f32x4*)(ssq + w * 16 + 4 * q4) = (f32x4){s0, s1, s2, s3}; }
            }
        }
        if (FULL) __syncthreads();
        if (FULL) {
            f32x4 tot = (f32x4){0.f, 0.f, 0.f, 0.f};
#pragma unroll
            for (int ww = 0; ww < 8; ++ww) tot += *(const LAS f32x4*)(ssq + ww * 16 + 4 * q4);
#pragma unroll
            for (int j = 0; j < 4; ++j) { const float rstd = rsqrtf(tot[j] * (1.f / 128.f) + EPS); const float o = acco[j] * rstd * an * bf2f(gr[j]);
                po[(size_t)(16 * n + j) * D] = (bf16_t)(cvt_pk_bf16(o, 0.f) & 0xffffu); }
        }
    }
    if (Sout) {
#pragma unroll
        for (int mt = 0; mt < 8; ++mt)
#pragma unroll
            for (int j = 0; j < 4; ++j) Sout[(size_t)(16 * mt + 4 * q4 + j) * 128 + 16 * w + c16] = accS[mt][j];
    }
    if (Dout && tid < 128) Dout[tid] = __expf(btot);
    __syncthreads();
}

__device__ __forceinline__ void unpack8(const u32x4 w, float (&v)[8]) { v[0] = bflo(w.x); v[1] = bfhi(w.x); v[2] = bflo(w.y); v[3] = bfhi(w.y); v[4] = bflo(w.z); v[5] = bfhi(w.z); v[6] = bflo(w.w); v[7] = bfhi(w.w); }
__device__ __forceinline__ u32x4 pack8(const float (&v)[8]) { u32x4 o; o.x = cvt_pk_bf16(v[0], v[1]); o.y = cvt_pk_bf16(v[2], v[3]); o.z = cvt_pk_bf16(v[4], v[5]); o.w = cvt_pk_bf16(v[6], v[7]); return o; }
__device__ __forceinline__ void load8f(const float* p, float (&v)[8]) { const f32x4 a = *(const f32x4*)p, b = *(const f32x4*)(p + 4); v[0] = a[0]; v[1] = a[1]; v[2] = a[2]; v[3] = a[3]; v[4] = b[0]; v[5] = b[1]; v[6] = b[2]; v[7] = b[3]; }
__device__ __forceinline__ void store8f(float* p, const float (&v)[8]) { *(f32x4*)p = (f32x4){v[0], v[1], v[2], v[3]}; *(f32x4*)(p + 4) = (f32x4){v[4], v[5], v[6], v[7]}; }

__device__ __forceinline__ void shortconv_phase(const Args& a, int l, int R0, int MG, const bf16_t* P, bf16_t* AB, unsigned* ctr, volatile LAS unsigned* bcast) {
    const float* cw = a.in[17] + (size_t)l * 3 * BW;
    int tidc = threadIdx.x; asm volatile("" : "+v"(tidc));
    const int nconv = (MG / 8) * 64;
    for (;;) {
        __syncthreads();
        if (tidc == 0) *bcast = __hip_atomic_fetch_add(ctr, 512u, __ATOMIC_RELAXED, __HIP_MEMORY_SCOPE_AGENT);
        __syncthreads();
        const int it = (int)*bcast + tidc;
        if (it - tidc >= nconv) break;
        if (it >= nconv) continue;
        const int rb = it >> 6, ch = (it & 63) * 8, r0 = rb * 8, R = R0 + r0;
        int t0, Lq; const float* st_in = nullptr; float* st_out;
        if (R < MP) { t0 = R & (SEQ - 1); Lq = SEQ; st_out = a.out + O_SCP + (size_t)((l * 16 + (R >> 12)) * 2) * BW; }
        else { const int Rs = R - MP; t0 = Rs & 15; Lq = DSEQ; const int sq = Rs >> 4; st_in = a.in[3] + (size_t)((l * 16 + sq) * 2) * BW; st_out = a.out + O_SCS + (size_t)((l * 16 + sq) * 2) * BW; }
        float w0[8], w1[8], w2[8], p2[8], p1[8];
        load8f(cw + ch, w0); load8f(cw + BW + ch, w1); load8f(cw + 2 * BW + ch, w2);
        if (t0 == 0) {
            if (st_in) { load8f(st_in + ch, p2); load8f(st_in + BW + ch, p1); }
            else {
#pragma unroll
                for (int e = 0; e < 8; ++e) { p2[e] = 0.f; p1[e] = 0.f; } }
        } else {
            float c8[8], v8[8];
            unpack8(*(const u32x4*)(P + (size_t)(r0 - 2) * N1 + 2560 + ch), c8); unpack8(*(const u32x4*)(P + (size_t)(r0 - 2) * N1 + 3072 + ch), v8);
#pragma unroll
            for (int e = 0; e < 8; ++e) p2[e] = c8[e] * v8[e];
            unpack8(*(const u32x4*)(P + (size_t)(r0 - 1) * N1 + 2560 + ch), c8); unpack8(*(const u32x4*)(P + (size_t)(r0 - 1) * N1 + 3072 + ch), v8);
#pragma unroll
            for (int e = 0; e < 8; ++e) p1[e] = c8[e] * v8[e];
        }
#pragma unroll 2
        for (int i = 0; i < 8; ++i) {
            const bf16_t* pr = P + (size_t)(r0 + i) * N1;
            float b8[8], c8[8], v8[8], o8[8];
            unpack8(*(const u32x4*)(pr + 2048 + ch), b8); unpack8(*(const u32x4*)(pr + 2560 + ch), c8); unpack8(*(const u32x4*)(pr + 3072 + ch), v8);
#pragma unroll
            for (int e = 0; e < 8; ++e) { const float cv = c8[e] * v8[e]; o8[e] = b8[e] * (w0[e] * p2[e] + w1[e] * p1[e] + w2[e] * cv); p2[e] = p1[e]; p1[e] = cv; }
            *(u32x4*)(AB + (size_t)(r0 + i) * D + 512 + ch) = pack8(o8);
        }
        if (t0 + 8 == Lq) { store8f(st_out + ch, p2); store8f(st_out + BW + ch, p1); }
    }
}
#define XB_TMO      128
#define XB_XCNT(j)  (256  + 64 * (j))
#define XB_XSUB(j)  (1280 + 64 * (j))
#define XB_XGEN(j)  (2304 + 64 * (j))
#define XB_TOP      3328
#define XB_TOPGEN   3392
#define XCD_BAR_WORDS 3456
#define XB_SPIN_CAP (1u << 22)
__device__ __forceinline__ unsigned xb_ld(unsigned* p)              { return __hip_atomic_load(p, __ATOMIC_RELAXED, __HIP_MEMORY_SCOPE_AGENT); }
__device__ __forceinline__ unsigned xb_add(unsigned* p, unsigned v) { return __hip_atomic_fetch_add(p, v, __ATOMIC_RELAXED, __HIP_MEMORY_SCOPE_AGENT); }
__device__ __forceinline__ unsigned xb_xcc_id() { return (unsigned)__builtin_amdgcn_s_getreg((3 << 11) | 20) & 0xFu; }
#define XB_SPIN(cond, bar) do { unsigned _sp = 0; while (cond) { __builtin_amdgcn_s_sleep(1); \
    if ((++_sp & 255u) == 0u) { if (xb_ld(&(bar)[XB_TMO])) break; if (_sp > XB_SPIN_CAP) { atomicAdd(&(bar)[XB_TMO], 1u); break; } } } } while (0)
struct XcdBarrier { unsigned* bar; unsigned x; volatile LAS unsigned* st; };
__device__ __forceinline__ XcdBarrier xcd_barrier_post(unsigned* bar, volatile LAS unsigned* st) {
    XcdBarrier b; b.bar = bar; b.x = xb_xcc_id(); b.st = st;
    if (threadIdx.x == 0) (void)xb_add(&bar[XB_XCNT(b.x)], 1u);
    return b;
}
__device__ __forceinline__ void xcd_barrier_complete(unsigned* bar, unsigned x, unsigned& nloc, unsigned& nx) {
    const unsigned G = gridDim.x * gridDim.y * gridDim.z;
    unsigned sum, cnt, mine, sp = 0u;
    for (;;) {
        sum = 0u; cnt = 0u; mine = 0u;
#pragma unroll
        for (unsigned j = 0; j < 16; ++j) { const unsigned c = xb_ld(&bar[XB_XCNT(j)]); sum += c; cnt += (c > 0u) ? 1u : 0u; mine = (j == x) ? c : mine; }
        if (sum == G) break;
        __builtin_amdgcn_s_sleep(1);
        if ((++sp & 255u) == 0u) { if (xb_ld(&bar[XB_TMO])) break; if (sp > XB_SPIN_CAP) { atomicAdd(&bar[XB_TMO], 1u); break; } }
    }
    nloc = mine > 0u ? mine : 1u; nx = cnt > 0u ? cnt : 1u;
}
__device__ __forceinline__ void xcd_barrier(const XcdBarrier& b) {
    asm volatile("s_waitcnt vmcnt(0) lgkmcnt(0)" ::: "memory");
    __syncthreads();
    if (threadIdx.x == 0) {
        unsigned* bar = b.bar;
        __builtin_amdgcn_s_waitcnt(0);
        unsigned nloc = b.st[0], nx = b.st[1];
        if (nloc == 0u) { xcd_barrier_complete(bar, b.x, nloc, nx); b.st[0] = nloc; b.st[1] = nx; }
        const unsigned old = xb_add(&bar[XB_XSUB(b.x)], 1u);
        const unsigned gen = old / nloc;
        if (old + 1u == (gen + 1u) * nloc) {
            __builtin_amdgcn_fence(__ATOMIC_RELEASE, "agent");
            asm volatile("s_waitcnt vmcnt(0)" ::: "memory");
            const unsigned og = xb_add(&bar[XB_TOP], 1u);
            const unsigned tg = og / nx;
            if (og + 1u == (tg + 1u) * nx) xb_add(&bar[XB_TOPGEN], 1u);
            else XB_SPIN(xb_ld(&bar[XB_TOPGEN]) == tg, bar);
            __builtin_amdgcn_fence(__ATOMIC_ACQUIRE, "agent");
            xb_add(&bar[XB_XGEN(b.x)], 1u);
            asm volatile("s_waitcnt vmcnt(0)" ::: "memory");
        } else {
            XB_SPIN(xb_ld(&bar[XB_XGEN(b.x)]) == gen, bar);
            __builtin_amdgcn_fence(__ATOMIC_ACQUIRE, "agent");
            asm volatile("s_waitcnt vmcnt(0)" ::: "memory");
        }
    }
    __syncthreads();
}

#define GSYNC_CG() do { asm volatile("s_waitcnt vmcnt(0) lgkmcnt(0)" ::: "memory"); grid.sync(); } while (0)
#define GSYNC() xcd_barrier(xbar)
__global__ void __launch_bounds__(512, 2) fwd_megakernel(Args a) {
    extern __shared__ __attribute__((aligned(16))) unsigned char lds_raw[];
    LAS unsigned char* lds = (LAS unsigned char*)lds_raw;
    cg::grid_group grid = cg::this_grid();
    const int tid = threadIdx.x, lane = tid & 63, wave = __builtin_amdgcn_readfirstlane(tid >> 6);
    const int G = gridDim.x, wg = blockIdx.x;
    unsigned char* ws = a.ws;
    volatile LAS unsigned* MISC = (volatile LAS unsigned*)(lds + 131072 + 320);
    if (tid < 32) MISC[tid] = 0u;
    __syncthreads();
    const XcdBarrier xbar = xcd_barrier_post((unsigned*)ws + 4096, MISC + 8);
    float* ADA = (float*)(ws + WS_ADA);
    float* LB = (float*)(ws + WS_LB);
    bf16_t* Hb = (bf16_t*)(ws + WS_H);
    bf16_t* ABb = (bf16_t*)(ws + WS_AB);
    bf16_t* Pb = (bf16_t*)(ws + WS_P);
    bf16_t* ACTb = (bf16_t*)(ws + WS_ACT);
    bf16_t* XBb = (bf16_t*)(ws + WS_XB);

    if (wg < 192) {
        LAS float* csT = (LAS float*)lds;
        for (int i = tid; i < 32 * 1024; i += 512) { const int b = i >> 10, kx = i & 1023; const float c = (b < 16) ? a.in[5][(size_t)b * D + kx] : a.in[6][(size_t)(b - 16) * D + kx]; csT[kx * 32 + b] = c * fsigmoid(c); }
        __syncthreads();
        const int cc = tid & 127, kq = tid >> 7;
        const int col = wg * 128 + cc;
        const int l = col / 6144, n = col - l * 6144;
        const float* wp = a.in[7] + (size_t)l * D * 6144 + n;
        float acc[32];
#pragma unroll
        for (int b = 0; b < 32; ++b) acc[b] = 0.f;
#pragma unroll 4
        for (int kx = 256 * kq; kx < 256 * kq + 256; ++kx) { const float wv = wp[(size_t)kx * 6144];
#pragma unroll
            for (int b4 = 0; b4 < 8; ++b4) { const f32x4 c4 = *(const LAS f32x4*)(csT + kx * 32 + 4 * b4); acc[4 * b4] += c4[0] * wv; acc[4 * b4 + 1] += c4[1] * wv; acc[4 * b4 + 2] += c4[2] * wv; acc[4 * b4 + 3] += c4[3] * wv; } }
        __syncthreads();
        LAS float* red = (LAS float*)lds;
#pragma unroll
        for (int b = 0; b < 32; ++b) red[(kq * 32 + b) * 128 + cc] = acc[b];
        __syncthreads();
#pragma unroll
        for (int i = 0; i < 8; ++i) { const int o = tid + 512 * i, b = o >> 7, c2 = o & 127; const int col2 = wg * 128 + c2, n2 = col2 - l * 6144;
            const float v = red[(0 * 32 + b) * 128 + c2] + red[(1 * 32 + b) * 128 + c2] + red[(2 * 32 + b) * 128 + c2] + red[(3 * 32 + b) * 128 + c2];
            ADA[((size_t)l * 32 + b) * 6144 + n2] = v + a.in[8][(size_t)l * 6144 + n2]; }
        __syncthreads();
    }
    if (wg == 192) {
        const float x0 = a.in[14][tid], x1 = a.in[14][512 + tid], x2 = a.in[14][1024 + tid], x3 = a.in[14][1536 + tid];
        const float mx = fmaxf(fmaxf(x0, x1), fmaxf(x2, x3));
        const float e0 = __expf(x0 - mx), e1 = __expf(x1 - mx), e2 = __expf(x2 - mx), e3 = __expf(x3 - mx), inv = 1.f / (e0 + e1 + e2 + e3);
        LB[tid] = 0.f; LB[512 + tid] = e1 * inv; LB[1024 + tid] = (e1 + e2) * inv; LB[1536 + tid] = (e1 + e2 + e3) * inv;
    }
    {
        LAS float* scr = (LAS float*)(lds + wave * 16384);
        const int gw = wg * 8 + wave, NGW = G * 8;
        constexpr int I_IN = 16 * (NIN / 32), I_BG = 16 * (2048 / 32), I_PA = 8 * 32, I_PB = 8 * 32, I_O = 16 * 32, I_UP = 16 * (NUP / 32), I_DN = (DFF / 64) * 32;
        constexpr int I_LAYER = I_IN + I_BG + I_PA + I_PB + I_O + I_UP + I_DN;
        for (int it = gw; it < 4 * I_LAYER; it += NGW) {
            const int l = it / I_LAYER; int r = it - l * I_LAYER;
            bf16_t* wl = (bf16_t*)(ws + WS_W + (size_t)l * LAYER_W);
            if (r < I_IN) { transpose_item(a.in[13] + (size_t)l * D * NIN, D, NIN, wl + W1_OFF / 2, 0, scr, r, lane); continue; } r -= I_IN;
            if (r < I_BG) { transpose_item(a.in[19] + (size_t)l * D * 2048, D, 2048, wl + W1_OFF / 2, NIN, scr, r, lane); continue; } r -= I_BG;
            if (r < I_PA) { transpose_item(a.in[16] + (size_t)l * AW * D, AW, D, wl + WPA_OFF / 2, 0, scr, r, lane); continue; } r -= I_PA;
            if (r < I_PB) { transpose_item(a.in[18] + (size_t)l * BW * D, BW, D, wl + WPB_OFF / 2, 0, scr, r, lane); continue; } r -= I_PB;
            if (r < I_O) { transpose_item(a.in[20] + (size_t)l * D * D, D, D, wl + WO_OFF / 2, 0, scr, r, lane); continue; } r -= I_O;
            if (r < I_UP) { const int n0 = 32 * (r % (NUP / 32));
                const int jj = n0 < DFF ? n0 : n0 - DFF, rowb = 256 * (jj >> 7) + (n0 < DFF ? 0 : 128) + (jj & 127);
                transpose_item(a.in[21] + (size_t)l * D * NUP, D, NUP, wl + WUP_OFF / 2, rowb - n0, scr, r, lane); continue; } r -= I_UP;
            transpose_item(a.in[23] + (size_t)l * DFF * D, DFF, D, wl + WDN_OFF / 2, 0, scr, r, lane);
        }
    }
    GSYNC_CG();

    for (int grp = 0; grp < 2; ++grp) {
        const int R0 = grp ? MG0 : 0, MG = grp ? MG1 : MG0, nM = MG / 256;
        int tid = threadIdx.x; asm volatile("" : "+v"(tid));
        const int lane = tid & 63, wave = __builtin_amdgcn_readfirstlane(tid >> 6);
        for (int r = wg * 8 + wave; r < MG; r += G * 8) {
            const int R = R0 + r; const float* xin = (R < MP) ? a.in[0] + (size_t)R * D : a.in[1] + (size_t)(R - MP) * D;
            const float* ad = ADA + (size_t)row_batch(R) * 6144;
            row_pass(nullptr, xin, nullptr, nullptr, nullptr, nullptr, nullptr, Hb + (size_t)r * D, a.in[9], ad + 1024, ad, lane);
        }
        GSYNC();
        for (int l = 0; l < DEPTH; ++l) {
            int tid = threadIdx.x; asm volatile("" : "+v"(tid));
            const int lane = tid & 63, wave = __builtin_amdgcn_readfirstlane(tid >> 6);
            const bf16_t* wl = (const bf16_t*)(ws + WS_W + (size_t)l * LAYER_W);
            { pg8::Gemm g{Hb, wl + W1_OFF / 2, D, D, D}; pg8::StaticOrder S; S.init(nM, N1 / 256, G, wg); pg8::EpiStore E{Pb, N1, 1}; pg8::gemm_phase(lds, g, S, E); }
            GSYNC();
            {
                int tidb = threadIdx.x; asm volatile("" : "+v"(tidb));
                const int chain = wg >> 3, chunk = wg & 7, sqg = chain >> 2, hd = chain & 3;
                const int lrow = sqg * SEQ + chunk * 512;
                float* DS = (float*)(ws + WS_DS) + (size_t)(chain * 8) * 16384;
                float* DD = (float*)(ws + WS_DD) + (size_t)(chain * 8) * 128;
                float* SS = (float*)(ws + WS_SS) + (size_t)wg * 16384;
                const float* lbv = LB + l * 512 + hd * 128;
                const float* anv = a.in[15] + l * 128;
                if (wg < 256 && chunk < 7)
                    hgrn_item<false>(lds, Pb + (size_t)lrow * N1, ABb + (size_t)lrow * D, 512, hd, lbv, anv, nullptr, nullptr, 0, DS + (size_t)chunk * 16384, DD + chunk * 128);
                shortconv_phase(a, l, R0, MG, Pb, ABb, (unsigned*)ws + 1024 + 64 * (grp * 4 + l), MISC + 16);
                GSYNC();
                if (wg < 256)
                    hgrn_item<true>(lds, Pb + (size_t)lrow * N1, ABb + (size_t)lrow * D, 512, hd, lbv, anv, DS, DD, chunk,
                              chunk == 7 ? a.out + O_SHP + (size_t)((l * 16 + 8 * grp + sqg) * 4 + hd) * 16384 : nullptr, nullptr);
                if (grp == 1 && wg < 64) {
                    const int sq = wg >> 2, hs = wg & 3; const int srow = MG0 + sq * DSEQ;
                    hgrn_item<true>(lds, Pb + (size_t)srow * N1, ABb + (size_t)srow * D, DSEQ, hs, LB + l * 512 + hs * 128, anv,
                              a.in[2] + (size_t)((l * 16 + sq) * 4 + hs) * 16384, nullptr, 1, a.out + O_SHS + (size_t)((l * 16 + sq) * 4 + hs) * 16384, nullptr);
                }
            }
            GSYNC();
            { pg8::Gemm g{ABb, wl + WPA_OFF / 2, D, AW, AW}; pg8::StaticOrder S; S.init(nM, D / 256, G, wg); pg8::EpiGate E{Hb, Pb + NIN, 0}; pg8::gemm_phase(lds, g, S, E); }
            { pg8::Gemm g{ABb + AW, wl + WPB_OFF / 2, D, BW, BW}; pg8::StaticOrder S; S.init(nM, D / 256, G, wg); pg8::EpiGate E{Hb, Pb + NIN + D, 1}; pg8::gemm_phase(lds, g, S, E); }
            GSYNC();
            { pg8::Gemm g{Hb, wl + WO_OFF / 2, D, D, D}; pg8::StaticOrder S; S.init(nM, D / 256, G, wg); pg8::EpiStore E{ABb, D, 0}; pg8::gemm_phase(lds, g, S, E); }
            GSYNC();
            for (int r = wg * 8 + wave; r < MG; r += G * 8) {
                const int R = R0 + r; const float* xin = (R < MP) ? a.in[0] + (size_t)R * D : a.in[1] + (size_t)(R - MP) * D;
                const float* ad = ADA + ((size_t)l * 32 + row_batch(R)) * 6144;
                row_pass(ABb + (size_t)r * D, xin, (l == 0) ? nullptr : XBb + (size_t)r * D, nullptr, XBb + (size_t)r * D, a.in[10] + l * D, ad + 2048, Hb + (size_t)r * D, a.in[11] + l * D, ad + 4096, ad + 3072, lane);
            }
            GSYNC();
            { pg8::Gemm g{Hb, wl + WUP_OFF / 2, D, D, D, 254, -2}; pg8::StaticOrder S; S.init((MG + 253) / 254, NUP / 256, G, wg);
              pg8::EpiFfn E{ACTb, a.in[22] + (size_t)l * 3 * DFF, a.in[4], a.out + O_SFP, a.out + O_SFS, R0, MG, l, (LAS float*)(lds + 131072 + 1024)};
              pg8::gemm_phase(lds, g, S, E); }
            GSYNC();
            { pg8::Gemm g{ACTb, wl + WDN_OFF / 2, DFF, DFF, DFF}; pg8::StaticOrder S; S.init(nM, D / 256, G, wg); pg8::EpiStore E{ABb, D, 0}; pg8::gemm_phase(lds, g, S, E); }
            GSYNC();
            for (int r = wg * 8 + wave; r < MG; r += G * 8) {
                const int R = R0 + r;
                const float* ad = ADA + ((size_t)l * 32 + row_batch(R)) * 6144;
                const float* adn = ADA + ((size_t)(l + 1 < DEPTH ? l + 1 : l) * 32 + row_batch(R)) * 6144;
                row_pass(ABb + (size_t)r * D, nullptr, XBb + (size_t)r * D, a.out + (size_t)R * D, (l + 1 < DEPTH) ? XBb + (size_t)r * D : nullptr, a.in[12] + l * D, ad + 5120, (l + 1 < DEPTH) ? Hb + (size_t)r * D : nullptr,
                         a.in[9] + (l + 1 < DEPTH ? l + 1 : l) * D, adn + 1024, adn, lane);
            }
            GSYNC();
        }
    }
}

extern "C" void kernel_launch(void* const* d_in, const int* in_sizes, int n_in, void* d_out, int out_size, void* d_ws, size_t ws_size, hipStream_t stream) {
    static int grid = 0;
    if (grid == 0) {
        if (n_in != 24 || ws_size < WS_END) { fprintf(stderr, "kernel_launch: unexpected n_in %d / ws_size %zu (need %zu)\n", n_in, ws_size, (size_t)WS_END); grid = -1; return; }
        int dev = 0, cus = 0, per_cu = 0;
        hipGetDevice(&dev);
        hipDeviceGetAttribute(&cus, hipDeviceAttributeMultiprocessorCount, dev);
        if (hipFuncSetAttribute((const void*)fwd_megakernel, hipFuncAttributeMaxDynamicSharedMemorySize, LDS_BYTES) != hipSuccess) { fprintf(stderr, "kernel_launch: hipFuncSetAttribute failed\n"); }
        if (hipOccupancyMaxActiveBlocksPerMultiprocessor(&per_cu, (const void*)fwd_megakernel, 512, LDS_BYTES) != hipSuccess || per_cu < 1) { fprintf(stderr, "kernel_launch: occupancy query says %d\n", per_cu); per_cu = 1; }
        (void)hipGetLastError();
        grid = cus;
    }
    if (grid < 0) return;
    if (hipMemsetAsync(d_ws, 0, 65536, stream) != hipSuccess) { fprintf(stderr, "kernel_launch: hipMemsetAsync failed\n"); return; }
    Args a{};
    for (int i = 0; i < 24; ++i) a.in[i] = (const float*)d_in[i];
    a.out = (float*)d_out; a.ws = (unsigned char*)d_ws;
    void* args[] = {&a};
    hipError_t e = hipLaunchCooperativeKernel((const void*)fwd_megakernel, dim3(grid), dim3(512), args, LDS_BYTES, stream);
    if (e != hipSuccess) fprintf(stderr, "kernel_launch: cooperative launch failed: %s (grid %d)\n", hipGetErrorString(e), grid);
}
```

```cpp
#include <hip/hip_runtime.h>
#include <hip/hip_cooperative_groups.h>
#include <cstdio>
#include <cstdint>
namespace cg = cooperative_groups;

#define LAS __attribute__((address_space(3)))
typedef unsigned short bf16_t;
typedef short bf16x8 __attribute__((ext_vector_type(8)));
typedef short bf16x4 __attribute__((ext_vector_type(4)));
typedef float f32x4 __attribute__((ext_vector_type(4)));
typedef unsigned u32x4 __attribute__((ext_vector_type(4)));
typedef unsigned u32x2 __attribute__((ext_vector_type(2)));

constexpr int D = 1024, SEQ = 4096, NBATCH = 16, DEPTH = 4, DSEQ = 16;
constexpr int AW = 512, BW = 512, DFF = 2816, NIN = 3584, N1 = 5632, NUP = 5632;
constexpr int MP = NBATCH * SEQ;
constexpr int MS = NBATCH * DSEQ;
constexpr int MG0 = 32768, MG1 = 33024, MGMAX = 33024;
constexpr float EPS = 1e-6f;
constexpr size_t O_YP = 0, O_YS = 67108864, O_SHP = 67371008, O_SCP = 71565312, O_SFP = 71630848, O_SHS = 71991296, O_SCS = 76185600, O_SFS = 76251136;
constexpr size_t MiB = 1u << 20;
constexpr size_t WS_ADA = 1 * MiB;
constexpr size_t WS_LB = 5 * MiB;
constexpr size_t WS_W = 8 * MiB;
constexpr size_t W1_OFF = 0, WPA_OFF = (size_t)N1 * D * 2, WPB_OFF = WPA_OFF + (size_t)D * AW * 2, WO_OFF = WPB_OFF + (size_t)D * BW * 2,
                 WUP_OFF = WO_OFF + (size_t)D * D * 2, WDN_OFF = WUP_OFF + (size_t)NUP * D * 2, LAYER_W = WDN_OFF + (size_t)D * DFF * 2;
constexpr size_t WS_H = 136 * MiB;
constexpr size_t WS_AB = 202 * MiB;
constexpr size_t WS_P = 268 * MiB;
constexpr size_t WS_ACT = 624 * MiB;
constexpr size_t WS_DS = 804 * MiB;
constexpr size_t WS_DD = 822 * MiB;
constexpr size_t WS_SS = 824 * MiB;
constexpr size_t WS_DUMMY = 840 * MiB;
constexpr size_t WS_XB = 842 * MiB;
constexpr size_t WS_END = 908 * MiB;
static_assert(WS_W + 4 * LAYER_W <= WS_H && WS_H + (size_t)MGMAX * D * 2 <= WS_AB && WS_AB + (size_t)MGMAX * D * 2 <= WS_P && WS_P + (size_t)MGMAX * N1 * 2 <= WS_ACT && WS_ACT + (size_t)MGMAX * DFF * 2 <= WS_DS && WS_DS + (size_t)32 * 8 * 16384 * 4 <= WS_DD, "ws map");
constexpr int LDS_BYTES = 147456;

__device__ __forceinline__ unsigned cvt_pk_bf16(float lo, float hi) { unsigned r; asm volatile("v_cvt_pk_bf16_f32 %0, %1, %2" : "=v"(r) : "v"(lo), "v"(hi)); return r; }
__device__ __forceinline__ float bf2f(unsigned short b) { return __uint_as_float(((unsigned)b) << 16); }
__device__ __forceinline__ float bflo(unsigned w) { return __uint_as_float(w << 16); }
__device__ __forceinline__ float bfhi(unsigned w) { return __uint_as_float(w & 0xffff0000u); }
__device__ __forceinline__ float fsigmoid(float x) { return __builtin_amdgcn_rcpf(1.f + __expf(-x)); }
template <int CTRL> __device__ __forceinline__ float dpp_rot(float v) { return __builtin_bit_cast(float, __builtin_amdgcn_update_dpp(0, __builtin_bit_cast(int, v), CTRL, 0xf, 0xf, true)); }
__device__ __forceinline__ float sum16(float x) { x += dpp_rot<0x128>(x); x += dpp_rot<0x124>(x); x += dpp_rot<0x122>(x); x += dpp_rot<0x121>(x); return x; }
__device__ __forceinline__ float wave_sum(float v) { v = sum16(v); v += __shfl_xor(v, 16); v += __shfl_xor(v, 32); return v; }

namespace pg8 {
constexpr int BM = 256, BK = 64, HALF = 128, HTB = HALF * BK * 2, STAGE_BYTES = 8 * HTB, NXCD = 8, WGM = 8;
__host__ __device__ __forceinline__ int lds_byte(int r, int c) { const int st = (r >> 4) * 2 + (c >> 5), rr = r & 15, cc = c & 31, ob = rr * 64 + cc * 2; return st * 1024 + (ob ^ (((ob >> 9) & 1) << 5)); }
__host__ __device__ __forceinline__ void stage_rc(int b, int& R, int& C) { const int st = b / 1024, sb = b % 1024, swz = sb ^ (((sb >> 9) & 1) << 5); R = (st >> 1) * 16 + swz / 64; C = (st & 1) * 32 + (swz % 64) / 2; }
__host__ __device__ __forceinline__ int perm32(int rho) { const int n = rho >> 4, i = rho & 15; return 8 * (i >> 2) + 4 * n + (i & 3); }
struct Unit { int pm, pn; };
struct Gemm { const bf16_t* A; const bf16_t* Bt; int lda, ldb, K; int mstride = 256; int arow0 = 0; };
struct StaticOrder {
    int nM, nN, nwg, G, c;
    __device__ void init(int nM_, int nN_, int G_, int c_) { nM = nM_; nN = nN_; nwg = nM * nN; G = G_; c = c_; }
    __device__ bool next(int i, Unit& u) const {
        const long L = (long)i * G + c; if (L >= nwg) return false;
        int wgid = (int)L; { const int q = nwg / NXCD, r = nwg % NXCD, xcd = wgid % NXCD, off = wgid / NXCD; wgid = (xcd < r ? xcd * (q + 1) : r * (q + 1) + (xcd - r) * q) + off; }
        const int nig = WGM * nN, gid = wgid / nig, fm = gid * WGM, gsz = (nM - fm) < WGM ? (nM - fm) : WGM;
        u.pm = fm + ((wgid % nig) % gsz); u.pn = (wgid % nig) / gsz; return true;
    }
};
template <class Epi>
__device__ __forceinline__ void gemm_phase(LAS unsigned char* lds, const Gemm g, const StaticOrder& S, const Epi& E) {
    int tid = threadIdx.x; asm volatile("" : "+v"(tid));
    const int wid = __builtin_amdgcn_readfirstlane(tid >> 6), lane = tid & 63, wr = wid >> 2, wc = wid & 3, fr = lane & 15, fq = lane >> 4;
    const int K = g.K, nt = K / BK;
    unsigned voffA[2], voffB[2];
#pragma unroll
    for (int i = 0; i < 2; ++i) { int R, C; stage_rc(tid * 16 + i * 8192, R, C); const int Rb = (R & ~31) + perm32(R & 31);
        voffA[i] = (unsigned)(R * g.lda + C) * 2u; voffB[i] = (unsigned)(Rb * g.ldb + C) * 2u; }
    const size_t kstep = (size_t)(BK * 2);
    const size_t hstepA = (size_t)HALF * g.lda * 2, hstepB = (size_t)HALF * g.ldb * 2;
    const long tstepA = (long)g.mstride * g.lda * 2, tstepB = (long)(2 * hstepB); const long abase0 = (long)g.arow0 * g.lda * 2;
    const unsigned ldsw = (unsigned)wid * 1024u;
    const int aoff = lds_byte(wr * 64 + fr, fq * 8), boff = lds_byte(wc * 32 + fr, fq * 8);
#define PG8_SA(b, h) (((b) * 2 + (h)) * HTB)
#define PG8_SB(b, h) ((4 + (b) * 2 + (h)) * HTB)
#define PG8_STAGE(bufoff, gbase, voff) do { _Pragma("unroll") for (int _i = 0; _i < 2; ++_i) \
        __builtin_amdgcn_global_load_lds((const unsigned*)((const char*)(gbase) + (voff)[_i]), (LAS unsigned*)(lds + (bufoff) + ldsw + _i * 8192), 16, 0, 0); } while (0)
#define PG8_LDA(dst, b, h) do { _Pragma("unroll") for (int m = 0; m < 4; ++m) _Pragma("unroll") for (int k = 0; k < 2; ++k) dst[m][k] = *(const LAS bf16x8*)(lds + PG8_SA(b, h) + aoff + m * 2048 + k * 1024); } while (0)
#define PG8_LDB(dst, b, h) do { _Pragma("unroll") for (int n = 0; n < 2; ++n) _Pragma("unroll") for (int k = 0; k < 2; ++k) dst[n][k] = *(const LAS bf16x8*)(lds + PG8_SB(b, h) + boff + n * 2048 + k * 1024); } while (0)
#define PG8_MMA(ai, bj, At, Bt) do { __builtin_amdgcn_s_setprio(1); _Pragma("unroll") for (int m = 0; m < 4; ++m) _Pragma("unroll") for (int n = 0; n < 2; ++n) _Pragma("unroll") for (int k = 0; k < 2; ++k) \
        acc[ai][bj][m][n] = __builtin_amdgcn_mfma_f32_16x16x32_bf16(Bt[n][k], At[m][k], acc[ai][bj][m][n], 0, 0, 0); __builtin_amdgcn_s_setprio(0); } while (0)
#define PG8_WAIT_V(n) asm volatile("s_waitcnt vmcnt(" #n ")" ::: "memory")
#define PG8_WAIT_L(n) asm volatile("s_waitcnt lgkmcnt(" #n ")" ::: "memory")
#define PG8_BAR __builtin_amdgcn_s_barrier()
#define PG8_SCHED __builtin_amdgcn_sched_barrier(0)
    Unit cur, nxt; int ui = 0;
    if (!S.next(0, cur)) return;
    f32x4 acc[2][2][4][2];
#pragma unroll
    for (int a = 0; a < 2; ++a)
#pragma unroll
        for (int b = 0; b < 2; ++b)
#pragma unroll
            for (int m = 0; m < 4; ++m)
#pragma unroll
                for (int n = 0; n < 2; ++n) acc[a][b][m][n] = (f32x4){0.f, 0.f, 0.f, 0.f};
    bf16x8 At[4][2], B0[2][2], B1[2][2];
    const char* cA = (const char*)g.A + abase0 + (long)cur.pm * tstepA; const char* cB = (const char*)g.Bt + (long)cur.pn * tstepB;
    PG8_STAGE(PG8_SB(0, 0), cB, voffB); PG8_STAGE(PG8_SB(0, 1), cB + hstepB, voffB); PG8_STAGE(PG8_SA(0, 0), cA, voffA); PG8_STAGE(PG8_SA(0, 1), cA + hstepA, voffA);
    if (wr == 1) PG8_BAR;
    PG8_WAIT_V(2); PG8_BAR;
    PG8_STAGE(PG8_SB(1, 0), cB + kstep, voffB); PG8_STAGE(PG8_SA(1, 0), cA + kstep, voffA); PG8_STAGE(PG8_SB(1, 1), cB + hstepB + kstep, voffB);
    PG8_WAIT_V(6); PG8_BAR;
    for (;;) {
        const bool has_next = S.next(ui + 1, nxt);
        const char* nA = has_next ? (const char*)g.A + abase0 + (long)nxt.pm * tstepA : cA; const char* nB = has_next ? (const char*)g.Bt + (long)nxt.pn * tstepB : cB;
        for (int t = 0; t < nt; t += 2) {
            const bool last = (t == nt - 2);
            const char* a1 = cA + (size_t)(t + 1) * kstep;
            const char* a2 = last ? nA : cA + (size_t)(t + 2) * kstep; const char* b2 = last ? nB : cB + (size_t)(t + 2) * kstep;
            const char* a3 = a2 + kstep; const char* b3 = b2 + kstep;
            PG8_LDB(B0, 0, 0); PG8_LDB(B1, 0, 1); PG8_SCHED; PG8_LDA(At, 0, 0); PG8_STAGE(PG8_SA(1, 1), a1 + hstepA, voffA);
            PG8_WAIT_V(8); PG8_WAIT_L(0); PG8_BAR; PG8_MMA(0, 0, At, B0); PG8_MMA(0, 1, At, B1); PG8_BAR; PG8_SCHED;
            PG8_LDA(At, 0, 1); PG8_STAGE(PG8_SB(0, 0), b2, voffB); PG8_STAGE(PG8_SB(0, 1), b2 + hstepB, voffB); PG8_STAGE(PG8_SA(0, 0), a2, voffA);
            PG8_WAIT_V(8); PG8_WAIT_L(0); PG8_BAR; PG8_MMA(1, 0, At, B0); PG8_MMA(1, 1, At, B1); PG8_BAR; PG8_SCHED;
            PG8_LDB(B0, 1, 0); PG8_LDB(B1, 1, 1); PG8_SCHED; PG8_LDA(At, 1, 0); PG8_STAGE(PG8_SA(0, 1), a2 + hstepA, voffA);
            PG8_WAIT_V(8); PG8_WAIT_L(0); PG8_BAR; PG8_MMA(0, 0, At, B0); PG8_MMA(0, 1, At, B1); PG8_BAR; PG8_SCHED;
            PG8_LDA(At, 1, 1); PG8_STAGE(PG8_SB(1, 0), b3, voffB); PG8_STAGE(PG8_SB(1, 1), b3 + hstepB, voffB); PG8_STAGE(PG8_SA(1, 0), a3, voffA);
            PG8_WAIT_V(8); PG8_WAIT_L(0); PG8_BAR; PG8_MMA(1, 0, At, B0); PG8_MMA(1, 1, At, B1); PG8_BAR; PG8_SCHED;
        }
        if (wr == 0) PG8_BAR;
        E(acc, cur, wr, wc, fr, fq);
        if (!has_next) break;
#pragma unroll
        for (int a = 0; a < 2; ++a)
#pragma unroll
            for (int b = 0; b < 2; ++b)
#pragma unroll
                for (int m = 0; m < 4; ++m)
#pragma unroll
                    for (int n = 0; n < 2; ++n) acc[a][b][m][n] = (f32x4){0.f, 0.f, 0.f, 0.f};
        cur = nxt; cA = nA; cB = nB; ++ui;
        if (wr == 1) PG8_BAR;
    }
    PG8_WAIT_V(0);
    PG8_BAR;
#undef PG8_SA
#undef PG8_SB
#undef PG8_STAGE
#undef PG8_LDA
#undef PG8_LDB
#undef PG8_MMA
#undef PG8_WAIT_V
#undef PG8_WAIT_L
#undef PG8_BAR
#undef PG8_SCHED
}

struct EpiStore {
    bf16_t* O; int ldc; int kind;
    __device__ __forceinline__ void operator()(const f32x4 (&acc)[2][2][4][2], const Unit& u, int wr, int wc, int fr, int fq) const {
        const int row0 = u.pm * BM + wr * 64 + fr, col0 = u.pn * BM + wc * 32 + 8 * fq;
        int act = 0;
        if (kind == 1) { const int pn = u.pn; act = (pn < 2 || pn == 6 || pn == 7) ? 1 : (pn >= 14 ? 2 : 0); }
#pragma unroll
        for (int ai = 0; ai < 2; ++ai)
#pragma unroll
            for (int m = 0; m < 4; ++m) { bf16_t* rowp = O + (size_t)(row0 + ai * HALF + m * 16) * ldc + col0;
#pragma unroll
                for (int bj = 0; bj < 2; ++bj) { f32x4 v0 = acc[ai][bj][m][0], v1 = acc[ai][bj][m][1];
                    if (act) {
#pragma unroll
                        for (int e = 0; e < 4; ++e) { const float s0 = fsigmoid(v0[e]), s1 = fsigmoid(v1[e]); v0[e] = (act == 1) ? v0[e] * s0 : s0; v1[e] = (act == 1) ? v1[e] * s1 : s1; }
                    }
                    u32x4 o; o.x = cvt_pk_bf16(v0[0], v0[1]); o.y = cvt_pk_bf16(v0[2], v0[3]); o.z = cvt_pk_bf16(v1[0], v1[1]); o.w = cvt_pk_bf16(v1[2], v1[3]);
                    *(u32x4*)(rowp + bj * HALF) = o; } }
    }
};
struct EpiGate {
    bf16_t* O; const bf16_t* Gt; int accum;
    __device__ __forceinline__ void operator()(const f32x4 (&acc)[2][2][4][2], const Unit& u, int wr, int wc, int fr, int fq) const {
        const int row0 = u.pm * BM + wr * 64 + fr, col0 = u.pn * BM + wc * 32 + 8 * fq;
#pragma unroll
        for (int ai = 0; ai < 2; ++ai) {
            u32x4 gv[4][2], ov[4][2];
#pragma unroll
            for (int m = 0; m < 4; ++m)
#pragma unroll
                for (int bj = 0; bj < 2; ++bj) { const size_t r = (size_t)(row0 + ai * HALF + m * 16); const int c = col0 + bj * HALF;
                    gv[m][bj] = *(const u32x4*)(Gt + r * N1 + c); ov[m][bj] = accum ? *(const u32x4*)(O + r * D + c) : (u32x4){0u, 0u, 0u, 0u}; }
#pragma unroll
            for (int m = 0; m < 4; ++m)
#pragma unroll
                for (int bj = 0; bj < 2; ++bj) { const size_t r = (size_t)(row0 + ai * HALF + m * 16); const int c = col0 + bj * HALF;
                    const u32x4 g = gv[m][bj], o0 = ov[m][bj];
                    f32x4 v0 = acc[ai][bj][m][0], v1 = acc[ai][bj][m][1];
                    v0[0] = v0[0] * bflo(g.x) + bflo(o0.x); v0[1] = v0[1] * bfhi(g.x) + bfhi(o0.x); v0[2] = v0[2] * bflo(g.y) + bflo(o0.y); v0[3] = v0[3] * bfhi(g.y) + bfhi(o0.y);
                    v1[0] = v1[0] * bflo(g.z) + bflo(o0.z); v1[1] = v1[1] * bfhi(g.z) + bfhi(o0.z); v1[2] = v1[2] * bflo(g.w) + bflo(o0.w); v1[3] = v1[3] * bfhi(g.w) + bfhi(o0.w);
                    u32x4 o; o.x = cvt_pk_bf16(v0[0], v0[1]); o.y = cvt_pk_bf16(v0[2], v0[3]); o.z = cvt_pk_bf16(v1[0], v1[1]); o.w = cvt_pk_bf16(v1[2], v1[3]);
                    *(u32x4*)(O + r * D + c) = o; }
        }
    }
};

struct EpiFfn {
    bf16_t* ACT; const float* cw; const float* stin; float* stout_p; float* stout_s; int R0, MG, l; LAS float* halo;
    __device__ __forceinline__ void operator()(const f32x4 (&acc)[2][2][4][2], const Unit& u, int wr, int wc, int fr, int fq) const {
        const int colg = u.pn * 128 + wc * 32 + 8 * fq;
        if (fr >= 14) {
#pragma unroll
            for (int ai = 0; ai < 2; ++ai) { LAS float* hp = halo + ((ai * 2 + wr) * 2 + (fr - 14)) * 128 + wc * 32 + 8 * fq; *(LAS f32x4*)hp = acc[ai][0][3][0]; *(LAS f32x4*)(hp + 4) = acc[ai][0][3][1]; }
        }
        asm volatile("s_waitcnt lgkmcnt(0)" ::: "memory"); __builtin_amdgcn_s_barrier(); asm volatile("" ::: "memory");
        const int lane = fq * 16 + fr, src1 = (lane & 48) | ((fr + 15) & 15), src2 = (lane & 48) | ((fr + 14) & 15);
#pragma unroll
        for (int n = 0; n < 2; ++n) {
            const int col = colg + 4 * n;
            const f32x4 w0 = *(const f32x4*)(cw + col), w1 = *(const f32x4*)(cw + DFF + col), w2 = *(const f32x4*)(cw + 2 * DFF + col);
#pragma unroll
            for (int ai = 0; ai < 2; ++ai)
#pragma unroll
                for (int m = 0; m < 4; ++m) {
                    const int rho = 128 * ai + 64 * wr + 16 * m + fr, Rl = u.pm * 254 - 2 + rho, R = R0 + Rl;
                    const bool valid = (rho >= 2) && (Rl < MG);
                    int t, Lq, sq; const bool smp = (R >= MP);
                    if (!smp) { t = R & (SEQ - 1); Lq = SEQ; sq = R >> 12; } else { const int Rs = R - MP; t = Rs & 15; Lq = DSEQ; sq = Rs >> 4; }
                    const f32x4 g4 = acc[ai][0][m][n];
                    const f32x4 gm = acc[ai][0][m > 0 ? m - 1 : 0][n];
                    f32x4 p1, p2;
#pragma unroll
                    for (int e = 0; e < 4; ++e) { const float s1 = (m > 0 && fr == 15) ? gm[e] : g4[e], s2 = (m > 0 && fr >= 14) ? gm[e] : g4[e]; p1[e] = dpp_rot<0x121>(s1); p2[e] = dpp_rot<0x122>(s2); }
                    if (m == 0) { const int pb = ai * 2 + wr - 1;
                        if (pb >= 0 && fr < 2) { const LAS float* h0 = halo + (pb * 2) * 128 + wc * 32 + 8 * fq + 4 * n;
                            const f32x4 x0 = *(const LAS f32x4*)h0, y0 = *(const LAS f32x4*)(h0 + 128);
                            if (fr == 0) { p1 = y0; p2 = x0; } else { p2 = y0; } } }
                    if (valid && t < 2) {
                        f32x4 s0v = (f32x4){0.f, 0.f, 0.f, 0.f}, s1v = s0v;
                        if (smp) { const float* sp = stin + (size_t)((l * 16 + sq) * 2) * DFF + col; s0v = *(const f32x4*)sp; s1v = *(const f32x4*)(sp + DFF); }
                        if (t == 0) { p1 = s1v; p2 = s0v; } else { p2 = s1v; }
                    }
                    if (valid) {
                        const f32x4 v4 = acc[ai][1][m][n];
                        float o[4];
#pragma unroll
                        for (int e = 0; e < 4; ++e) { const float y = w0[e] * p2[e] + w1[e] * p1[e] + w2[e] * g4[e]; o[e] = y * fsigmoid(y) * v4[e]; }
                        u32x2 ov; ov.x = cvt_pk_bf16(o[0], o[1]); ov.y = cvt_pk_bf16(o[2], o[3]);
                        *(u32x2*)(ACT + (size_t)Rl * DFF + col) = ov;
                        if (t >= Lq - 2) *(f32x4*)((smp ? stout_s : stout_p) + (size_t)((l * 16 + sq) * 2 + (t - (Lq - 2))) * DFF + col) = g4;
                    }
                }
        }
    }
};
}

struct Args { const float* in[24]; float* out; unsigned char* ws; };

__device__ __forceinline__ void transpose_item(const float* W, int K, int N, bf16_t* WT, int row_off, LAS float* scr, int item, int lane) {
    const int nblk = N / 32, kb = item / nblk, nb = item % nblk, k0 = 64 * kb, n0 = 32 * nb;
#pragma unroll 8
    for (int i = 0; i < 32; ++i) { const int kk = 2 * i + (lane >> 5); scr[kk * 33 + (lane & 31)] = W[(size_t)(k0 + kk) * N + n0 + (lane & 31)]; }
    asm volatile("s_waitcnt lgkmcnt(0)" ::: "memory");
    const int c = lane & 7;
#pragma unroll
    for (int j = 0; j < 4; ++j) { const int n = (lane >> 3) + 8 * j; const LAS float* s = scr + (8 * c) * 33 + n;
        u32x4 o; o.x = cvt_pk_bf16(s[0 * 33], s[1 * 33]); o.y = cvt_pk_bf16(s[2 * 33], s[3 * 33]); o.z = cvt_pk_bf16(s[4 * 33], s[5 * 33]); o.w = cvt_pk_bf16(s[6 * 33], s[7 * 33]);
        *(u32x4*)(WT + (size_t)(row_off + n0 + n) * K + k0 + 8 * c) = o; }
    asm volatile("s_waitcnt lgkmcnt(0)" ::: "memory");
}

__device__ __forceinline__ void row_pass(const bf16_t* mrow  , const float* xin, const bf16_t* xin_b, float* xout, bf16_t* xout_b, const float* gpost, const float* gate,
                                         bf16_t* hrow  , const float* gpre, const float* sc, const float* sh, int lane) {
    float xv[2][8];
    if (xin_b) {
#pragma unroll
        for (int j = 0; j < 2; ++j) { const u32x4 w = *(const u32x4*)(xin_b + 512 * j + 8 * lane);
            xv[j][0] = bflo(w.x); xv[j][1] = bfhi(w.x); xv[j][2] = bflo(w.y); xv[j][3] = bfhi(w.y); xv[j][4] = bflo(w.z); xv[j][5] = bfhi(w.z); xv[j][6] = bflo(w.w); xv[j][7] = bfhi(w.w); }
    } else {
#pragma unroll
        for (int j = 0; j < 2; ++j) { const int c0 = 512 * j + 8 * lane; const f32x4 a = *(const f32x4*)(xin + c0), b = *(const f32x4*)(xin + c0 + 4);
            xv[j][0] = a[0]; xv[j][1] = a[1]; xv[j][2] = a[2]; xv[j][3] = a[3]; xv[j][4] = b[0]; xv[j][5] = b[1]; xv[j][6] = b[2]; xv[j][7] = b[3]; }
    }
    if (mrow) {
        float mv[2][8]; float ss = 0.f;
#pragma unroll
        for (int j = 0; j < 2; ++j) { const u32x4 w = *(const u32x4*)(mrow + 512 * j + 8 * lane);
            mv[j][0] = bflo(w.x); mv[j][1] = bfhi(w.x); mv[j][2] = bflo(w.y); mv[j][3] = bfhi(w.y); mv[j][4] = bflo(w.z); mv[j][5] = bfhi(w.z); mv[j][6] = bflo(w.w); mv[j][7] = bfhi(w.w);
#pragma unroll
            for (int e = 0; e < 8; ++e) ss += mv[j][e] * mv[j][e]; }
        const float rstd = rsqrtf(wave_sum(ss) * (1.f / D) + EPS);
#pragma unroll
        for (int j = 0; j < 2; ++j) { const int c0 = 512 * j + 8 * lane;
            const f32x4 g0 = *(const f32x4*)(gpost + c0), g1 = *(const f32x4*)(gpost + c0 + 4), t0 = *(const f32x4*)(gate + c0), t1 = *(const f32x4*)(gate + c0 + 4);
#pragma unroll
            for (int e = 0; e < 4; ++e) { xv[j][e] += t0[e] * (mv[j][e] * rstd * g0[e]); xv[j][4 + e] += t1[e] * (mv[j][4 + e] * rstd * g1[e]); }
            if (xout_b) { u32x4 o; o.x = cvt_pk_bf16(xv[j][0], xv[j][1]); o.y = cvt_pk_bf16(xv[j][2], xv[j][3]); o.z = cvt_pk_bf16(xv[j][4], xv[j][5]); o.w = cvt_pk_bf16(xv[j][6], xv[j][7]); *(u32x4*)(xout_b + c0) = o;
            } else { *(f32x4*)(xout + c0) = (f32x4){xv[j][0], xv[j][1], xv[j][2], xv[j][3]}; *(f32x4*)(xout + c0 + 4) = (f32x4){xv[j][4], xv[j][5], xv[j][6], xv[j][7]}; } }
    }
    if (hrow) {
        float ss = 0.f;
#pragma unroll
        for (int j = 0; j < 2; ++j)
#pragma unroll
            for (int e = 0; e < 8; ++e) ss += xv[j][e] * xv[j][e];
        const float rstd = rsqrtf(wave_sum(ss) * (1.f / D) + EPS);
#pragma unroll
        for (int j = 0; j < 2; ++j) { const int c0 = 512 * j + 8 * lane; float hv[8];
            const f32x4 g0 = *(const f32x4*)(gpre + c0), g1 = *(const f32x4*)(gpre + c0 + 4), s0 = *(const f32x4*)(sc + c0), s1 = *(const f32x4*)(sc + c0 + 4), h0 = *(const f32x4*)(sh + c0), h1 = *(const f32x4*)(sh + c0 + 4);
#pragma unroll
            for (int e = 0; e < 4; ++e) { hv[e] = xv[j][e] * rstd * g0[e] * (1.f + s0[e]) + h0[e]; hv[4 + e] = xv[j][4 + e] * rstd * g1[e] * (1.f + s1[e]) + h1[e]; }
            u32x4 o; o.x = cvt_pk_bf16(hv[0], hv[1]); o.y = cvt_pk_bf16(hv[2], hv[3]); o.z = cvt_pk_bf16(hv[4], hv[5]); o.w = cvt_pk_bf16(hv[6], hv[7]);
            *(u32x4*)(hrow + c0) = o; }
    }
}
__device__ __forceinline__ int row_batch(int R) { return R < MP ? (R >> 12) : 16 + ((R - MP) >> 4); }

template <bool FULL>
__device__ __forceinline__ void hgrn_item(LAS unsigned char* lds, const bf16_t* P, bf16_t* AB, int L, int hd, const float* lbv, const float* anorm, const float* S0, const float* Dd, int ns, float* Sout, float* Dout) {
    int tid = threadIdx.x; asm volatile("" : "+v"(tid));
    const int w = tid >> 6, lane = tid & 63, q4 = lane >> 4, c16 = lane & 15;
    const int k = tid & 127, tq = tid >> 7;
    LAS bf16_t* Qt = (LAS bf16_t*)lds;
    LAS bf16_t* Kt = Qt + 16 * 136;
    LAS bf16_t* KhT = Kt + 16 * 136;
    LAS bf16_t* VsT = KhT + 128 * 20;
    LAS float* dvec = (LAS float*)(VsT + 128 * 20);
    LAS float* qsum = dvec + 128;
    LAS float* ssq = qsum + 512;
    const float lb = lbv[k], oml = 1.f - lb;
    const float an = FULL ? anorm[16 * w + c16] : 0.f;
    f32x4 accS[8];
#pragma unroll
    for (int mt = 0; mt < 8; ++mt) accS[mt] = (f32x4){0.f, 0.f, 0.f, 0.f};
    for (int c = 0; c < ns; ++c) { const float* sc = S0 + (size_t)c * 16384 + 16 * w + c16;
#pragma unroll
        for (int mt = 0; mt < 8; ++mt) { f32x4 d4 = (f32x4){0.f, 0.f, 0.f, 0.f}; if (Dd) d4 = *(const f32x4*)(Dd + c * 128 + 16 * mt + 4 * q4);
#pragma unroll
            for (int j = 0; j < 4; ++j) accS[mt][j] = accS[mt][j] * d4[j] + sc[(size_t)(16 * mt + 4 * q4 + j) * 128]; } }
    const bf16_t* pq = P + 128 * hd + k + (size_t)(4 * tq) * N1;
    const bf16_t* pz = pq + 512;
    const int vt = (tid >> 4) & 15, vc = tid & 15;
    const bf16_t* pv = P + 1024 + 128 * hd + 8 * vc + (size_t)vt * N1;
    const bf16_t* pg = P + 1536 + 128 * hd + 16 * w + c16 + (size_t)(4 * q4) * N1;
    bf16_t* po = AB + 128 * hd + 16 * w + c16 + (size_t)(4 * q4) * D;
    const int nsteps = L >> 4;
    float btot = 0.f;
    unsigned short zr[4], qr[4], grn[4]; u32x4 vr = (u32x4){0u, 0u, 0u, 0u};
#pragma unroll
    for (int i = 0; i < 4; ++i) { zr[i] = pz[(size_t)i * N1]; qr[i] = pq[(size_t)i * N1]; grn[i] = pg[(size_t)i * N1]; }
    if (tid < 256) vr = *(const u32x4*)pv;
    for (int n = 0; n < nsteps; ++n) {
        unsigned short zc[4], qc[4], gr[4]; const u32x4 vcur = vr;
#pragma unroll
        for (int i = 0; i < 4; ++i) { zc[i] = zr[i]; qc[i] = qr[i]; gr[i] = grn[i]; }
        const size_t roff = (size_t)(16 * n) * N1;
        {
            const size_t nro = (size_t)(16 * (n + 1 < nsteps ? n + 1 : n)) * N1;
#pragma unroll
            for (int i = 0; i < 4; ++i) { zr[i] = pz[nro + (size_t)i * N1]; qr[i] = pq[nro + (size_t)i * N1]; grn[i] = pg[nro + (size_t)i * N1]; }
            if (tid < 256) vr = *(const u32x4*)(pv + nro);
        }
        float cs[4], kk[4], qv[4];
        {
            float run = 0.f;
#pragma unroll
            for (int i = 0; i < 4; ++i) { float z = bf2f(zc[i]); z = fminf(fmaxf(z, -30.f), 30.f); const float e = __expf(-z), sg = __builtin_amdgcn_rcpf(1.f + e), sn = e * sg;
                const float f = lb + oml * sg; run += __builtin_amdgcn_logf(f) * 0.69314718056f; cs[i] = run; kk[i] = oml * sn; qv[i] = bf2f(qc[i]); }
            qsum[tq * 128 + k] = run;
        }
        __syncthreads();
        {
            float pre = 0.f, tot = 0.f;
#pragma unroll
            for (int j = 0; j < 4; ++j) { const float v = qsum[j * 128 + k]; tot += v; pre += (j < tq) ? v : 0.f; }
            btot += tot;
            float kh[4];
#pragma unroll
            for (int i = 0; i < 4; ++i) { const float b = pre + cs[i]; const float qt = qv[i] * __expf(b), kt = kk[i] * __expf(fminf(-b, 80.f)); kh[i] = kk[i] * __expf(tot - b);
                Qt[(4 * tq + i) * 136 + k] = (bf16_t)(cvt_pk_bf16(qt, 0.f) & 0xffffu); Kt[(4 * tq + i) * 136 + k] = (bf16_t)(cvt_pk_bf16(kt, 0.f) & 0xffffu); }
            u32x2 kp; kp.x = cvt_pk_bf16(kh[0], kh[1]); kp.y = cvt_pk_bf16(kh[2], kh[3]);
            *(LAS u32x2*)(KhT + k * 20 + 4 * tq) = kp;
            if (tq == 0) dvec[k] = __expf(tot);
            if (tid < 256) {
                VsT[(8 * vc + 0) * 20 + vt] = (bf16_t)(vcur.x & 0xffffu); VsT[(8 * vc + 1) * 20 + vt] = (bf16_t)(vcur.x >> 16);
                VsT[(8 * vc + 2) * 20 + vt] = (bf16_t)(vcur.y & 0xffffu); VsT[(8 * vc + 3) * 20 + vt] = (bf16_t)(vcur.y >> 16);
                VsT[(8 * vc + 4) * 20 + vt] = (bf16_t)(vcur.z & 0xffffu); VsT[(8 * vc + 5) * 20 + vt] = (bf16_t)(vcur.z >> 16);
                VsT[(8 * vc + 6) * 20 + vt] = (bf16_t)(vcur.w & 0xffffu); VsT[(8 * vc + 7) * 20 + vt] = (bf16_t)(vcur.w >> 16);
            }
        }
        __syncthreads();
        f32x4 acco = (f32x4){0.f, 0.f, 0.f, 0.f};
        {
            const u32x2 vv = *(const LAS u32x2*)(VsT + (16 * w + c16) * 20 + 4 * q4);
            const bf16x4 vf = __builtin_bit_cast(bf16x4, vv);
            if (FULL) {
            bf16x8 qf[4], kf[4];
#pragma unroll
            for (int kq = 0; kq < 4; ++kq) {
                const u32x2 a0 = *(const LAS u32x2*)(Qt + c16 * 136 + 32 * kq + 4 * q4), a1 = *(const LAS u32x2*)(Qt + c16 * 136 + 32 * kq + 16 + 4 * q4);
                const u32x2 b0 = *(const LAS u32x2*)(Kt + c16 * 136 + 32 * kq + 4 * q4), b1 = *(const LAS u32x2*)(Kt + c16 * 136 + 32 * kq + 16 + 4 * q4);
                u32x4 qa = (u32x4){a0.x, a0.y, a1.x, a1.y}, ka = (u32x4){b0.x, b0.y, b1.x, b1.y};
                qf[kq] = __builtin_bit_cast(bf16x8, qa); kf[kq] = __builtin_bit_cast(bf16x8, ka);
            }
            f32x4 accA = (f32x4){0.f, 0.f, 0.f, 0.f};
#pragma unroll
            for (int kq = 0; kq < 4; ++kq) accA = __builtin_amdgcn_mfma_f32_16x16x32_bf16(kf[kq], qf[kq], accA, 0, 0, 0);
#pragma unroll
            for (int j = 0; j < 4; ++j) accA[j] = (c16 >= 4 * q4 + j) ? accA[j] : 0.f;
            u32x2 pa; pa.x = cvt_pk_bf16(accA[0], accA[1]); pa.y = cvt_pk_bf16(accA[2], accA[3]);
            const bf16x4 pA = __builtin_bit_cast(bf16x4, pa);
            acco = __builtin_amdgcn_mfma_f32_16x16x16bf16_1k(pA, vf, (f32x4){0.f, 0.f, 0.f, 0.f}, 0, 0, 0);
#pragma unroll
            for (int kq = 0; kq < 4; ++kq) {
                u32x4 sp; sp.x = cvt_pk_bf16(accS[2 * kq][0], accS[2 * kq][1]); sp.y = cvt_pk_bf16(accS[2 * kq][2], accS[2 * kq][3]);
                sp.z = cvt_pk_bf16(accS[2 * kq + 1][0], accS[2 * kq + 1][1]); sp.w = cvt_pk_bf16(accS[2 * kq + 1][2], accS[2 * kq + 1][3]);
                acco = __builtin_amdgcn_mfma_f32_16x16x32_bf16(qf[kq], __builtin_bit_cast(bf16x8, sp), acco, 0, 0, 0);
            }
            }
#pragma unroll
            for (int mt = 0; mt < 8; ++mt) {
                const u32x2 kh2 = *(const LAS u32x2*)(KhT + (16 * mt + c16) * 20 + 4 * q4);
                const f32x4 d4 = *(const LAS f32x4*)(dvec + 16 * mt + 4 * q4);
                accS[mt] = accS[mt] * d4;
                accS[mt] = __builtin_amdgcn_mfma_f32_16x16x16bf16_1k(__builtin_bit_cast(bf16x4, kh2), vf, accS[mt], 0, 0, 0);
            }
            if (FULL) {
            const float s0 = sum16(acco[0] * acco[0]), s1 = sum16(acco[1] * acco[1]), s2 = sum16(acco[2] * acco[2]), s3 = sum16(acco[3] * acco[3]);
            if (c16 == 0) { *(LAS f32x4*)(ssq + w * 16 + 4 * q4) = (f32x4){s0, s1, s2, s3}; }
            }
        }
        if (FULL) __syncthreads();
        if (FULL) {
            f32x4 tot = (f32x4){0.f, 0.f, 0.f, 0.f};
#pragma unroll
            for (int ww = 0; ww < 8; ++ww) tot += *(const LAS f32x4*)(ssq + ww * 16 + 4 * q4);
#pragma unroll
            for (int j = 0; j < 4; ++j) { const float rstd = rsqrtf(tot[j] * (1.f / 128.f) + EPS); const float o = acco[j] * rstd * an * bf2f(gr[j]);
                po[(size_t)(16 * n + j) * D] = (bf16_t)(cvt_pk_bf16(o, 0.f) & 0xffffu); }
        }
    }
    if (Sout) {
#pragma unroll
        for (int mt = 0; mt < 8; ++mt)
#pragma unroll
            for (int j = 0; j < 4; ++j) Sout[(size_t)(16 * mt + 4 * q4 + j) * 128 + 16 * w + c16] = accS[mt][j];
    }
    if (Dout && tid < 128) Dout[tid] = __expf(btot);
    __syncthreads();
}

__device__ __forceinline__ void unpack8(const u32x4 w, float (&v)[8]) { v[0] = bflo(w.x); v[1] = bfhi(w.x); v[2] = bflo(w.y); v[3] = bfhi(w.y); v[4] = bflo(w.z); v[5] = bfhi(w.z); v[6] = bflo(w.w); v[7] = bfhi(w.w); }
__device__ __forceinline__ u32x4 pack8(const float (&v)[8]) { u32x4 o; o.x = cvt_pk_bf16(v[0], v[1]); o.y = cvt_pk_bf16(v[2], v[3]); o.z = cvt_pk_bf16(v[4], v[5]); o.w = cvt_pk_bf16(v[6], v[7]); return o; }
__device__ __forceinline__ void load8f(const float* p, float (&v)[8]) { const f32x4 a = *(const f32x4*)p, b = *(const f32x4*)(p + 4); v[0] = a[0]; v[1] = a[1]; v[2] = a[2]; v[3] = a[3]; v[4] = b[0]; v[5] = b[1]; v[6] = b[2]; v[7] = b[3]; }
__device__ __forceinline__ void store8f(float* p, const float (&v)[8]) { *(f32x4*)p = (f32x4){v[0], v[1], v[2], v[3]}; *(f32x4*)(p + 4) = (f32x4){v[4], v[5], v[6], v[7]}; }

__device__ __forceinline__ void shortconv_phase(const Args& a, int l, int R0, int MG, const bf16_t* P, bf16_t* AB, unsigned* ctr, volatile LAS unsigned* bcast) {
    const float* cw = a.in[17] + (size_t)l * 3 * BW;
    int tidc = threadIdx.x; asm volatile("" : "+v"(tidc));
    const int nconv = (MG / 8) * 64;
    for (;;) {
        __syncthreads();
        if (tidc == 0) *bcast = __hip_atomic_fetch_add(ctr, 512u, __ATOMIC_RELAXED, __HIP_MEMORY_SCOPE_AGENT);
        __syncthreads();
        const int it = (int)*bcast + tidc;
        if (it - tidc >= nconv) break;
        if (it >= nconv) continue;
        const int rb = it >> 6, ch = (it & 63) * 8, r0 = rb * 8, R = R0 + r0;
        int t0, Lq; const float* st_in = nullptr; float* st_out;
        if (R < MP) { t0 = R & (SEQ - 1); Lq = SEQ; st_out = a.out + O_SCP + (size_t)((l * 16 + (R >> 12)) * 2) * BW; }
        else { const int Rs = R - MP; t0 = Rs & 15; Lq = DSEQ; const int sq = Rs >> 4; st_in = a.in[3] + (size_t)((l * 16 + sq) * 2) * BW; st_out = a.out + O_SCS + (size_t)((l * 16 + sq) * 2) * BW; }
        float w0[8], w1[8], w2[8], p2[8], p1[8];
        load8f(cw + ch, w0); load8f(cw + BW + ch, w1); load8f(cw + 2 * BW + ch, w2);
        if (t0 == 0) {
            if (st_in) { load8f(st_in + ch, p2); load8f(st_in + BW + ch, p1); }
            else {
#pragma unroll
                for (int e = 0; e < 8; ++e) { p2[e] = 0.f; p1[e] = 0.f; } }
        } else {
            float c8[8], v8[8];
            unpack8(*(const u32x4*)(P + (size_t)(r0 - 2) * N1 + 2560 + ch), c8); unpack8(*(const u32x4*)(P + (size_t)(r0 - 2) * N1 + 3072 + ch), v8);
#pragma unroll
            for (int e = 0; e < 8; ++e) p2[e] = c8[e] * v8[e];
            unpack8(*(const u32x4*)(P + (size_t)(r0 - 1) * N1 + 2560 + ch), c8); unpack8(*(const u32x4*)(P + (size_t)(r0 - 1) * N1 + 3072 + ch), v8);
#pragma unroll
            for (int e = 0; e < 8; ++e) p1[e] = c8[e] * v8[e];
        }
#pragma unroll 2
        for (int i = 0; i < 8; ++i) {
            const bf16_t* pr = P + (size_t)(r0 + i) * N1;
            float b8[8], c8[8], v8[8], o8[8];
            unpack8(*(const u32x4*)(pr + 2048 + ch), b8); unpack8(*(const u32x4*)(pr + 2560 + ch), c8); unpack8(*(const u32x4*)(pr + 3072 + ch), v8);
#pragma unroll
            for (int e = 0; e < 8; ++e) { const float cv = c8[e] * v8[e]; o8[e] = b8[e] * (w0[e] * p2[e] + w1[e] * p1[e] + w2[e] * cv); p2[e] = p1[e]; p1[e] = cv; }
            *(u32x4*)(AB + (size_t)(r0 + i) * D + 512 + ch) = pack8(o8);
        }
        if (t0 + 8 == Lq) { store8f(st_out + ch, p2); store8f(st_out + BW + ch, p1); }
    }
}
#define XB_TMO      128
#define XB_XCNT(j)  (256  + 64 * (j))
#define XB_XSUB(j)  (1280 + 64 * (j))
#define XB_XGEN(j)  (2304 + 64 * (j))
#define XB_TOP      3328
#define XB_TOPGEN   3392
#define XCD_BAR_WORDS 3456
#define XB_SPIN_CAP (1u << 22)
__device__ __forceinline__ unsigned xb_ld(unsigned* p)              { return __hip_atomic_load(p, __ATOMIC_RELAXED, __HIP_MEMORY_SCOPE_AGENT); }
__device__ __forceinline__ unsigned xb_add(unsigned* p, unsigned v) { return __hip_atomic_fetch_add(p, v, __ATOMIC_RELAXED, __HIP_MEMORY_SCOPE_AGENT); }
__device__ __forceinline__ unsigned xb_xcc_id() { return (unsigned)__builtin_amdgcn_s_getreg((3 << 11) | 20) & 0xFu; }
#define XB_SPIN(cond, bar) do { unsigned _sp = 0; while (cond) { __builtin_amdgcn_s_sleep(1); \
    if ((++_sp & 255u) == 0u) { if (xb_ld(&(bar)[XB_TMO])) break; if (_sp > XB_SPIN_CAP) { atomicAdd(&(bar)[XB_TMO], 1u); break; } } } } while (0)
struct XcdBarrier { unsigned* bar; unsigned x; volatile LAS unsigned* st; };
__device__ __forceinline__ XcdBarrier xcd_barrier_post(unsigned* bar, volatile LAS unsigned* st) {
    XcdBarrier b; b.bar = bar; b.x = xb_xcc_id(); b.st = st;
    if (threadIdx.x == 0) (void)xb_add(&bar[XB_XCNT(b.x)], 1u);
    return b;
}
__device__ __forceinline__ void xcd_barrier_complete(unsigned* bar, unsigned x, unsigned& nloc, unsigned& nx) {
    const unsigned G = gridDim.x * gridDim.y * gridDim.z;
    unsigned sum, cnt, mine, sp = 0u;
    for (;;) {
        sum = 0u; cnt = 0u; mine = 0u;
#pragma unroll
        for (unsigned j = 0; j < 16; ++j) { const unsigned c = xb_ld(&bar[XB_XCNT(j)]); sum += c; cnt += (c > 0u) ? 1u : 0u; mine = (j == x) ? c : mine; }
        if (sum == G) break;
        __builtin_amdgcn_s_sleep(1);
        if ((++sp & 255u) == 0u) { if (xb_ld(&bar[XB_TMO])) break; if (sp > XB_SPIN_CAP) { atomicAdd(&bar[XB_TMO], 1u); break; } }
    }
    nloc = mine > 0u ? mine : 1u; nx = cnt > 0u ? cnt : 1u;
}
__device__ __forceinline__ void xcd_barrier(const XcdBarrier& b) {
    asm volatile("s_waitcnt vmcnt(0) lgkmcnt(0)" ::: "memory");
    __syncthreads();
    if (threadIdx.x == 0) {
        unsigned* bar = b.bar;
        __builtin_amdgcn_s_waitcnt(0);
        unsigned nloc = b.st[0], nx = b.st[1];
        if (nloc == 0u) { xcd_barrier_complete(bar, b.x, nloc, nx); b.st[0] = nloc; b.st[1] = nx; }
        const unsigned old = xb_add(&bar[XB_XSUB(b.x)], 1u);
        const unsigned gen = old / nloc;
        if (old + 1u == (gen + 1u) * nloc) {
            __builtin_amdgcn_fence(__ATOMIC_RELEASE, "agent");
            asm volatile("s_waitcnt vmcnt(0)" ::: "memory");
            const unsigned og = xb_add(&bar[XB_TOP], 1u);
            const unsigned tg = og / nx;
            if (og + 1u == (tg + 1u) * nx) xb_add(&bar[XB_TOPGEN], 1u);
            else XB_SPIN(xb_ld(&bar[XB_TOPGEN]) == tg, bar);
            __builtin_amdgcn_fence(__ATOMIC_ACQUIRE, "agent");
            xb_add(&bar[XB_XGEN(b.x)], 1u);
            asm volatile("s_waitcnt vmcnt(0)" ::: "memory");
        } else {
            XB_SPIN(xb_ld(&bar[XB_XGEN(b.x)]) == gen, bar);
            __builtin_amdgcn_fence(__ATOMIC_ACQUIRE, "agent");
            asm volatile("s_waitcnt vmcnt(0)" ::: "memory");
        }
    }
    __syncthreads();
}

#define GSYNC_CG() do { asm volatile("s_waitcnt vmcnt(0) lgkmcnt(0)" ::: "memory"); grid.sync(); } while (0)
#define GSYNC() xcd_barrier(xbar)
__global__ void __launch_bounds__(512, 2) fwd_megakernel(Args a) {
    extern __shared__ __attribute__((aligned(16))) unsigned char lds_raw[];
    LAS unsigned char* lds = (LAS unsigned char*)lds_raw;
    cg::grid_group grid = cg::this_grid();
    const int tid = threadIdx.x, lane = tid & 63, wave = __builtin_amdgcn_readfirstlane(tid >> 6);
    const int G = gridDim.x, wg = blockIdx.x;
    unsigned char* ws = a.ws;
    volatile LAS unsigned* MISC = (volatile LAS unsigned*)(lds + 131072 + 320);
    if (tid < 32) MISC[tid] = 0u;
    __syncthreads();
    const XcdBarrier xbar = xcd_barrier_post((unsigned*)ws + 4096, MISC + 8);
    float* ADA = (float*)(ws + WS_ADA);
    float* LB = (float*)(ws + WS_LB);
    bf16_t* Hb = (bf16_t*)(ws + WS_H);
    bf16_t* ABb = (bf16_t*)(ws + WS_AB);
    bf16_t* Pb = (bf16_t*)(ws + WS_P);
    bf16_t* ACTb = (bf16_t*)(ws + WS_ACT);
    bf16_t* XBb = (bf16_t*)(ws + WS_XB);

    if (wg < 192) {
        LAS float* csT = (LAS float*)lds;
        for (int i = tid; i < 32 * 1024; i += 512) { const int b = i >> 10, kx = i & 1023; const float c = (b < 16) ? a.in[5][(size_t)b * D + kx] : a.in[6][(size_t)(b - 16) * D + kx]; csT[kx * 32 + b] = c * fsigmoid(c); }
        __syncthreads();
        const int cc = tid & 127, kq = tid >> 7;
        const int col = wg * 128 + cc;
        const int l = col / 6144, n = col - l * 6144;
        const float* wp = a.in[7] + (size_t)l * D * 6144 + n;
        float acc[32];
#pragma unroll
        for (int b = 0; b < 32; ++b) acc[b] = 0.f;
#pragma unroll 4
        for (int kx = 256 * kq; kx < 256 * kq + 256; ++kx) { const float wv = wp[(size_t)kx * 6144];
#pragma unroll
            for (int b4 = 0; b4 < 8; ++b4) { const f32x4 c4 = *(const LAS f32x4*)(csT + kx * 32 + 4 * b4); acc[4 * b4] += c4[0] * wv; acc[4 * b4 + 1] += c4[1] * wv; acc[4 * b4 + 2] += c4[2] * wv; acc[4 * b4 + 3] += c4[3] * wv; } }
        __syncthreads();
        LAS float* red = (LAS float*)lds;
#pragma unroll
        for (int b = 0; b < 32; ++b) red[(kq * 32 + b) * 128 + cc] = acc[b];
        __syncthreads();
#pragma unroll
        for (int i = 0; i < 8; ++i) { const int o = tid + 512 * i, b = o >> 7, c2 = o & 127; const int col2 = wg * 128 + c2, n2 = col2 - l * 6144;
            const float v = red[(0 * 32 + b) * 128 + c2] + red[(1 * 32 + b) * 128 + c2] + red[(2 * 32 + b) * 128 + c2] + red[(3 * 32 + b) * 128 + c2];
            ADA[((size_t)l * 32 + b) * 6144 + n2] = v + a.in[8][(size_t)l * 6144 + n2]; }
        __syncthreads();
    }
    if (wg == 192) {
        const float x0 = a.in[14][tid], x1 = a.in[14][512 + tid], x2 = a.in[14][1024 + tid], x3 = a.in[14][1536 + tid];
        const float mx = fmaxf(fmaxf(x0, x1), fmaxf(x2, x3));
        const float e0 = __expf(x0 - mx), e1 = __expf(x1 - mx), e2 = __expf(x2 - mx), e3 = __expf(x3 - mx), inv = 1.f / (e0 + e1 + e2 + e3);
        LB[tid] = 0.f; LB[512 + tid] = e1 * inv; LB[1024 + tid] = (e1 + e2) * inv; LB[1536 + tid] = (e1 + e2 + e3) * inv;
    }
    {
        LAS float* scr = (LAS float*)(lds + wave * 16384);
        const int gw = wg * 8 + wave, NGW = G * 8;
        constexpr int I_IN = 16 * (NIN / 32), I_BG = 16 * (2048 / 32), I_PA = 8 * 32, I_PB = 8 * 32, I_O = 16 * 32, I_UP = 16 * (NUP / 32), I_DN = (DFF / 64) * 32;
        constexpr int I_LAYER = I_IN + I_BG + I_PA + I_PB + I_O + I_UP + I_DN;
        for (int it = gw; it < 4 * I_LAYER; it += NGW) {
            const int l = it / I_LAYER; int r = it - l * I_LAYER;
            bf16_t* wl = (bf16_t*)(ws + WS_W + (size_t)l * LAYER_W);
            if (r < I_IN) { transpose_item(a.in[13] + (size_t)l * D * NIN, D, NIN, wl + W1_OFF / 2, 0, scr, r, lane); continue; } r -= I_IN;
            if (r < I_BG) { transpose_item(a.in[19] + (size_t)l * D * 2048, D, 2048, wl + W1_OFF / 2, NIN, scr, r, lane); continue; } r -= I_BG;
            if (r < I_PA) { transpose_item(a.in[16] + (size_t)l * AW * D, AW, D, wl + WPA_OFF / 2, 0, scr, r, lane); continue; } r -= I_PA;
            if (r < I_PB) { transpose_item(a.in[18] + (size_t)l * BW * D, BW, D, wl + WPB_OFF / 2, 0, scr, r, lane); continue; } r -= I_PB;
            if (r < I_O) { transpose_item(a.in[20] + (size_t)l * D * D, D, D, wl + WO_OFF / 2, 0, scr, r, lane); continue; } r -= I_O;
            if (r < I_UP) { const int n0 = 32 * (r % (NUP / 32));
                const int jj = n0 < DFF ? n0 : n0 - DFF, rowb = 256 * (jj >> 7) + (n0 < DFF ? 0 : 128) + (jj & 127);
                transpose_item(a.in[21] + (size_t)l * D * NUP, D, NUP, wl + WUP_OFF / 2, rowb - n0, scr, r, lane); continue; } r -= I_UP;
            transpose_item(a.in[23] + (size_t)l * DFF * D, DFF, D, wl + WDN_OFF / 2, 0, scr, r, lane);
        }
    }
    GSYNC_CG();

    for (int grp = 0; grp < 2; ++grp) {
        const int R0 = grp ? MG0 : 0, MG = grp ? MG1 : MG0, nM = MG / 256;
        int tid = threadIdx.x; asm volatile("" : "+v"(tid));
        const int lane = tid & 63, wave = __builtin_amdgcn_readfirstlane(tid >> 6);
        for (int r = wg * 8 + wave; r < MG; r += G * 8) {
            const int R = R0 + r; const float* xin = (R < MP) ? a.in[0] + (size_t)R * D : a.in[1] + (size_t)(R - MP) * D;
            const float* ad = ADA + (size_t)row_batch(R) * 6144;
            row_pass(nullptr, xin, nullptr, nullptr, nullptr, nullptr, nullptr, Hb + (size_t)r * D, a.in[9], ad + 1024, ad, lane);
        }
        GSYNC();
        for (int l = 0; l < DEPTH; ++l) {
            int tid = threadIdx.x; asm volatile("" : "+v"(tid));
            const int lane = tid & 63, wave = __builtin_amdgcn_readfirstlane(tid >> 6);
            const bf16_t* wl = (const bf16_t*)(ws + WS_W + (size_t)l * LAYER_W);
            { pg8::Gemm g{Hb, wl + W1_OFF / 2, D, D, D}; pg8::StaticOrder S; S.init(nM, N1 / 256, G, wg); pg8::EpiStore E{Pb, N1, 1}; pg8::gemm_phase(lds, g, S, E); }
            GSYNC();
            {
                int tidb = threadIdx.x; asm volatile("" : "+v"(tidb));
                const int chain = wg >> 3, chunk = wg & 7, sqg = chain >> 2, hd = chain & 3;
                const int lrow = sqg * SEQ + chunk * 512;
                float* DS = (float*)(ws + WS_DS) + (size_t)(chain * 8) * 16384;
                float* DD = (float*)(ws + WS_DD) + (size_t)(chain * 8) * 128;
                float* SS = (float*)(ws + WS_SS) + (size_t)wg * 16384;
                const float* lbv = LB + l * 512 + hd * 128;
                const float* anv = a.in[15] + l * 128;
                if (wg < 256 && chunk < 7)
                    hgrn_item<false>(lds, Pb + (size_t)lrow * N1, ABb + (size_t)lrow * D, 512, hd, lbv, anv, nullptr, nullptr, 0, DS + (size_t)chunk * 16384, DD + chunk * 128);
                shortconv_phase(a, l, R0, MG, Pb, ABb, (unsigned*)ws + 1024 + 64 * (grp * 4 + l), MISC + 16);
                GSYNC();
                if (wg < 256)
                    hgrn_item<true>(lds, Pb + (size_t)lrow * N1, ABb + (size_t)lrow * D, 512, hd, lbv, anv, DS, DD, chunk,
                              chunk == 7 ? a.out + O_SHP + (size_t)((l * 16 + 8 * grp + sqg) * 4 + hd) * 16384 : nullptr, nullptr);
                if (grp == 1 && wg < 64) {
                    const int sq = wg >> 2, hs = wg & 3; const int srow = MG0 + sq * DSEQ;
                    hgrn_item<true>(lds, Pb + (size_t)srow * N1, ABb + (size_t)srow * D, DSEQ, hs, LB + l * 512 + hs * 128, anv,
                              a.in[2] + (size_t)((l * 16 + sq) * 4 + hs) * 16384, nullptr, 1, a.out + O_SHS + (size_t)((l * 16 + sq) * 4 + hs) * 16384, nullptr);
                }
            }
            GSYNC();
            { pg8::Gemm g{ABb, wl + WPA_OFF / 2, D, AW, AW}; pg8::StaticOrder S; S.init(nM, D / 256, G, wg); pg8::EpiGate E{Hb, Pb + NIN, 0}; pg8::gemm_phase(lds, g, S, E); }
            { pg8::Gemm g{ABb + AW, wl + WPB_OFF / 2, D, BW, BW}; pg8::StaticOrder S; S.init(nM, D / 256, G, wg); pg8::EpiGate E{Hb, Pb + NIN + D, 1}; pg8::gemm_phase(lds, g, S, E); }
            GSYNC();
            { pg8::Gemm g{Hb, wl + WO_OFF / 2, D, D, D}; pg8::StaticOrder S; S.init(nM, D / 256, G, wg); pg8::EpiStore E{ABb, D, 0}; pg8::gemm_phase(lds, g, S, E); }
            GSYNC();
            for (int r = wg * 8 + wave; r < MG; r += G * 8) {
                const int R = R0 + r; const float* xin = (R < MP) ? a.in[0] + (size_t)R * D : a.in[1] + (size_t)(R - MP) * D;
                const float* ad = ADA + ((size_t)l * 32 + row_batch(R)) * 6144;
                row_pass(ABb + (size_t)r * D, xin, (l == 0) ? nullptr : XBb + (size_t)r * D, nullptr, XBb + (size_t)r * D, a.in[10] + l * D, ad + 2048, Hb + (size_t)r * D, a.in[11] + l * D, ad + 4096, ad + 3072, lane);
            }
            GSYNC();
            { pg8::Gemm g{Hb, wl + WUP_OFF / 2, D, D, D, 254, -2}; pg8::StaticOrder S; S.init((MG + 253) / 254, NUP / 256, G, wg);
              pg8::EpiFfn E{ACTb, a.in[22] + (size_t)l * 3 * DFF, a.in[4], a.out + O_SFP, a.out + O_SFS, R0, MG, l, (LAS float*)(lds + 131072 + 1024)};
              pg8::gemm_phase(lds, g, S, E); }
            GSYNC();
            { pg8::Gemm g{ACTb, wl + WDN_OFF / 2, DFF, DFF, DFF}; pg8::StaticOrder S; S.init(nM, D / 256, G, wg); pg8::EpiStore E{ABb, D, 0}; pg8::gemm_phase(lds, g, S, E); }
            GSYNC();
            for (int r = wg * 8 + wave; r < MG; r += G * 8) {
                const int R = R0 + r;
                const float* ad = ADA + ((size_t)l * 32 + row_batch(R)) * 6144;
                const float* adn = ADA + ((size_t)(l + 1 < DEPTH ? l + 1 : l) * 32 + row_batch(R)) * 6144;
                row_pass(ABb + (size_t)r * D, nullptr, XBb + (size_t)r * D, a.out + (size_t)R * D, (l + 1 < DEPTH) ? XBb + (size_t)r * D : nullptr, a.in[12] + l * D, ad + 5120, (l + 1 < DEPTH) ? Hb + (size_t)r * D : nullptr,
                         a.in[9] + (l + 1 < DEPTH ? l + 1 : l) * D, adn + 1024, adn, lane);
            }
            GSYNC();
        }
    }
}

extern "C" void kernel_launch(void* const* d_in, const int* in_sizes, int n_in, void* d_out, int out_size, void* d_ws, size_t ws_size, hipStream_t stream) {
    static int grid = 0;
    if (grid == 0) {
        if (n_in != 24 || ws_size < WS_END) { fprintf(stderr, "kernel_launch: unexpected n_in %d / ws_size %zu (need %zu)\n", n_in, ws_size, (size_t)WS_END); grid = -1; return; }
        int dev = 0, cus = 0, per_cu = 0;
        hipGetDevice(&dev);
        hipDeviceGetAttribute(&cus, hipDeviceAttributeMultiprocessorCount, dev);
        if (hipFuncSetAttribute((const void*)fwd_megakernel, hipFuncAttributeMaxDynamicSharedMemorySize, LDS_BYTES) != hipSuccess) { fprintf(stderr, "kernel_launch: hipFuncSetAttribute failed\n"); }
        if (hipOccupancyMaxActiveBlocksPerMultiprocessor(&per_cu, (const void*)fwd_megakernel, 512, LDS_BYTES) != hipSuccess || per_cu < 1) { fprintf(stderr, "kernel_launch: occupancy query says %d\n", per_cu); per_cu = 1; }
        (void)hipGetLastError();
        grid = cus;
    }
    if (grid < 0) return;
    if (hipMemsetAsync(d_ws, 0, 65536, stream) != hipSuccess) { fprintf(stderr, "kernel_launch: hipMemsetAsync failed\n"); return; }
    Args a{};
    for (int i = 0; i < 24; ++i) a.in[i] = (const float*)d_in[i];
    a.out = (float*)d_out; a.ws = (unsigned char*)d_ws;
    void* args[] = {&a};
    hipError_t e = hipLaunchCooperativeKernel((const void*)fwd_megakernel, dim3(grid), dim3(512), args, LDS_BYTES, stream);
    if (e != hipSuccess) fprintf(stderr, "kernel_launch: cooperative launch failed: %s (grid %d)\n", hipGetErrorString(e), grid);
}
```

```cpp
#include <hip/hip_runtime.h>
#include <hip/hip_cooperative_groups.h>
#include <cstdio>
#include <cstdint>
namespace cg = cooperative_groups;

#define LAS __attribute__((address_space(3)))
typedef unsigned short bf16_t;
typedef short bf16x8 __attribute__((ext_vector_type(8)));
typedef short bf16x4 __attribute__((ext_vector_type(4)));
typedef float f32x4 __attribute__((ext_vector_type(4)));
typedef unsigned u32x4 __attribute__((ext_vector_type(4)));
typedef unsigned u32x2 __attribute__((ext_vector_type(2)));

constexpr int D = 1024, SEQ = 4096, NBATCH = 16, DEPTH = 4, DSEQ = 16;
constexpr int AW = 512, BW = 512, DFF = 2816, NIN = 3584, N1 = 5632, NUP = 5632;
constexpr int MP = NBATCH * SEQ;
constexpr int MS = NBATCH * DSEQ;
constexpr int MG0 = 32768, MG1 = 33024, MGMAX = 33024;
constexpr float EPS = 1e-6f;
constexpr size_t O_YP = 0, O_YS = 67108864, O_SHP = 67371008, O_SCP = 71565312, O_SFP = 71630848, O_SHS = 71991296, O_SCS = 76185600, O_SFS = 76251136;
constexpr size_t MiB = 1u << 20;
constexpr size_t WS_ADA = 1 * MiB;
constexpr size_t WS_LB = 5 * MiB;
constexpr size_t WS_W = 8 * MiB;
constexpr size_t W1_OFF = 0, WPA_OFF = (size_t)N1 * D * 2, WPB_OFF = WPA_OFF + (size_t)D * AW * 2, WO_OFF = WPB_OFF + (size_t)D * BW * 2,
                 WUP_OFF = WO_OFF + (size_t)D * D * 2, WDN_OFF = WUP_OFF + (size_t)NUP * D * 2, LAYER_W = WDN_OFF + (size_t)D * DFF * 2;
constexpr size_t WS_H = 136 * MiB;
constexpr size_t WS_AB = 202 * MiB;
constexpr size_t WS_P = 268 * MiB;
constexpr size_t WS_ACT = 624 * MiB;
constexpr size_t WS_DS = 804 * MiB;
constexpr size_t WS_DD = 822 * MiB;
constexpr size_t WS_SS = 824 * MiB;
constexpr size_t WS_DUMMY = 840 * MiB;
constexpr size_t WS_XB = 842 * MiB;
constexpr size_t WS_END = 908 * MiB;
static_assert(WS_W + 4 * LAYER_W <= WS_H && WS_H + (size_t)MGMAX * D * 2 <= WS_AB && WS_AB + (size_t)MGMAX * D * 2 <= WS_P && WS_P + (size_t)MGMAX * N1 * 2 <= WS_ACT && WS_ACT + (size_t)MGMAX * DFF * 2 <= WS_DS && WS_DS + (size_t)32 * 8 * 16384 * 4 <= WS_DD, "ws map");
constexpr int LDS_BYTES = 147456;

__device__ __forceinline__ unsigned cvt_pk_bf16(float lo, float hi) { unsigned r; asm volatile("v_cvt_pk_bf16_f32 %0, %1, %2" : "=v"(r) : "v"(lo), "v"(hi)); return r; }
__device__ __forceinline__ float bf2f(unsigned short b) { return __uint_as_float(((unsigned)b) << 16); }
__device__ __forceinline__ float bflo(unsigned w) { return __uint_as_float(w << 16); }
__device__ __forceinline__ float bfhi(unsigned w) { return __uint_as_float(w & 0xffff0000u); }
__device__ __forceinline__ float fsigmoid(float x) { return __builtin_amdgcn_rcpf(1.f + __expf(-x)); }
template <int CTRL> __device__ __forceinline__ float dpp_rot(float v) { return __builtin_bit_cast(float, __builtin_amdgcn_update_dpp(0, __builtin_bit_cast(int, v), CTRL, 0xf, 0xf, true)); }
__device__ __forceinline__ float sum16(float x) { x += dpp_rot<0x128>(x); x += dpp_rot<0x124>(x); x += dpp_rot<0x122>(x); x += dpp_rot<0x121>(x); return x; }
__device__ __forceinline__ float wave_sum(float v) { v = sum16(v); v += __shfl_xor(v, 16); v += __shfl_xor(v, 32); return v; }

namespace pg8 {
constexpr int BM = 256, BK = 64, HALF = 128, HTB = HALF * BK * 2, STAGE_BYTES = 8 * HTB, NXCD = 8, WGM = 8;
__host__ __device__ __forceinline__ int lds_byte(int r, int c) { const int st = (r >> 4) * 2 + (c >> 5), rr = r & 15, cc = c & 31, ob = rr * 64 + cc * 2; return st * 1024 + (ob ^ (((ob >> 9) & 1) << 5)); }
__host__ __device__ __forceinline__ void stage_rc(int b, int& R, int& C) { const int st = b / 1024, sb = b % 1024, swz = sb ^ (((sb >> 9) & 1) << 5); R = (st >> 1) * 16 + swz / 64; C = (st & 1) * 32 + (swz % 64) / 2; }
__host__ __device__ __forceinline__ int perm32(int rho) { const int n = rho >> 4, i = rho & 15; return 8 * (i >> 2) + 4 * n + (i & 3); }
struct Unit { int pm, pn; };
struct Gemm { const bf16_t* A; const bf16_t* Bt; int lda, ldb, K; int mstride = 256; int arow0 = 0; };
struct StaticOrder {
    int nM, nN, nwg, G, c;
    __device__ void init(int nM_, int nN_, int G_, int c_) { nM = nM_; nN = nN_; nwg = nM * nN; G = G_; c = c_; }
    __device__ bool next(int i, Unit& u) const {
        const long L = (long)i * G + c; if (L >= nwg) return false;
        int wgid = (int)L; { const int q = nwg / NXCD, r = nwg % NXCD, xcd = wgid % NXCD, off = wgid / NXCD; wgid = (xcd < r ? xcd * (q + 1) : r * (q + 1) + (xcd - r) * q) + off; }
        const int nig = WGM * nN, gid = wgid / nig, fm = gid * WGM, gsz = (nM - fm) < WGM ? (nM - fm) : WGM;
        u.pm = fm + ((wgid % nig) % gsz); u.pn = (wgid % nig) / gsz; return true;
    }
};
template <class Epi>
__device__ __forceinline__ void gemm_phase(LAS unsigned char* lds, const Gemm g, const StaticOrder& S, const Epi& E) {
    int tid = threadIdx.x; asm volatile("" : "+v"(tid));
    const int wid = __builtin_amdgcn_readfirstlane(tid >> 6), lane = tid & 63, wr = wid >> 2, wc = wid & 3, fr = lane & 15, fq = lane >> 4;
    const int K = g.K, nt = K / BK;
    unsigned voffA[2], voffB[2];
#pragma unroll
    for (int i = 0; i < 2; ++i) { int R, C; stage_rc(tid * 16 + i * 8192, R, C); const int Rb = (R & ~31) + perm32(R & 31);
        voffA[i] = (unsigned)(R * g.lda + C) * 2u; voffB[i] = (unsigned)(Rb * g.ldb + C) * 2u; }
    const size_t kstep = (size_t)(BK * 2);
    const size_t hstepA = (size_t)HALF * g.lda * 2, hstepB = (size_t)HALF * g.ldb * 2;
    const long tstepA = (long)g.mstride * g.lda * 2, tstepB = (long)(2 * hstepB); const long abase0 = (long)g.arow0 * g.lda * 2;
    const unsigned ldsw = (unsigned)wid * 1024u;
    const int aoff = lds_byte(wr * 64 + fr, fq * 8), boff = lds_byte(wc * 32 + fr, fq * 8);
#define PG8_SA(b, h) (((b) * 2 + (h)) * HTB)
#define PG8_SB(b, h) ((4 + (b) * 2 + (h)) * HTB)
#define PG8_STAGE(bufoff, gbase, voff) do { _Pragma("unroll") for (int _i = 0; _i < 2; ++_i) \
        __builtin_amdgcn_global_load_lds((const unsigned*)((const char*)(gbase) + (voff)[_i]), (LAS unsigned*)(lds + (bufoff) + ldsw + _i * 8192), 16, 0, 0); } while (0)
#define PG8_LDA(dst, b, h) do { _Pragma("unroll") for (int m = 0; m < 4; ++m) _Pragma("unroll") for (int k = 0; k < 2; ++k) dst[m][k] = *(const LAS bf16x8*)(lds + PG8_SA(b, h) + aoff + m * 2048 + k * 1024); } while (0)
#define PG8_LDB(dst, b, h) do { _Pragma("unroll") for (int n = 0; n < 2; ++n) _Pragma("unroll") for (int k = 0; k < 2; ++k) dst[n][k] = *(const LAS bf16x8*)(lds + PG8_SB(b, h) + boff + n * 2048 + k * 1024); } while (0)
#define PG8_MMA(ai, bj, At, Bt) do { __builtin_amdgcn_s_setprio(1); _Pragma("unroll") for (int m = 0; m < 4; ++m) _Pragma("unroll") for (int n = 0; n < 2; ++n) _Pragma("unroll") for (int k = 0; k < 2; ++k) \
        acc[ai][bj][m][n] = __builtin_amdgcn_mfma_f32_16x16x32_bf16(Bt[n][k], At[m][k], acc[ai][bj][m][n], 0, 0, 0); __builtin_amdgcn_s_setprio(0); } while (0)
#define PG8_WAIT_V(n) asm volatile("s_waitcnt vmcnt(" #n ")" ::: "memory")
#define PG8_WAIT_L(n) asm volatile("s_waitcnt lgkmcnt(" #n ")" ::: "memory")
#define PG8_BAR __builtin_amdgcn_s_barrier()
#define PG8_SCHED __builtin_amdgcn_sched_barrier(0)
    Unit cur, nxt; int ui = 0;
    if (!S.next(0, cur)) return;
    f32x4 acc[2][2][4][2];
#pragma unroll
    for (int a = 0; a < 2; ++a)
#pragma unroll
        for (int b = 0; b < 2; ++b)
#pragma unroll
            for (int m = 0; m < 4; ++m)
#pragma unroll
                for (int n = 0; n < 2; ++n) acc[a][b][m][n] = (f32x4){0.f, 0.f, 0.f, 0.f};
    bf16x8 At[4][2], B0[2][2], B1[2][2];
    const char* cA = (const char*)g.A + abase0 + (long)cur.pm * tstepA; const char* cB = (const char*)g.Bt + (long)cur.pn * tstepB;
    PG8_STAGE(PG8_SB(0, 0), cB, voffB); PG8_STAGE(PG8_SB(0, 1), cB + hstepB, voffB); PG8_STAGE(PG8_SA(0, 0), cA, voffA); PG8_STAGE(PG8_SA(0, 1), cA + hstepA, voffA);
    if (wr == 1) PG8_BAR;
    PG8_WAIT_V(2); PG8_BAR;
    PG8_STAGE(PG8_SB(1, 0), cB + kstep, voffB); PG8_STAGE(PG8_SA(1, 0), cA + kstep, voffA); PG8_STAGE(PG8_SB(1, 1), cB + hstepB + kstep, voffB);
    PG8_WAIT_V(6); PG8_BAR;
    for (;;) {
        const bool has_next = S.next(ui + 1, nxt);
        const char* nA = has_next ? (const char*)g.A + abase0 + (long)nxt.pm * tstepA : cA; const char* nB = has_next ? (const char*)g.Bt + (long)nxt.pn * tstepB : cB;
        for (int t = 0; t < nt; t += 2) {
            const bool last = (t == nt - 2);
            const char* a1 = cA + (size_t)(t + 1) * kstep;
            const char* a2 = last ? nA : cA + (size_t)(t + 2) * kstep; const char* b2 = last ? nB : cB + (size_t)(t + 2) * kstep;
            const char* a3 = a2 + kstep; const char* b3 = b2 + kstep;
            PG8_LDB(B0, 0, 0); PG8_LDB(B1, 0, 1); PG8_SCHED; PG8_LDA(At, 0, 0); PG8_STAGE(PG8_SA(1, 1), a1 + hstepA, voffA);
            PG8_WAIT_V(8); PG8_WAIT_L(0); PG8_BAR; PG8_MMA(0, 0, At, B0); PG8_MMA(0, 1, At, B1); PG8_BAR; PG8_SCHED;
            PG8_LDA(At, 0, 1); PG8_STAGE(PG8_SB(0, 0), b2, voffB); PG8_STAGE(PG8_SB(0, 1), b2 + hstepB, voffB); PG8_STAGE(PG8_SA(0, 0), a2, voffA);
            PG8_WAIT_V(8); PG8_WAIT_L(0); PG8_BAR; PG8_MMA(1, 0, At, B0); PG8_MMA(1, 1, At, B1); PG8_BAR; PG8_SCHED;
            PG8_LDB(B0, 1, 0); PG8_LDB(B1, 1, 1); PG8_SCHED; PG8_LDA(At, 1, 0); PG8_STAGE(PG8_SA(0, 1), a2 + hstepA, voffA);
            PG8_WAIT_V(8); PG8_WAIT_L(0); PG8_BAR; PG8_MMA(0, 0, At, B0); PG8_MMA(0, 1, At, B1); PG8_BAR; PG8_SCHED;
            PG8_LDA(At, 1, 1); PG8_STAGE(PG8_SB(1, 0), b3, voffB); PG8_STAGE(PG8_SB(1, 1), b3 + hstepB, voffB); PG8_STAGE(PG8_SA(1, 0), a3, voffA);
            PG8_WAIT_V(8); PG8_WAIT_L(0); PG8_BAR; PG8_MMA(1, 0, At, B0); PG8_MMA(1, 1, At, B1); PG8_BAR; PG8_SCHED;
        }
        if (wr == 0) PG8_BAR;
        E(acc, cur, wr, wc, fr, fq);
        if (!has_next) break;
#pragma unroll
        for (int a = 0; a < 2; ++a)
#pragma unroll
            for (int b = 0; b < 2; ++b)
#pragma unroll
                for (int m = 0; m < 4; ++m)
#pragma unroll
                    for (int n = 0; n < 2; ++n) acc[a][b][m][n] = (f32x4){0.f, 0.f, 0.f, 0.f};
        cur = nxt; cA = nA; cB = nB; ++ui;
        if (wr == 1) PG8_BAR;
    }
    PG8_WAIT_V(0);
    PG8_BAR;
#undef PG8_SA
#undef PG8_SB
#undef PG8_STAGE
#undef PG8_LDA
#undef PG8_LDB
#undef PG8_MMA
#undef PG8_WAIT_V
#undef PG8_WAIT_L
#undef PG8_BAR
#undef PG8_SCHED
}

struct EpiStore {
    bf16_t* O; int ldc; int kind;
    __device__ __forceinline__ void operator()(const f32x4 (&acc)[2][2][4][2], const Unit& u, int wr, int wc, int fr, int fq) const {
        const int row0 = u.pm * BM + wr * 64 + fr, col0 = u.pn * BM + wc * 32 + 8 * fq;
        int act = 0;
        if (kind == 1) { const int pn = u.pn; act = (pn < 2 || pn == 6 || pn == 7) ? 1 : (pn >= 14 ? 2 : 0); }
#pragma unroll
        for (int ai = 0; ai < 2; ++ai)
#pragma unroll
            for (int m = 0; m < 4; ++m) { bf16_t* rowp = O + (size_t)(row0 + ai * HALF + m * 16) * ldc + col0;
#pragma unroll
                for (int bj = 0; bj < 2; ++bj) { f32x4 v0 = acc[ai][bj][m][0], v1 = acc[ai][bj][m][1];
                    if (act) {
#pragma unroll
                        for (int e = 0; e < 4; ++e) { const float s0 = fsigmoid(v0[e]), s1 = fsigmoid(v1[e]); v0[e] = (act == 1) ? v0[e] * s0 : s0; v1[e] = (act == 1) ? v1[e] * s1 : s1; }
                    }
                    u32x4 o; o.x = cvt_pk_bf16(v0[0], v0[1]); o.y = cvt_pk_bf16(v0[2], v0[3]); o.z = cvt_pk_bf16(v1[0], v1[1]); o.w = cvt_pk_bf16(v1[2], v1[3]);
                    *(u32x4*)(rowp + bj * HALF) = o; } }
    }
};
struct EpiGate {
    bf16_t* O; const bf16_t* Gt; int accum;
    __device__ __forceinline__ void operator()(const f32x4 (&acc)[2][2][4][2], const Unit& u, int wr, int wc, int fr, int fq) const {
        const int row0 = u.pm * BM + wr * 64 + fr, col0 = u.pn * BM + wc * 32 + 8 * fq;
#pragma unroll
        for (int ai = 0; ai < 2; ++ai) {
            u32x4 gv[4][2], ov[4][2];
#pragma unroll
            for (int m = 0; m < 4; ++m)
#pragma unroll
                for (int bj = 0; bj < 2; ++bj) { const size_t r = (size_t)(row0 + ai * HALF + m * 16); const int c = col0 + bj * HALF;
                    gv[m][bj] = *(const u32x4*)(Gt + r * N1 + c); ov[m][bj] = accum ? *(const u32x4*)(O + r * D + c) : (u32x4){0u, 0u, 0u, 0u}; }
#pragma unroll
            for (int m = 0; m < 4; ++m)
#pragma unroll
                for (int bj = 0; bj < 2; ++bj) { const size_t r = (size_t)(row0 + ai * HALF + m * 16); const int c = col0 + bj * HALF;
                    const u32x4 g = gv[m][bj], o0 = ov[m][bj];
                    f32x4 v0 = acc[ai][bj][m][0], v1 = acc[ai][bj][m][1];
                    v0[0] = v0[0] * bflo(g.x) + bflo(o0.x); v0[1] = v0[1] * bfhi(g.x) + bfhi(o0.x); v0[2] = v0[2] * bflo(g.y) + bflo(o0.y); v0[3] = v0[3] * bfhi(g.y) + bfhi(o0.y);
                    v1[0] = v1[0] * bflo(g.z) + bflo(o0.z); v1[1] = v1[1] * bfhi(g.z) + bfhi(o0.z); v1[2] = v1[2] * bflo(g.w) + bflo(o0.w); v1[3] = v1[3] * bfhi(g.w) + bfhi(o0.w);
                    u32x4 o; o.x = cvt_pk_bf16(v0[0], v0[1]); o.y = cvt_pk_bf16(v0[2], v0[3]); o.z = cvt_pk_bf16(v1[0], v1[1]); o.w = cvt_pk_bf16(v1[2], v1[3]);
                    *(u32x4*)(O + r * D + c) = o; }
        }
    }
};

struct EpiFfn {
    bf16_t* ACT; const float* cw; const float* stin; float* stout_p; float* stout_s; int R0, MG, l; LAS float* halo;
    __device__ __forceinline__ void operator()(const f32x4 (&acc)[2][2][4][2], const Unit& u, int wr, int wc, int fr, int fq) const {
        const int colg = u.pn * 128 + wc * 32 + 8 * fq;
        if (fr >= 14) {
#pragma unroll
            for (int ai = 0; ai < 2; ++ai) { LAS float* hp = halo + ((ai * 2 + wr) * 2 + (fr - 14)) * 128 + wc * 32 + 8 * fq; *(LAS f32x4*)hp = acc[ai][0][3][0]; *(LAS f32x4*)(hp + 4) = acc[ai][0][3][1]; }
        }
        asm volatile("s_waitcnt lgkmcnt(0)" ::: "memory"); __builtin_amdgcn_s_barrier(); asm volatile("" ::: "memory");
        const int lane = fq * 16 + fr, src1 = (lane & 48) | ((fr + 15) & 15), src2 = (lane & 48) | ((fr + 14) & 15);
#pragma unroll
        for (int n = 0; n < 2; ++n) {
            const int col = colg + 4 * n;
            const f32x4 w0 = *(const f32x4*)(cw + col), w1 = *(const f32x4*)(cw + DFF + col), w2 = *(const f32x4*)(cw + 2 * DFF + col);
#pragma unroll
            for (int ai = 0; ai < 2; ++ai)
#pragma unroll
                for (int m = 0; m < 4; ++m) {
                    const int rho = 128 * ai + 64 * wr + 16 * m + fr, Rl = u.pm * 254 - 2 + rho, R = R0 + Rl;
                    const bool valid = (rho >= 2) && (Rl < MG);
                    int t, Lq, sq; const bool smp = (R >= MP);
                    if (!smp) { t = R & (SEQ - 1); Lq = SEQ; sq = R >> 12; } else { const int Rs = R - MP; t = Rs & 15; Lq = DSEQ; sq = Rs >> 4; }
                    const f32x4 g4 = acc[ai][0][m][n];
                    const f32x4 gm = acc[ai][0][m > 0 ? m - 1 : 0][n];
                    f32x4 p1, p2;
#pragma unroll
                    for (int e = 0; e < 4; ++e) { const float s1 = (m > 0 && fr == 15) ? gm[e] : g4[e], s2 = (m > 0 && fr >= 14) ? gm[e] : g4[e]; p1[e] = dpp_rot<0x121>(s1); p2[e] = dpp_rot<0x122>(s2); }
                    if (m == 0) { const int pb = ai * 2 + wr - 1;
                        if (pb >= 0 && fr < 2) { const LAS float* h0 = halo + (pb * 2) * 128 + wc * 32 + 8 * fq + 4 * n;
                            const f32x4 x0 = *(const LAS f32x4*)h0, y0 = *(const LAS f32x4*)(h0 + 128);
                            if (fr == 0) { p1 = y0; p2 = x0; } else { p2 = y0; } } }
                    if (valid && t < 2) {
                        f32x4 s0v = (f32x4){0.f, 0.f, 0.f, 0.f}, s1v = s0v;
                        if (smp) { const float* sp = stin + (size_t)((l * 16 + sq) * 2) * DFF + col; s0v = *(const f32x4*)sp; s1v = *(const f32x4*)(sp + DFF); }
                        if (t == 0) { p1 = s1v; p2 = s0v; } else { p2 = s1v; }
                    }
                    if (valid) {
                        const f32x4 v4 = acc[ai][1][m][n];
                        float o[4];
#pragma unroll
                        for (int e = 0; e < 4; ++e) { const float y = w0[e] * p2[e] + w1[e] * p1[e] + w2[e] * g4[e]; o[e] = y * fsigmoid(y) * v4[e]; }
                        u32x2 ov; ov.x = cvt_pk_bf16(o[0], o[1]); ov.y = cvt_pk_bf16(o[2], o[3]);
                        *(u32x2*)(ACT + (size_t)Rl * DFF + col) = ov;
                        if (t >= Lq - 2) *(f32x4*)((smp ? stout_s : stout_p) + (size_t)((l * 16 + sq) * 2 + (t - (Lq - 2))) * DFF + col) = g4;
                    }
                }
        }
    }
};
}

struct Args { const float* in[24]; float* out; unsigned char* ws; };

__device__ __forceinline__ void transpose_item(const float* W, int K, int N, bf16_t* WT, int row_off, LAS float* scr, int item, int lane) {
    const int nblk = N / 32, kb = item / nblk, nb = item % nblk, k0 = 64 * kb, n0 = 32 * nb;
#pragma unroll 8
    for (int i = 0; i < 32; ++i) { const int kk = 2 * i + (lane >> 5); scr[kk * 33 + (lane & 31)] = W[(size_t)(k0 + kk) * N + n0 + (lane & 31)]; }
    asm volatile("s_waitcnt lgkmcnt(0)" ::: "memory");
    const int c = lane & 7;
#pragma unroll
    for (int j = 0; j < 4; ++j) { const int n = (lane >> 3) + 8 * j; const LAS float* s = scr + (8 * c) * 33 + n;
        u32x4 o; o.x = cvt_pk_bf16(s[0 * 33], s[1 * 33]); o.y = cvt_pk_bf16(s[2 * 33], s[3 * 33]); o.z = cvt_pk_bf16(s[4 * 33], s[5 * 33]); o.w = cvt_pk_bf16(s[6 * 33], s[7 * 33]);
        *(u32x4*)(WT + (size_t)(row_off + n0 + n) * K + k0 + 8 * c) = o; }
    asm volatile("s_waitcnt lgkmcnt(0)" ::: "memory");
}

__device__ __forceinline__ void row_pass(const bf16_t* mrow  , const float* xin, const bf16_t* xin_b, float* xout, bf16_t* xout_b, const float* gpost, const float* gate,
                                         bf16_t* hrow  , const float* gpre, const float* sc, const float* sh, int lane) {
    float xv[2][8];
    if (xin_b) {
#pragma unroll
        for (int j = 0; j < 2; ++j) { const u32x4 w = *(const u32x4*)(xin_b + 512 * j + 8 * lane);
            xv[j][0] = bflo(w.x); xv[j][1] = bfhi(w.x); xv[j][2] = bflo(w.y); xv[j][3] = bfhi(w.y); xv[j][4] = bflo(w.z); xv[j][5] = bfhi(w.z); xv[j][6] = bflo(w.w); xv[j][7] = bfhi(w.w); }
    } else {
#pragma unroll
        for (int j = 0; j < 2; ++j) { const int c0 = 512 * j + 8 * lane; const f32x4 a = *(const f32x4*)(xin + c0), b = *(const f32x4*)(xin + c0 + 4);
            xv[j][0] = a[0]; xv[j][1] = a[1]; xv[j][2] = a[2]; xv[j][3] = a[3]; xv[j][4] = b[0]; xv[j][5] = b[1]; xv[j][6] = b[2]; xv[j][7] = b[3]; }
    }
    if (mrow) {
        float mv[2][8]; float ss = 0.f;
#pragma unroll
        for (int j = 0; j < 2; ++j) { const u32x4 w = *(const u32x4*)(mrow + 512 * j + 8 * lane);
            mv[j][0] = bflo(w.x); mv[j][1] = bfhi(w.x); mv[j][2] = bflo(w.y); mv[j][3] = bfhi(w.y); mv[j][4] = bflo(w.z); mv[j][5] = bfhi(w.z); mv[j][6] = bflo(w.w); mv[j][7] = bfhi(w.w);
#pragma unroll
            for (int e = 0; e < 8; ++e) ss += mv[j][e] * mv[j][e]; }
        const float rstd = __builtin_amdgcn_rsqf(wave_sum(ss) * (1.f / D) + EPS);
#pragma unroll
        for (int j = 0; j < 2; ++j) { const int c0 = 512 * j + 8 * lane;
            const f32x4 g0 = *(const f32x4*)(gpost + c0), g1 = *(const f32x4*)(gpost + c0 + 4), t0 = *(const f32x4*)(gate + c0), t1 = *(const f32x4*)(gate + c0 + 4);
#pragma unroll
            for (int e = 0; e < 4; ++e) { xv[j][e] += t0[e] * (mv[j][e] * rstd * g0[e]); xv[j][4 + e] += t1[e] * (mv[j][4 + e] * rstd * g1[e]); }
            if (xout_b) { u32x4 o; o.x = cvt_pk_bf16(xv[j][0], xv[j][1]); o.y = cvt_pk_bf16(xv[j][2], xv[j][3]); o.z = cvt_pk_bf16(xv[j][4], xv[j][5]); o.w = cvt_pk_bf16(xv[j][6], xv[j][7]); *(u32x4*)(xout_b + c0) = o;
            } else { *(f32x4*)(xout + c0) = (f32x4){xv[j][0], xv[j][1], xv[j][2], xv[j][3]}; *(f32x4*)(xout + c0 + 4) = (f32x4){xv[j][4], xv[j][5], xv[j][6], xv[j][7]}; } }
    }
    if (hrow) {
        float ss = 0.f;
#pragma unroll
        for (int j = 0; j < 2; ++j)
#pragma unroll
            for (int e = 0; e < 8; ++e) ss += xv[j][e] * xv[j][e];
        const float rstd = __builtin_amdgcn_rsqf(wave_sum(ss) * (1.f / D) + EPS);
#pragma unroll
        for (int j = 0; j < 2; ++j) { const int c0 = 512 * j + 8 * lane; float hv[8];
            const f32x4 g0 = *(const f32x4*)(gpre + c0), g1 = *(const f32x4*)(gpre + c0 + 4), s0 = *(const f32x4*)(sc + c0), s1 = *(const f32x4*)(sc + c0 + 4), h0 = *(const f32x4*)(sh + c0), h1 = *(const f32x4*)(sh + c0 + 4);
#pragma unroll
            for (int e = 0; e < 4; ++e) { hv[e] = xv[j][e] * rstd * g0[e] * (1.f + s0[e]) + h0[e]; hv[4 + e] = xv[j][4 + e] * rstd * g1[e] * (1.f + s1[e]) + h1[e]; }
            u32x4 o; o.x = cvt_pk_bf16(hv[0], hv[1]); o.y = cvt_pk_bf16(hv[2], hv[3]); o.z = cvt_pk_bf16(hv[4], hv[5]); o.w = cvt_pk_bf16(hv[6], hv[7]);
            *(u32x4*)(hrow + c0) = o; }
    }
}
__device__ __forceinline__ int row_batch(int R) { return R < MP ? (R >> 12) : 16 + ((R - MP) >> 4); }

template <bool FULL>
__device__ __forceinline__ void hgrn_item(LAS unsigned char* lds, const bf16_t* P, bf16_t* AB, int L, int hd, const float* lbv, const float* anorm, const float* S0, const float* Dd, int ns, float* Sout, float* Dout) {
    int tid = threadIdx.x; asm volatile("" : "+v"(tid));
    const int w = tid >> 6, lane = tid & 63, q4 = lane >> 4, c16 = lane & 15;
    const int k = tid & 127, tq = tid >> 7;
    LAS bf16_t* Qt = (LAS bf16_t*)lds;
    LAS bf16_t* Kt = Qt + 16 * 136;
    LAS bf16_t* KhT = Kt + 16 * 136;
    LAS bf16_t* VsT = KhT + 128 * 20;
    LAS float* dvec = (LAS float*)(VsT + 128 * 20);
    LAS float* qsum = dvec + 128;
    LAS float* ssq = qsum + 512;
    const float lb = lbv[k], oml = 1.f - lb;
    const float an = FULL ? anorm[16 * w + c16] : 0.f;
    f32x4 accS[8];
#pragma unroll
    for (int mt = 0; mt < 8; ++mt) accS[mt] = (f32x4){0.f, 0.f, 0.f, 0.f};
    for (int c = 0; c < ns; ++c) { const float* sc = S0 + (size_t)c * 16384 + 16 * w + c16;
#pragma unroll
        for (int mt = 0; mt < 8; ++mt) { f32x4 d4 = (f32x4){0.f, 0.f, 0.f, 0.f}; if (Dd) d4 = *(const f32x4*)(Dd + c * 128 + 16 * mt + 4 * q4);
#pragma unroll
            for (int j = 0; j < 4; ++j) accS[mt][j] = accS[mt][j] * d4[j] + sc[(size_t)(16 * mt + 4 * q4 + j) * 128]; } }
    const bf16_t* pq = P + 128 * hd + k + (size_t)(4 * tq) * N1;
    const bf16_t* pz = pq + 512;
    const int vt = (tid >> 4) & 15, vc = tid & 15;
    const bf16_t* pv = P + 1024 + 128 * hd + 8 * vc + (size_t)vt * N1;
    const bf16_t* pg = P + 1536 + 128 * hd + 16 * w + c16 + (size_t)(4 * q4) * N1;
    bf16_t* po = AB + 128 * hd + 16 * w + c16 + (size_t)(4 * q4) * D;
    const int nsteps = L >> 4;
    float btot = 0.f;
    unsigned short zr[4], qr[4], grn[4]; u32x4 vr = (u32x4){0u, 0u, 0u, 0u};
#pragma unroll
    for (int i = 0; i < 4; ++i) { zr[i] = pz[(size_t)i * N1]; qr[i] = pq[(size_t)i * N1]; grn[i] = pg[(size_t)i * N1]; }
    if (tid < 256) vr = *(const u32x4*)pv;
    for (int n = 0; n < nsteps; ++n) {
        unsigned short zc[4], qc[4], gr[4]; const u32x4 vcur = vr;
#pragma unroll
        for (int i = 0; i < 4; ++i) { zc[i] = zr[i]; qc[i] = qr[i]; gr[i] = grn[i]; }
        const size_t roff = (size_t)(16 * n) * N1;
        {
            const size_t nro = (size_t)(16 * (n + 1 < nsteps ? n + 1 : n)) * N1;
#pragma unroll
            for (int i = 0; i < 4; ++i) { zr[i] = pz[nro + (size_t)i * N1]; qr[i] = pq[nro + (size_t)i * N1]; grn[i] = pg[nro + (size_t)i * N1]; }
            if (tid < 256) vr = *(const u32x4*)(pv + nro);
        }
        float cs[4], kk[4], qv[4];
        {
            float run = 0.f;
#pragma unroll
            for (int i = 0; i < 4; ++i) { float z = bf2f(zc[i]); z = fminf(fmaxf(z, -30.f), 30.f); const float e = __expf(-z), sg = __builtin_amdgcn_rcpf(1.f + e), sn = e * sg;
                const float f = lb + oml * sg; run += __builtin_amdgcn_logf(f) * 0.69314718056f; cs[i] = run; kk[i] = oml * sn; qv[i] = bf2f(qc[i]); }
            qsum[tq * 128 + k] = run;
        }
        __syncthreads();
        {
            float pre = 0.f, tot = 0.f;
#pragma unroll
            for (int j = 0; j < 4; ++j) { const float v = qsum[j * 128 + k]; tot += v; pre += (j < tq) ? v : 0.f; }
            btot += tot;
            float kh[4];
#pragma unroll
            for (int i = 0; i < 4; ++i) { const float b = pre + cs[i]; const float qt = qv[i] * __expf(b), kt = kk[i] * __expf(fminf(-b, 80.f)); kh[i] = kk[i] * __expf(tot - b);
                Qt[(4 * tq + i) * 136 + k] = (bf16_t)(cvt_pk_bf16(qt, 0.f) & 0xffffu); Kt[(4 * tq + i) * 136 + k] = (bf16_t)(cvt_pk_bf16(kt, 0.f) & 0xffffu); }
            u32x2 kp; kp.x = cvt_pk_bf16(kh[0], kh[1]); kp.y = cvt_pk_bf16(kh[2], kh[3]);
            *(LAS u32x2*)(KhT + k * 20 + 4 * tq) = kp;
            if (tq == 0) dvec[k] = __expf(tot);
            if (tid < 256) {
                VsT[(8 * vc + 0) * 20 + vt] = (bf16_t)(vcur.x & 0xffffu); VsT[(8 * vc + 1) * 20 + vt] = (bf16_t)(vcur.x >> 16);
                VsT[(8 * vc + 2) * 20 + vt] = (bf16_t)(vcur.y & 0xffffu); VsT[(8 * vc + 3) * 20 + vt] = (bf16_t)(vcur.y >> 16);
                VsT[(8 * vc + 4) * 20 + vt] = (bf16_t)(vcur.z & 0xffffu); VsT[(8 * vc + 5) * 20 + vt] = (bf16_t)(vcur.z >> 16);
                VsT[(8 * vc + 6) * 20 + vt] = (bf16_t)(vcur.w & 0xffffu); VsT[(8 * vc + 7) * 20 + vt] = (bf16_t)(vcur.w >> 16);
            }
        }
        __syncthreads();
        f32x4 acco = (f32x4){0.f, 0.f, 0.f, 0.f};
        {
            const u32x2 vv = *(const LAS u32x2*)(VsT + (16 * w + c16) * 20 + 4 * q4);
            const bf16x4 vf = __builtin_bit_cast(bf16x4, vv);
            if (FULL) {
            bf16x8 qf[4], kf[4];
#pragma unroll
            for (int kq = 0; kq < 4; ++kq) {
                const u32x2 a0 = *(const LAS u32x2*)(Qt + c16 * 136 + 32 * kq + 4 * q4), a1 = *(const LAS u32x2*)(Qt + c16 * 136 + 32 * kq + 16 + 4 * q4);
                const u32x2 b0 = *(const LAS u32x2*)(Kt + c16 * 136 + 32 * kq + 4 * q4), b1 = *(const LAS u32x2*)(Kt + c16 * 136 + 32 * kq + 16 + 4 * q4);
                u32x4 qa = (u32x4){a0.x, a0.y, a1.x, a1.y}, ka = (u32x4){b0.x, b0.y, b1.x, b1.y};
                qf[kq] = __builtin_bit_cast(bf16x8, qa); kf[kq] = __builtin_bit_cast(bf16x8, ka);
            }
            f32x4 accA = (f32x4){0.f, 0.f, 0.f, 0.f};
#pragma unroll
            for (int kq = 0; kq < 4; ++kq) accA = __builtin_amdgcn_mfma_f32_16x16x32_bf16(kf[kq], qf[kq], accA, 0, 0, 0);
#pragma unroll
            for (int j = 0; j < 4; ++j) accA[j] = (c16 >= 4 * q4 + j) ? accA[j] : 0.f;
            u32x2 pa; pa.x = cvt_pk_bf16(accA[0], accA[1]); pa.y = cvt_pk_bf16(accA[2], accA[3]);
            const bf16x4 pA = __builtin_bit_cast(bf16x4, pa);
            acco = __builtin_amdgcn_mfma_f32_16x16x16bf16_1k(pA, vf, (f32x4){0.f, 0.f, 0.f, 0.f}, 0, 0, 0);
#pragma unroll
            for (int kq = 0; kq < 4; ++kq) {
                u32x4 sp; sp.x = cvt_pk_bf16(accS[2 * kq][0], accS[2 * kq][1]); sp.y = cvt_pk_bf16(accS[2 * kq][2], accS[2 * kq][3]);
                sp.z = cvt_pk_bf16(accS[2 * kq + 1][0], accS[2 * kq + 1][1]); sp.w = cvt_pk_bf16(accS[2 * kq + 1][2], accS[2 * kq + 1][3]);
                acco = __builtin_amdgcn_mfma_f32_16x16x32_bf16(qf[kq], __builtin_bit_cast(bf16x8, sp), acco, 0, 0, 0);
            }
            }
#pragma unroll
            for (int mt = 0; mt < 8; ++mt) {
                const u32x2 kh2 = *(const LAS u32x2*)(KhT + (16 * mt + c16) * 20 + 4 * q4);
                const f32x4 d4 = *(const LAS f32x4*)(dvec + 16 * mt + 4 * q4);
                accS[mt] = accS[mt] * d4;
                accS[mt] = __builtin_amdgcn_mfma_f32_16x16x16bf16_1k(__builtin_bit_cast(bf16x4, kh2), vf, accS[mt], 0, 0, 0);
            }
            if (FULL) {
            const float s0 = sum16(acco[0] * acco[0]), s1 = sum16(acco[1] * acco[1]), s2 = sum16(acco[2] * acco[2]), s3 = sum16(acco[3] * acco[3]);
            if (c16 == 0) { *(LAS f32x4*)(ssq + w * 16 + 4 * q4) = (f32x4){s0, s1, s2, s3}; }
            }
        }
        if (FULL) __syncthreads();
        if (FULL) {
            f32x4 tot = (f32x4){0.f, 0.f, 0.f, 0.f};
#pragma unroll
            for (int ww = 0; ww < 8; ++ww) tot += *(const LAS f32x4*)(ssq + ww * 16 + 4 * q4);
#pragma unroll
            for (int j = 0; j < 4; ++j) { const float rstd = __builtin_amdgcn_rsqf(tot[j] * (1.f / 128.f) + EPS); const float o = acco[j] * rstd * an * bf2f(gr[j]);
                po[(size_t)(16 * n + j) * D] = (bf16_t)(cvt_pk_bf16(o, 0.f) & 0xffffu); }
        }
    }
    if (Sout) {
#pragma unroll
        for (int mt = 0; mt < 8; ++mt)
#pragma unroll
            for (int j = 0; j < 4; ++j) Sout[(size_t)(16 * mt + 4 * q4 + j) * 128 + 16 * w + c16] = accS[mt][j];
    }
    if (Dout && tid < 128) Dout[tid] = __expf(btot);
    __syncthreads();
}

__device__ __forceinline__ void unpack8(const u32x4 w, float (&v)[8]) { v[0] = bflo(w.x); v[1] = bfhi(w.x); v[2] = bflo(w.y); v[3] = bfhi(w.y); v[4] = bflo(w.z); v[5] = bfhi(w.z); v[6] = bflo(w.w); v[7] = bfhi(w.w); }
__device__ __forceinline__ u32x4 pack8(const float (&v)[8]) { u32x4 o; o.x = cvt_pk_bf16(v[0], v[1]); o.y = cvt_pk_bf16(v[2], v[3]); o.z = cvt_pk_bf16(v[4], v[5]); o.w = cvt_pk_bf16(v[6], v[7]); return o; }
__device__ __forceinline__ void load8f(const float* p, float (&v)[8]) { const f32x4 a = *(const f32x4*)p, b = *(const f32x4*)(p + 4); v[0] = a[0]; v[1] = a[1]; v[2] = a[2]; v[3] = a[3]; v[4] = b[0]; v[5] = b[1]; v[6] = b[2]; v[7] = b[3]; }
__device__ __forceinline__ void store8f(float* p, const float (&v)[8]) { *(f32x4*)p = (f32x4){v[0], v[1], v[2], v[3]}; *(f32x4*)(p + 4) = (f32x4){v[4], v[5], v[6], v[7]}; }

__device__ __forceinline__ void shortconv_phase(const Args& a, int l, int R0, int MG, const bf16_t* P, bf16_t* AB, unsigned* ctr, volatile LAS unsigned* bcast) {
    const float* cw = a.in[17] + (size_t)l * 3 * BW;
    int tidc = threadIdx.x; asm volatile("" : "+v"(tidc));
    const int nconv = (MG / 8) * 64;
    for (;;) {
        __syncthreads();
        if (tidc == 0) *bcast = __hip_atomic_fetch_add(ctr, 512u, __ATOMIC_RELAXED, __HIP_MEMORY_SCOPE_AGENT);
        __syncthreads();
        const int it = (int)*bcast + tidc;
        if (it - tidc >= nconv) break;
        if (it >= nconv) continue;
        const int rb = it >> 6, ch = (it & 63) * 8, r0 = rb * 8, R = R0 + r0;
        int t0, Lq; const float* st_in = nullptr; float* st_out;
        if (R < MP) { t0 = R & (SEQ - 1); Lq = SEQ; st_out = a.out + O_SCP + (size_t)((l * 16 + (R >> 12)) * 2) * BW; }
        else { const int Rs = R - MP; t0 = Rs & 15; Lq = DSEQ; const int sq = Rs >> 4; st_in = a.in[3] + (size_t)((l * 16 + sq) * 2) * BW; st_out = a.out + O_SCS + (size_t)((l * 16 + sq) * 2) * BW; }
        float w0[8], w1[8], w2[8], p2[8], p1[8];
        load8f(cw + ch, w0); load8f(cw + BW + ch, w1); load8f(cw + 2 * BW + ch, w2);
        if (t0 == 0) {
            if (st_in) { load8f(st_in + ch, p2); load8f(st_in + BW + ch, p1); }
            else {
#pragma unroll
                for (int e = 0; e < 8; ++e) { p2[e] = 0.f; p1[e] = 0.f; } }
        } else {
            float c8[8], v8[8];
            unpack8(*(const u32x4*)(P + (size_t)(r0 - 2) * N1 + 2560 + ch), c8); unpack8(*(const u32x4*)(P + (size_t)(r0 - 2) * N1 + 3072 + ch), v8);
#pragma unroll
            for (int e = 0; e < 8; ++e) p2[e] = c8[e] * v8[e];
            unpack8(*(const u32x4*)(P + (size_t)(r0 - 1) * N1 + 2560 + ch), c8); unpack8(*(const u32x4*)(P + (size_t)(r0 - 1) * N1 + 3072 + ch), v8);
#pragma unroll
            for (int e = 0; e < 8; ++e) p1[e] = c8[e] * v8[e];
        }
#pragma unroll 2
        for (int i = 0; i < 8; ++i) {
            const bf16_t* pr = P + (size_t)(r0 + i) * N1;
            float b8[8], c8[8], v8[8], o8[8];
            unpack8(*(const u32x4*)(pr + 2048 + ch), b8); unpack8(*(const u32x4*)(pr + 2560 + ch), c8); unpack8(*(const u32x4*)(pr + 3072 + ch), v8);
#pragma unroll
            for (int e = 0; e < 8; ++e) { const float cv = c8[e] * v8[e]; o8[e] = b8[e] * (w0[e] * p2[e] + w1[e] * p1[e] + w2[e] * cv); p2[e] = p1[e]; p1[e] = cv; }
            *(u32x4*)(AB + (size_t)(r0 + i) * D + 512 + ch) = pack8(o8);
        }
        if (t0 + 8 == Lq) { store8f(st_out + ch, p2); store8f(st_out + BW + ch, p1); }
    }
}
#define XB_TMO      128
#define XB_XCNT(j)  (256  + 64 * (j))
#define XB_XSUB(j)  (1280 + 64 * (j))
#define XB_XGEN(j)  (2304 + 64 * (j))
#define XB_TOP      3328
#define XB_TOPGEN   3392
#define XCD_BAR_WORDS 3456
#define XB_SPIN_CAP (1u << 22)
__device__ __forceinline__ unsigned xb_ld(unsigned* p)              { return __hip_atomic_load(p, __ATOMIC_RELAXED, __HIP_MEMORY_SCOPE_AGENT); }
__device__ __forceinline__ unsigned xb_add(unsigned* p, unsigned v) { return __hip_atomic_fetch_add(p, v, __ATOMIC_RELAXED, __HIP_MEMORY_SCOPE_AGENT); }
__device__ __forceinline__ unsigned xb_xcc_id() { return (unsigned)__builtin_amdgcn_s_getreg((3 << 11) | 20) & 0xFu; }
#define XB_SPIN(cond, bar) do { unsigned _sp = 0; while (cond) { __builtin_amdgcn_s_sleep(1); \
    if ((++_sp & 255u) == 0u) { if (xb_ld(&(bar)[XB_TMO])) break; if (_sp > XB_SPIN_CAP) { atomicAdd(&(bar)[XB_TMO], 1u); break; } } } } while (0)
struct XcdBarrier { unsigned* bar; unsigned x; volatile LAS unsigned* st; };
__device__ __forceinline__ XcdBarrier xcd_barrier_post(unsigned* bar, volatile LAS unsigned* st) {
    XcdBarrier b; b.bar = bar; b.x = xb_xcc_id(); b.st = st;
    if (threadIdx.x == 0) (void)xb_add(&bar[XB_XCNT(b.x)], 1u);
    return b;
}
__device__ __forceinline__ void xcd_barrier_complete(unsigned* bar, unsigned x, unsigned& nloc, unsigned& nx) {
    const unsigned G = gridDim.x * gridDim.y * gridDim.z;
    unsigned sum, cnt, mine, sp = 0u;
    for (;;) {
        sum = 0u; cnt = 0u; mine = 0u;
#pragma unroll
        for (unsigned j = 0; j < 16; ++j) { const unsigned c = xb_ld(&bar[XB_XCNT(j)]); sum += c; cnt += (c > 0u) ? 1u : 0u; mine = (j == x) ? c : mine; }
        if (sum == G) break;
        __builtin_amdgcn_s_sleep(1);
        if ((++sp & 255u) == 0u) { if (xb_ld(&bar[XB_TMO])) break; if (sp > XB_SPIN_CAP) { atomicAdd(&bar[XB_TMO], 1u); break; } }
    }
    nloc = mine > 0u ? mine : 1u; nx = cnt > 0u ? cnt : 1u;
}
__device__ __forceinline__ void xcd_barrier(const XcdBarrier& b) {
    asm volatile("s_waitcnt vmcnt(0) lgkmcnt(0)" ::: "memory");
    __syncthreads();
    if (threadIdx.x == 0) {
        unsigned* bar = b.bar;
        __builtin_amdgcn_s_waitcnt(0);
        unsigned nloc = b.st[0], nx = b.st[1];
        if (nloc == 0u) { xcd_barrier_complete(bar, b.x, nloc, nx); b.st[0] = nloc; b.st[1] = nx; }
        const unsigned old = xb_add(&bar[XB_XSUB(b.x)], 1u);
        const unsigned gen = old / nloc;
        if (old + 1u == (gen + 1u) * nloc) {
            __builtin_amdgcn_fence(__ATOMIC_RELEASE, "agent");
            asm volatile("s_waitcnt vmcnt(0)" ::: "memory");
            const unsigned og = xb_add(&bar[XB_TOP], 1u);
            const unsigned tg = og / nx;
            if (og + 1u == (tg + 1u) * nx) xb_add(&bar[XB_TOPGEN], 1u);
            else XB_SPIN(xb_ld(&bar[XB_TOPGEN]) == tg, bar);
            __builtin_amdgcn_fence(__ATOMIC_ACQUIRE, "agent");
            xb_add(&bar[XB_XGEN(b.x)], 1u);
            asm volatile("s_waitcnt vmcnt(0)" ::: "memory");
        } else {
            XB_SPIN(xb_ld(&bar[XB_XGEN(b.x)]) == gen, bar);
            __builtin_amdgcn_fence(__ATOMIC_ACQUIRE, "agent");
            asm volatile("s_waitcnt vmcnt(0)" ::: "memory");
        }
    }
    __syncthreads();
}

#define GSYNC_CG() do { asm volatile("s_waitcnt vmcnt(0) lgkmcnt(0)" ::: "memory"); grid.sync(); } while (0)
#define GSYNC() xcd_barrier(xbar)
__global__ void __launch_bounds__(512, 2) fwd_megakernel(Args a) {
    extern __shared__ __attribute__((aligned(16))) unsigned char lds_raw[];
    LAS unsigned char* lds = (LAS unsigned char*)lds_raw;
    cg::grid_group grid = cg::this_grid();
    const int tid = threadIdx.x, lane = tid & 63, wave = __builtin_amdgcn_readfirstlane(tid >> 6);
    const int G = gridDim.x, wg = blockIdx.x;
    unsigned char* ws = a.ws;
    volatile LAS unsigned* MISC = (volatile LAS unsigned*)(lds + 131072 + 320);
    if (tid < 32) MISC[tid] = 0u;
    __syncthreads();
    const XcdBarrier xbar = xcd_barrier_post((unsigned*)ws + 4096, MISC + 8);
    float* ADA = (float*)(ws + WS_ADA);
    float* LB = (float*)(ws + WS_LB);
    bf16_t* Hb = (bf16_t*)(ws + WS_H);
    bf16_t* ABb = (bf16_t*)(ws + WS_AB);
    bf16_t* Pb = (bf16_t*)(ws + WS_P);
    bf16_t* ACTb = (bf16_t*)(ws + WS_ACT);
    bf16_t* XBb = (bf16_t*)(ws + WS_XB);

    if (wg < 192) {
        LAS float* csT = (LAS float*)lds;
        for (int i = tid; i < 32 * 1024; i += 512) { const int b = i >> 10, kx = i & 1023; const float c = (b < 16) ? a.in[5][(size_t)b * D + kx] : a.in[6][(size_t)(b - 16) * D + kx]; csT[kx * 32 + b] = c * fsigmoid(c); }
        __syncthreads();
        const int cc = tid & 127, kq = tid >> 7;
        const int col = wg * 128 + cc;
        const int l = col / 6144, n = col - l * 6144;
        const float* wp = a.in[7] + (size_t)l * D * 6144 + n;
        float acc[32];
#pragma unroll
        for (int b = 0; b < 32; ++b) acc[b] = 0.f;
#pragma unroll 4
        for (int kx = 256 * kq; kx < 256 * kq + 256; ++kx) { const float wv = wp[(size_t)kx * 6144];
#pragma unroll
            for (int b4 = 0; b4 < 8; ++b4) { const f32x4 c4 = *(const LAS f32x4*)(csT + kx * 32 + 4 * b4); acc[4 * b4] += c4[0] * wv; acc[4 * b4 + 1] += c4[1] * wv; acc[4 * b4 + 2] += c4[2] * wv; acc[4 * b4 + 3] += c4[3] * wv; } }
        __syncthreads();
        LAS float* red = (LAS float*)lds;
#pragma unroll
        for (int b = 0; b < 32; ++b) red[(kq * 32 + b) * 128 + cc] = acc[b];
        __syncthreads();
#pragma unroll
        for (int i = 0; i < 8; ++i) { const int o = tid + 512 * i, b = o >> 7, c2 = o & 127; const int col2 = wg * 128 + c2, n2 = col2 - l * 6144;
            const float v = red[(0 * 32 + b) * 128 + c2] + red[(1 * 32 + b) * 128 + c2] + red[(2 * 32 + b) * 128 + c2] + red[(3 * 32 + b) * 128 + c2];
            ADA[((size_t)l * 32 + b) * 6144 + n2] = v + a.in[8][(size_t)l * 6144 + n2]; }
        __syncthreads();
    }
    if (wg == 192) {
        const float x0 = a.in[14][tid], x1 = a.in[14][512 + tid], x2 = a.in[14][1024 + tid], x3 = a.in[14][1536 + tid];
        const float mx = fmaxf(fmaxf(x0, x1), fmaxf(x2, x3));
        const float e0 = __expf(x0 - mx), e1 = __expf(x1 - mx), e2 = __expf(x2 - mx), e3 = __expf(x3 - mx), inv = 1.f / (e0 + e1 + e2 + e3);
        LB[tid] = 0.f; LB[512 + tid] = e1 * inv; LB[1024 + tid] = (e1 + e2) * inv; LB[1536 + tid] = (e1 + e2 + e3) * inv;
    }
    {
        LAS float* scr = (LAS float*)(lds + wave * 16384);
        const int gw = wg * 8 + wave, NGW = G * 8;
        constexpr int I_IN = 16 * (NIN / 32), I_BG = 16 * (2048 / 32), I_PA = 8 * 32, I_PB = 8 * 32, I_O = 16 * 32, I_UP = 16 * (NUP / 32), I_DN = (DFF / 64) * 32;
        constexpr int I_LAYER = I_IN + I_BG + I_PA + I_PB + I_O + I_UP + I_DN;
        for (int it = gw; it < 4 * I_LAYER; it += NGW) {
            const int l = it / I_LAYER; int r = it - l * I_LAYER;
            bf16_t* wl = (bf16_t*)(ws + WS_W + (size_t)l * LAYER_W);
            if (r < I_IN) { transpose_item(a.in[13] + (size_t)l * D * NIN, D, NIN, wl + W1_OFF / 2, 0, scr, r, lane); continue; } r -= I_IN;
            if (r < I_BG) { transpose_item(a.in[19] + (size_t)l * D * 2048, D, 2048, wl + W1_OFF / 2, NIN, scr, r, lane); continue; } r -= I_BG;
            if (r < I_PA) { transpose_item(a.in[16] + (size_t)l * AW * D, AW, D, wl + WPA_OFF / 2, 0, scr, r, lane); continue; } r -= I_PA;
            if (r < I_PB) { transpose_item(a.in[18] + (size_t)l * BW * D, BW, D, wl + WPB_OFF / 2, 0, scr, r, lane); continue; } r -= I_PB;
            if (r < I_O) { transpose_item(a.in[20] + (size_t)l * D * D, D, D, wl + WO_OFF / 2, 0, scr, r, lane); continue; } r -= I_O;
            if (r < I_UP) { const int n0 = 32 * (r % (NUP / 32));
                const int jj = n0 < DFF ? n0 : n0 - DFF, rowb = 256 * (jj >> 7) + (n0 < DFF ? 0 : 128) + (jj & 127);
                transpose_item(a.in[21] + (size_t)l * D * NUP, D, NUP, wl + WUP_OFF / 2, rowb - n0, scr, r, lane); continue; } r -= I_UP;
            transpose_item(a.in[23] + (size_t)l * DFF * D, DFF, D, wl + WDN_OFF / 2, 0, scr, r, lane);
        }
    }
    GSYNC_CG();

    for (int grp = 0; grp < 2; ++grp) {
        const int R0 = grp ? MG0 : 0, MG = grp ? MG1 : MG0, nM = MG / 256;
        int tid = threadIdx.x; asm volatile("" : "+v"(tid));
        const int lane = tid & 63, wave = __builtin_amdgcn_readfirstlane(tid >> 6);
        for (int r = wg * 8 + wave; r < MG; r += G * 8) {
            const int R = R0 + r; const float* xin = (R < MP) ? a.in[0] + (size_t)R * D : a.in[1] + (size_t)(R - MP) * D;
            const float* ad = ADA + (size_t)row_batch(R) * 6144;
            row_pass(nullptr, xin, nullptr, nullptr, nullptr, nullptr, nullptr, Hb + (size_t)r * D, a.in[9], ad + 1024, ad, lane);
        }
        GSYNC();
        for (int l = 0; l < DEPTH; ++l) {
            int tid = threadIdx.x; asm volatile("" : "+v"(tid));
            const int lane = tid & 63, wave = __builtin_amdgcn_readfirstlane(tid >> 6);
            const bf16_t* wl = (const bf16_t*)(ws + WS_W + (size_t)l * LAYER_W);
            { pg8::Gemm g{Hb, wl + W1_OFF / 2, D, D, D}; pg8::StaticOrder S; S.init(nM, N1 / 256, G, wg); pg8::EpiStore E{Pb, N1, 1}; pg8::gemm_phase(lds, g, S, E); }
            GSYNC();
            {
                int tidb = threadIdx.x; asm volatile("" : "+v"(tidb));
                const int chain = wg >> 3, chunk = wg & 7, sqg = chain >> 2, hd = chain & 3;
                const int lrow = sqg * SEQ + chunk * 512;
                float* DS = (float*)(ws + WS_DS) + (size_t)(chain * 8) * 16384;
                float* DD = (float*)(ws + WS_DD) + (size_t)(chain * 8) * 128;
                float* SS = (float*)(ws + WS_SS) + (size_t)wg * 16384;
                const float* lbv = LB + l * 512 + hd * 128;
                const float* anv = a.in[15] + l * 128;
                if (wg < 256 && chunk < 7)
                    hgrn_item<false>(lds, Pb + (size_t)lrow * N1, ABb + (size_t)lrow * D, 512, hd, lbv, anv, nullptr, nullptr, 0, DS + (size_t)chunk * 16384, DD + chunk * 128);
                shortconv_phase(a, l, R0, MG, Pb, ABb, (unsigned*)ws + 1024 + 64 * (grp * 4 + l), MISC + 16);
                GSYNC();
                if (wg < 256)
                    hgrn_item<true>(lds, Pb + (size_t)lrow * N1, ABb + (size_t)lrow * D, 512, hd, lbv, anv, DS, DD, chunk,
                              chunk == 7 ? a.out + O_SHP + (size_t)((l * 16 + 8 * grp + sqg) * 4 + hd) * 16384 : nullptr, nullptr);
                if (grp == 1 && wg < 64) {
                    const int sq = wg >> 2, hs = wg & 3; const int srow = MG0 + sq * DSEQ;
                    hgrn_item<true>(lds, Pb + (size_t)srow * N1, ABb + (size_t)srow * D, DSEQ, hs, LB + l * 512 + hs * 128, anv,
                              a.in[2] + (size_t)((l * 16 + sq) * 4 + hs) * 16384, nullptr, 1, a.out + O_SHS + (size_t)((l * 16 + sq) * 4 + hs) * 16384, nullptr);
                }
            }
            GSYNC();
            { pg8::Gemm g{ABb, wl + WPA_OFF / 2, D, AW, AW}; pg8::StaticOrder S; S.init(nM, D / 256, G, wg); pg8::EpiGate E{Hb, Pb + NIN, 0}; pg8::gemm_phase(lds, g, S, E); }
            { pg8::Gemm g{ABb + AW, wl + WPB_OFF / 2, D, BW, BW}; pg8::StaticOrder S; S.init(nM, D / 256, G, wg); pg8::EpiGate E{Hb, Pb + NIN + D, 1}; pg8::gemm_phase(lds, g, S, E); }
            GSYNC();
            { pg8::Gemm g{Hb, wl + WO_OFF / 2, D, D, D}; pg8::StaticOrder S; S.init(nM, D / 256, G, wg); pg8::EpiStore E{ABb, D, 0}; pg8::gemm_phase(lds, g, S, E); }
            GSYNC();
            for (int r = wg * 8 + wave; r < MG; r += G * 8) {
                const int R = R0 + r; const float* xin = (R < MP) ? a.in[0] + (size_t)R * D : a.in[1] + (size_t)(R - MP) * D;
                const float* ad = ADA + ((size_t)l * 32 + row_batch(R)) * 6144;
                row_pass(ABb + (size_t)r * D, xin, (l == 0) ? nullptr : XBb + (size_t)r * D, nullptr, XBb + (size_t)r * D, a.in[10] + l * D, ad + 2048, Hb + (size_t)r * D, a.in[11] + l * D, ad + 4096, ad + 3072, lane);
            }
            GSYNC();
            { pg8::Gemm g{Hb, wl + WUP_OFF / 2, D, D, D, 254, -2}; pg8::StaticOrder S; S.init((MG + 253) / 254, NUP / 256, G, wg);
              pg8::EpiFfn E{ACTb, a.in[22] + (size_t)l * 3 * DFF, a.in[4], a.out + O_SFP, a.out + O_SFS, R0, MG, l, (LAS float*)(lds + 131072 + 1024)};
              pg8::gemm_phase(lds, g, S, E); }
            GSYNC();
            { pg8::Gemm g{ACTb, wl + WDN_OFF / 2, DFF, DFF, DFF}; pg8::StaticOrder S; S.init(nM, D / 256, G, wg); pg8::EpiStore E{ABb, D, 0}; pg8::gemm_phase(lds, g, S, E); }
            GSYNC();
            for (int r = wg * 8 + wave; r < MG; r += G * 8) {
                const int R = R0 + r;
                const float* ad = ADA + ((size_t)l * 32 + row_batch(R)) * 6144;
                const float* adn = ADA + ((size_t)(l + 1 < DEPTH ? l + 1 : l) * 32 + row_batch(R)) * 6144;
                row_pass(ABb + (size_t)r * D, nullptr, XBb + (size_t)r * D, a.out + (size_t)R * D, (l + 1 < DEPTH) ? XBb + (size_t)r * D : nullptr, a.in[12] + l * D, ad + 5120, (l + 1 < DEPTH) ? Hb + (size_t)r * D : nullptr,
                         a.in[9] + (l + 1 < DEPTH ? l + 1 : l) * D, adn + 1024, adn, lane);
            }
            if (l + 1 < DEPTH) GSYNC();
        }
    }
}

extern "C" void kernel_launch(void* const* d_in, const int* in_sizes, int n_in, void* d_out, int out_size, void* d_ws, size_t ws_size, hipStream_t stream) {
    static int grid = 0;
    if (grid == 0) {
        if (n_in != 24 || ws_size < WS_END) { fprintf(stderr, "kernel_launch: unexpected n_in %d / ws_size %zu (need %zu)\n", n_in, ws_size, (size_t)WS_END); grid = -1; return; }
        int dev = 0, cus = 0, per_cu = 0;
        hipGetDevice(&dev);
        hipDeviceGetAttribute(&cus, hipDeviceAttributeMultiprocessorCount, dev);
        if (hipFuncSetAttribute((const void*)fwd_megakernel, hipFuncAttributeMaxDynamicSharedMemorySize, LDS_BYTES) != hipSuccess) { fprintf(stderr, "kernel_launch: hipFuncSetAttribute failed\n"); }
        if (hipOccupancyMaxActiveBlocksPerMultiprocessor(&per_cu, (const void*)fwd_megakernel, 512, LDS_BYTES) != hipSuccess || per_cu < 1) { fprintf(stderr, "kernel_launch: occupancy query says %d\n", per_cu); per_cu = 1; }
        (void)hipGetLastError();
        grid = cus;
    }
    if (grid < 0) return;
    if (hipMemsetAsync(d_ws, 0, 65536, stream) != hipSuccess) { fprintf(stderr, "kernel_launch: hipMemsetAsync failed\n"); return; }
    Args a{};
    for (int i = 0; i < 24; ++i) a.in[i] = (const float*)d_in[i];
    a.out = (float*)d_out; a.ws = (unsigned char*)d_ws;
    void* args[] = {&a};
    hipError_t e = hipLaunchCooperativeKernel((const void*)fwd_megakernel, dim3(grid), dim3(512), args, LDS_BYTES, stream);
    if (e != hipSuccess) fprintf(stderr, "kernel_launch: cooperative launch failed: %s (grid %d)\n", hipGetErrorString(e), grid);
}
```

```cpp
#include <hip/hip_runtime.h>
#include <hip/hip_cooperative_groups.h>
#include <cstdio>
#include <cstdint>
namespace cg = cooperative_groups;

#define LAS __attribute__((address_space(3)))
typedef unsigned short bf16_t;
typedef short bf16x8 __attribute__((ext_vector_type(8)));
typedef short bf16x4 __attribute__((ext_vector_type(4)));
typedef float f32x4 __attribute__((ext_vector_type(4)));
typedef unsigned u32x4 __attribute__((ext_vector_type(4)));
typedef unsigned u32x2 __attribute__((ext_vector_type(2)));

constexpr int D = 1024, SEQ = 4096, NBATCH = 16, DEPTH = 4, DSEQ = 16;
constexpr int AW = 512, BW = 512, DFF = 2816, NIN = 3584, N1 = 5632, NUP = 5632;
constexpr int MP = NBATCH * SEQ;
constexpr int MS = NBATCH * DSEQ;
constexpr int MG0 = 32768, MG1 = 33024, MGMAX = 33024;
constexpr float EPS = 1e-6f;
constexpr size_t O_YP = 0, O_YS = 67108864, O_SHP = 67371008, O_SCP = 71565312, O_SFP = 71630848, O_SHS = 71991296, O_SCS = 76185600, O_SFS = 76251136;
constexpr size_t MiB = 1u << 20;
constexpr size_t WS_ADA = 1 * MiB;
constexpr size_t WS_LB = 5 * MiB;
constexpr size_t WS_W = 8 * MiB;
constexpr size_t W1_OFF = 0, WPA_OFF = (size_t)N1 * D * 2, WPB_OFF = WPA_OFF + (size_t)D * AW * 2, WO_OFF = WPB_OFF + (size_t)D * BW * 2,
                 WUP_OFF = WO_OFF + (size_t)D * D * 2, WDN_OFF = WUP_OFF + (size_t)NUP * D * 2, LAYER_W = WDN_OFF + (size_t)D * DFF * 2;
constexpr size_t WS_H = 136 * MiB;
constexpr size_t WS_AB = 202 * MiB;
constexpr size_t WS_P = 268 * MiB;
constexpr size_t WS_ACT = 624 * MiB;
constexpr size_t WS_DS = 804 * MiB;
constexpr size_t WS_DD = 822 * MiB;
constexpr size_t WS_SS = 824 * MiB;
constexpr size_t WS_DUMMY = 840 * MiB;
constexpr size_t WS_XB = 842 * MiB;
constexpr size_t WS_END = 908 * MiB;
static_assert(WS_W + 4 * LAYER_W <= WS_H && WS_H + (size_t)MGMAX * D * 2 <= WS_AB && WS_AB + (size_t)MGMAX * D * 2 <= WS_P && WS_P + (size_t)MGMAX * N1 * 2 <= WS_ACT && WS_ACT + (size_t)MGMAX * DFF * 2 <= WS_DS && WS_DS + (size_t)32 * 8 * 16384 * 4 <= WS_DD, "ws map");
constexpr int LDS_BYTES = 147456;

__device__ __forceinline__ unsigned cvt_pk_bf16(float lo, float hi) { unsigned r; asm volatile("v_cvt_pk_bf16_f32 %0, %1, %2" : "=v"(r) : "v"(lo), "v"(hi)); return r; }
__device__ __forceinline__ float bf2f(unsigned short b) { return __uint_as_float(((unsigned)b) << 16); }
__device__ __forceinline__ float bflo(unsigned w) { return __uint_as_float(w << 16); }
__device__ __forceinline__ float bfhi(unsigned w) { return __uint_as_float(w & 0xffff0000u); }
__device__ __forceinline__ float fsigmoid(float x) { return __builtin_amdgcn_rcpf(1.f + __expf(-x)); }
template <int CTRL> __device__ __forceinline__ float dpp_rot(float v) { return __builtin_bit_cast(float, __builtin_amdgcn_update_dpp(0, __builtin_bit_cast(int, v), CTRL, 0xf, 0xf, true)); }
__device__ __forceinline__ float sum16(float x) { x += dpp_rot<0x128>(x); x += dpp_rot<0x124>(x); x += dpp_rot<0x122>(x); x += dpp_rot<0x121>(x); return x; }
__device__ __forceinline__ float wave_sum(float v) { v = sum16(v); v += __shfl_xor(v, 16); v += __shfl_xor(v, 32); return v; }

namespace pg8 {
constexpr int BM = 256, BK = 64, HALF = 128, HTB = HALF * BK * 2, STAGE_BYTES = 8 * HTB, NXCD = 8, WGM = 8;
__host__ __device__ __forceinline__ int lds_byte(int r, int c) { const int st = (r >> 4) * 2 + (c >> 5), rr = r & 15, cc = c & 31, ob = rr * 64 + cc * 2; return st * 1024 + (ob ^ (((ob >> 9) & 1) << 5)); }
__host__ __device__ __forceinline__ void stage_rc(int b, int& R, int& C) { const int st = b / 1024, sb = b % 1024, swz = sb ^ (((sb >> 9) & 1) << 5); R = (st >> 1) * 16 + swz / 64; C = (st & 1) * 32 + (swz % 64) / 2; }
__host__ __device__ __forceinline__ int perm32(int rho) { const int n = rho >> 4, i = rho & 15; return 8 * (i >> 2) + 4 * n + (i & 3); }
struct Unit { int pm, pn; };
struct Gemm { const bf16_t* A; const bf16_t* Bt; int lda, ldb, K; int mstride = 256; int arow0 = 0; };
struct StaticOrder {
    int nM, nN, nwg, G, c;
    __device__ void init(int nM_, int nN_, int G_, int c_) { nM = nM_; nN = nN_; nwg = nM * nN; G = G_; c = c_; }
    __device__ bool next(int i, Unit& u) const {
        const long L = (long)i * G + c; if (L >= nwg) return false;
        int wgid = (int)L; { const int q = nwg / NXCD, r = nwg % NXCD, xcd = wgid % NXCD, off = wgid / NXCD; wgid = (xcd < r ? xcd * (q + 1) : r * (q + 1) + (xcd - r) * q) + off; }
        const int nig = WGM * nN, gid = wgid / nig, fm = gid * WGM, gsz = (nM - fm) < WGM ? (nM - fm) : WGM;
        u.pm = fm + ((wgid % nig) % gsz); u.pn = (wgid % nig) / gsz; return true;
    }
};
template <class Epi>
__device__ __forceinline__ void gemm_phase(LAS unsigned char* lds, const Gemm g, const StaticOrder& S, const Epi& E) {
    int tid = threadIdx.x; asm volatile("" : "+v"(tid));
    const int wid = __builtin_amdgcn_readfirstlane(tid >> 6), lane = tid & 63, wr = wid >> 2, wc = wid & 3, fr = lane & 15, fq = lane >> 4;
    const int K = g.K, nt = K / BK;
    unsigned voffA[2], voffB[2];
#pragma unroll
    for (int i = 0; i < 2; ++i) { int R, C; stage_rc(tid * 16 + i * 8192, R, C); const int Rb = (R & ~31) + perm32(R & 31);
        voffA[i] = (unsigned)(R * g.lda + C) * 2u; voffB[i] = (unsigned)(Rb * g.ldb + C) * 2u; }
    const size_t kstep = (size_t)(BK * 2);
    const size_t hstepA = (size_t)HALF * g.lda * 2, hstepB = (size_t)HALF * g.ldb * 2;
    const long tstepA = (long)g.mstride * g.lda * 2, tstepB = (long)(2 * hstepB); const long abase0 = (long)g.arow0 * g.lda * 2;
    const unsigned ldsw = (unsigned)wid * 1024u;
    const int aoff = lds_byte(wr * 64 + fr, fq * 8), boff = lds_byte(wc * 32 + fr, fq * 8);
#define PG8_SA(b, h) (((b) * 2 + (h)) * HTB)
#define PG8_SB(b, h) ((4 + (b) * 2 + (h)) * HTB)
#define PG8_STAGE(bufoff, gbase, voff) do { _Pragma("unroll") for (int _i = 0; _i < 2; ++_i) \
        __builtin_amdgcn_global_load_lds((const unsigned*)((const char*)(gbase) + (voff)[_i]), (LAS unsigned*)(lds + (bufoff) + ldsw + _i * 8192), 16, 0, 0); } while (0)
#define PG8_LDA(dst, b, h) do { _Pragma("unroll") for (int m = 0; m < 4; ++m) _Pragma("unroll") for (int k = 0; k < 2; ++k) dst[m][k] = *(const LAS bf16x8*)(lds + PG8_SA(b, h) + aoff + m * 2048 + k * 1024); } while (0)
#define PG8_LDB(dst, b, h) do { _Pragma("unroll") for (int n = 0; n < 2; ++n) _Pragma("unroll") for (int k = 0; k < 2; ++k) dst[n][k] = *(const LAS bf16x8*)(lds + PG8_SB(b, h) + boff + n * 2048 + k * 1024); } while (0)
#define PG8_MMA(ai, bj, At, Bt) do { __builtin_amdgcn_s_setprio(1); _Pragma("unroll") for (int m = 0; m < 4; ++m) _Pragma("unroll") for (int n = 0; n < 2; ++n) _Pragma("unroll") for (int k = 0; k < 2; ++k) \
        acc[ai][bj][m][n] = __builtin_amdgcn_mfma_f32_16x16x32_bf16(Bt[n][k], At[m][k], acc[ai][bj][m][n], 0, 0, 0); __builtin_amdgcn_s_setprio(0); } while (0)
#define PG8_WAIT_V(n) asm volatile("s_waitcnt vmcnt(" #n ")" ::: "memory")
#define PG8_WAIT_L(n) asm volatile("s_waitcnt lgkmcnt(" #n ")" ::: "memory")
#define PG8_BAR __builtin_amdgcn_s_barrier()
#define PG8_SCHED __builtin_amdgcn_sched_barrier(0)
    Unit cur, nxt; int ui = 0;
    if (!S.next(0, cur)) return;
    f32x4 acc[2][2][4][2];
#pragma unroll
    for (int a = 0; a < 2; ++a)
#pragma unroll
        for (int b = 0; b < 2; ++b)
#pragma unroll
            for (int m = 0; m < 4; ++m)
#pragma unroll
                for (int n = 0; n < 2; ++n) acc[a][b][m][n] = (f32x4){0.f, 0.f, 0.f, 0.f};
    bf16x8 At[4][2], B0[2][2], B1[2][2];
    const char* cA = (const char*)g.A + abase0 + (long)cur.pm * tstepA; const char* cB = (const char*)g.Bt + (long)cur.pn * tstepB;
    PG8_STAGE(PG8_SB(0, 0), cB, voffB); PG8_STAGE(PG8_SB(0, 1), cB + hstepB, voffB); PG8_STAGE(PG8_SA(0, 0), cA, voffA); PG8_STAGE(PG8_SA(0, 1), cA + hstepA, voffA);
    if (wr == 1) PG8_BAR;
    PG8_WAIT_V(2); PG8_BAR;
    PG8_STAGE(PG8_SB(1, 0), cB + kstep, voffB); PG8_STAGE(PG8_SA(1, 0), cA + kstep, voffA); PG8_STAGE(PG8_SB(1, 1), cB + hstepB + kstep, voffB);
    PG8_WAIT_V(6); PG8_BAR;
    for (;;) {
        const bool has_next = S.next(ui + 1, nxt);
        const char* nA = has_next ? (const char*)g.A + abase0 + (long)nxt.pm * tstepA : cA; const char* nB = has_next ? (const char*)g.Bt + (long)nxt.pn * tstepB : cB;
        for (int t = 0; t < nt; t += 2) {
            const bool last = (t == nt - 2);
            const char* a1 = cA + (size_t)(t + 1) * kstep;
            const char* a2 = last ? nA : cA + (size_t)(t + 2) * kstep; const char* b2 = last ? nB : cB + (size_t)(t + 2) * kstep;
            const char* a3 = a2 + kstep; const char* b3 = b2 + kstep;
            PG8_LDB(B0, 0, 0); PG8_LDB(B1, 0, 1); PG8_SCHED; PG8_LDA(At, 0, 0); PG8_STAGE(PG8_SA(1, 1), a1 + hstepA, voffA);
            PG8_WAIT_V(8); PG8_WAIT_L(0); PG8_BAR; PG8_MMA(0, 0, At, B0); PG8_MMA(0, 1, At, B1); PG8_BAR; PG8_SCHED;
            PG8_LDA(At, 0, 1); PG8_STAGE(PG8_SB(0, 0), b2, voffB); PG8_STAGE(PG8_SB(0, 1), b2 + hstepB, voffB); PG8_STAGE(PG8_SA(0, 0), a2, voffA);
            PG8_WAIT_V(8); PG8_WAIT_L(0); PG8_BAR; PG8_MMA(1, 0, At, B0); PG8_MMA(1, 1, At, B1); PG8_BAR; PG8_SCHED;
            PG8_LDB(B0, 1, 0); PG8_LDB(B1, 1, 1); PG8_SCHED; PG8_LDA(At, 1, 0); PG8_STAGE(PG8_SA(0, 1), a2 + hstepA, voffA);
            PG8_WAIT_V(8); PG8_WAIT_L(0); PG8_BAR; PG8_MMA(0, 0, At, B0); PG8_MMA(0, 1, At, B1); PG8_BAR; PG8_SCHED;
            PG8_LDA(At, 1, 1); PG8_STAGE(PG8_SB(1, 0), b3, voffB); PG8_STAGE(PG8_SB(1, 1), b3 + hstepB, voffB); PG8_STAGE(PG8_SA(1, 0), a3, voffA);
            PG8_WAIT_V(8); PG8_WAIT_L(0); PG8_BAR; PG8_MMA(1, 0, At, B0); PG8_MMA(1, 1, At, B1); PG8_BAR; PG8_SCHED;
        }
        if (wr == 0) PG8_BAR;
        E(acc, cur, wr, wc, fr, fq);
        if (!has_next) break;
#pragma unroll
        for (int a = 0; a < 2; ++a)
#pragma unroll
            for (int b = 0; b < 2; ++b)
#pragma unroll
                for (int m = 0; m < 4; ++m)
#pragma unroll
                    for (int n = 0; n < 2; ++n) acc[a][b][m][n] = (f32x4){0.f, 0.f, 0.f, 0.f};
        cur = nxt; cA = nA; cB = nB; ++ui;
        if (wr == 1) PG8_BAR;
    }
    PG8_WAIT_V(0);
    PG8_BAR;
#undef PG8_SA
#undef PG8_SB
#undef PG8_STAGE
#undef PG8_LDA
#undef PG8_LDB
#undef PG8_MMA
#undef PG8_WAIT_V
#undef PG8_WAIT_L
#undef PG8_BAR
#undef PG8_SCHED
}

struct EpiStore {
    bf16_t* O; int ldc; int kind;
    __device__ __forceinline__ void operator()(const f32x4 (&acc)[2][2][4][2], const Unit& u, int wr, int wc, int fr, int fq) const {
        const int row0 = u.pm * BM + wr * 64 + fr, col0 = u.pn * BM + wc * 32 + 8 * fq;
        int act = 0;
        if (kind == 1) { const int pn = u.pn; act = (pn < 2 || pn == 6 || pn == 7) ? 1 : (pn >= 14 ? 2 : 0); }
#pragma unroll
        for (int ai = 0; ai < 2; ++ai)
#pragma unroll
            for (int m = 0; m < 4; ++m) { bf16_t* rowp = O + (size_t)(row0 + ai * HALF + m * 16) * ldc + col0;
#pragma unroll
                for (int bj = 0; bj < 2; ++bj) { f32x4 v0 = acc[ai][bj][m][0], v1 = acc[ai][bj][m][1];
                    if (act) {
#pragma unroll
                        for (int e = 0; e < 4; ++e) { const float s0 = fsigmoid(v0[e]), s1 = fsigmoid(v1[e]); v0[e] = (act == 1) ? v0[e] * s0 : s0; v1[e] = (act == 1) ? v1[e] * s1 : s1; }
                    }
                    u32x4 o; o.x = cvt_pk_bf16(v0[0], v0[1]); o.y = cvt_pk_bf16(v0[2], v0[3]); o.z = cvt_pk_bf16(v1[0], v1[1]); o.w = cvt_pk_bf16(v1[2], v1[3]);
                    *(u32x4*)(rowp + bj * HALF) = o; } }
    }
};
struct EpiGate {
    bf16_t* O; const bf16_t* Gt; int accum;
    __device__ __forceinline__ void operator()(const f32x4 (&acc)[2][2][4][2], const Unit& u, int wr, int wc, int fr, int fq) const {
        const int row0 = u.pm * BM + wr * 64 + fr, col0 = u.pn * BM + wc * 32 + 8 * fq;
#pragma unroll
        for (int ai = 0; ai < 2; ++ai) {
            u32x4 gv[4][2], ov[4][2];
#pragma unroll
            for (int m = 0; m < 4; ++m)
#pragma unroll
                for (int bj = 0; bj < 2; ++bj) { const size_t r = (size_t)(row0 + ai * HALF + m * 16); const int c = col0 + bj * HALF;
                    gv[m][bj] = *(const u32x4*)(Gt + r * N1 + c); ov[m][bj] = accum ? *(const u32x4*)(O + r * D + c) : (u32x4){0u, 0u, 0u, 0u}; }
#pragma unroll
            for (int m = 0; m < 4; ++m)
#pragma unroll
                for (int bj = 0; bj < 2; ++bj) { const size_t r = (size_t)(row0 + ai * HALF + m * 16); const int c = col0 + bj * HALF;
                    const u32x4 g = gv[m][bj], o0 = ov[m][bj];
                    f32x4 v0 = acc[ai][bj][m][0], v1 = acc[ai][bj][m][1];
                    v0[0] = v0[0] * bflo(g.x) + bflo(o0.x); v0[1] = v0[1] * bfhi(g.x) + bfhi(o0.x); v0[2] = v0[2] * bflo(g.y) + bflo(o0.y); v0[3] = v0[3] * bfhi(g.y) + bfhi(o0.y);
                    v1[0] = v1[0] * bflo(g.z) + bflo(o0.z); v1[1] = v1[1] * bfhi(g.z) + bfhi(o0.z); v1[2] = v1[2] * bflo(g.w) + bflo(o0.w); v1[3] = v1[3] * bfhi(g.w) + bfhi(o0.w);
                    u32x4 o; o.x = cvt_pk_bf16(v0[0], v0[1]); o.y = cvt_pk_bf16(v0[2], v0[3]); o.z = cvt_pk_bf16(v1[0], v1[1]); o.w = cvt_pk_bf16(v1[2], v1[3]);
                    *(u32x4*)(O + r * D + c) = o; }
        }
    }
};

struct EpiFfn {
    bf16_t* ACT; const float* cw; const float* stin; float* stout_p; float* stout_s; int R0, MG, l; LAS float* halo;
    __device__ __forceinline__ void operator()(const f32x4 (&acc)[2][2][4][2], const Unit& u, int wr, int wc, int fr, int fq) const {
        const int colg = u.pn * 128 + wc * 32 + 8 * fq;
        if (fr >= 14) {
#pragma unroll
            for (int ai = 0; ai < 2; ++ai) { LAS float* hp = halo + ((ai * 2 + wr) * 2 + (fr - 14)) * 128 + wc * 32 + 8 * fq; *(LAS f32x4*)hp = acc[ai][0][3][0]; *(LAS f32x4*)(hp + 4) = acc[ai][0][3][1]; }
        }
        asm volatile("s_waitcnt lgkmcnt(0)" ::: "memory"); __builtin_amdgcn_s_barrier(); asm volatile("" ::: "memory");
        const int lane = fq * 16 + fr, src1 = (lane & 48) | ((fr + 15) & 15), src2 = (lane & 48) | ((fr + 14) & 15);
#pragma unroll
        for (int n = 0; n < 2; ++n) {
            const int col = colg + 4 * n;
            const f32x4 w0 = *(const f32x4*)(cw + col), w1 = *(const f32x4*)(cw + DFF + col), w2 = *(const f32x4*)(cw + 2 * DFF + col);
#pragma unroll
            for (int ai = 0; ai < 2; ++ai)
#pragma unroll
                for (int m = 0; m < 4; ++m) {
                    const int rho = 128 * ai + 64 * wr + 16 * m + fr, Rl = u.pm * 254 - 2 + rho, R = R0 + Rl;
                    const bool valid = (rho >= 2) && (Rl < MG);
                    int t, Lq, sq; const bool smp = (R >= MP);
                    if (!smp) { t = R & (SEQ - 1); Lq = SEQ; sq = R >> 12; } else { const int Rs = R - MP; t = Rs & 15; Lq = DSEQ; sq = Rs >> 4; }
                    const f32x4 g4 = acc[ai][0][m][n];
                    const f32x4 gm = acc[ai][0][m > 0 ? m - 1 : 0][n];
                    f32x4 p1, p2;
#pragma unroll
                    for (int e = 0; e < 4; ++e) { const float s1 = (m > 0 && fr == 15) ? gm[e] : g4[e], s2 = (m > 0 && fr >= 14) ? gm[e] : g4[e]; p1[e] = dpp_rot<0x121>(s1); p2[e] = dpp_rot<0x122>(s2); }
                    if (m == 0) { const int pb = ai * 2 + wr - 1;
                        if (pb >= 0 && fr < 2) { const LAS float* h0 = halo + (pb * 2) * 128 + wc * 32 + 8 * fq + 4 * n;
                            const f32x4 x0 = *(const LAS f32x4*)h0, y0 = *(const LAS f32x4*)(h0 + 128);
                            if (fr == 0) { p1 = y0; p2 = x0; } else { p2 = y0; } } }
                    if (valid && t < 2) {
                        f32x4 s0v = (f32x4){0.f, 0.f, 0.f, 0.f}, s1v = s0v;
                        if (smp) { const float* sp = stin + (size_t)((l * 16 + sq) * 2) * DFF + col; s0v = *(const f32x4*)sp; s1v = *(const f32x4*)(sp + DFF); }
                        if (t == 0) { p1 = s1v; p2 = s0v; } else { p2 = s1v; }
                    }
                    if (valid) {
                        const f32x4 v4 = acc[ai][1][m][n];
                        float o[4];
#pragma unroll
                        for (int e = 0; e < 4; ++e) { const float y = w0[e] * p2[e] + w1[e] * p1[e] + w2[e] * g4[e]; o[e] = y * fsigmoid(y) * v4[e]; }
                        u32x2 ov; ov.x = cvt_pk_bf16(o[0], o[1]); ov.y = cvt_pk_bf16(o[2], o[3]);
                        *(u32x2*)(ACT + (size_t)Rl * DFF + col) = ov;
                        if (t >= Lq - 2) *(f32x4*)((smp ? stout_s : stout_p) + (size_t)((l * 16 + sq) * 2 + (t - (Lq - 2))) * DFF + col) = g4;
                    }
                }
        }
    }
};
}

struct Args { const float* in[24]; float* out; unsigned char* ws; };

__device__ __forceinline__ void transpose_item(const float* W, int K, int N, bf16_t* WT, int row_off, LAS float* scr, int item, int lane) {
    const int nblk = N / 32, kb = item / nblk, nb = item % nblk, k0 = 64 * kb, n0 = 32 * nb;
#pragma unroll 8
    for (int i = 0; i < 32; ++i) { const int kk = 2 * i + (lane >> 5); scr[kk * 33 + (lane & 31)] = W[(size_t)(k0 + kk) * N + n0 + (lane & 31)]; }
    asm volatile("s_waitcnt lgkmcnt(0)" ::: "memory");
    const int c = lane & 7;
#pragma unroll
    for (int j = 0; j < 4; ++j) { const int n = (lane >> 3) + 8 * j; const LAS float* s = scr + (8 * c) * 33 + n;
        u32x4 o; o.x = cvt_pk_bf16(s[0 * 33], s[1 * 33]); o.y = cvt_pk_bf16(s[2 * 33], s[3 * 33]); o.z = cvt_pk_bf16(s[4 * 33], s[5 * 33]); o.w = cvt_pk_bf16(s[6 * 33], s[7 * 33]);
        *(u32x4*)(WT + (size_t)(row_off + n0 + n) * K + k0 + 8 * c) = o; }
    asm volatile("s_waitcnt lgkmcnt(0)" ::: "memory");
}

__device__ __forceinline__ void row_pass(const bf16_t* mrow  , const float* xin, const bf16_t* xin_b, float* xout, bf16_t* xout_b, const float* gpost, const float* gate,
                                         bf16_t* hrow  , const float* gpre, const float* sc, const float* sh, int lane) {
    float xv[2][8];
    if (xin_b) {
#pragma unroll
        for (int j = 0; j < 2; ++j) { const u32x4 w = *(const u32x4*)(xin_b + 512 * j + 8 * lane);
            xv[j][0] = bflo(w.x); xv[j][1] = bfhi(w.x); xv[j][2] = bflo(w.y); xv[j][3] = bfhi(w.y); xv[j][4] = bflo(w.z); xv[j][5] = bfhi(w.z); xv[j][6] = bflo(w.w); xv[j][7] = bfhi(w.w); }
    } else {
#pragma unroll
        for (int j = 0; j < 2; ++j) { const int c0 = 512 * j + 8 * lane; const f32x4 a = *(const f32x4*)(xin + c0), b = *(const f32x4*)(xin + c0 + 4);
            xv[j][0] = a[0]; xv[j][1] = a[1]; xv[j][2] = a[2]; xv[j][3] = a[3]; xv[j][4] = b[0]; xv[j][5] = b[1]; xv[j][6] = b[2]; xv[j][7] = b[3]; }
    }
    if (mrow) {
        float mv[2][8]; float ss = 0.f;
#pragma unroll
        for (int j = 0; j < 2; ++j) { const u32x4 w = *(const u32x4*)(mrow + 512 * j + 8 * lane);
            mv[j][0] = bflo(w.x); mv[j][1] = bfhi(w.x); mv[j][2] = bflo(w.y); mv[j][3] = bfhi(w.y); mv[j][4] = bflo(w.z); mv[j][5] = bfhi(w.z); mv[j][6] = bflo(w.w); mv[j][7] = bfhi(w.w);
#pragma unroll
            for (int e = 0; e < 8; ++e) ss += mv[j][e] * mv[j][e]; }
        const float rstd = __builtin_amdgcn_rsqf(wave_sum(ss) * (1.f / D) + EPS);
#pragma unroll
        for (int j = 0; j < 2; ++j) { const int c0 = 512 * j + 8 * lane;
            const f32x4 g0 = *(const f32x4*)(gpost + c0), g1 = *(const f32x4*)(gpost + c0 + 4), t0 = *(const f32x4*)(gate + c0), t1 = *(const f32x4*)(gate + c0 + 4);
#pragma unroll
            for (int e = 0; e < 4; ++e) { xv[j][e] += t0[e] * (mv[j][e] * rstd * g0[e]); xv[j][4 + e] += t1[e] * (mv[j][4 + e] * rstd * g1[e]); }
            if (xout_b) { u32x4 o; o.x = cvt_pk_bf16(xv[j][0], xv[j][1]); o.y = cvt_pk_bf16(xv[j][2], xv[j][3]); o.z = cvt_pk_bf16(xv[j][4], xv[j][5]); o.w = cvt_pk_bf16(xv[j][6], xv[j][7]); *(u32x4*)(xout_b + c0) = o;
            } else { *(f32x4*)(xout + c0) = (f32x4){xv[j][0], xv[j][1], xv[j][2], xv[j][3]}; *(f32x4*)(xout + c0 + 4) = (f32x4){xv[j][4], xv[j][5], xv[j][6], xv[j][7]}; } }
    }
    if (hrow) {
        float ss = 0.f;
#pragma unroll
        for (int j = 0; j < 2; ++j)
#pragma unroll
            for (int e = 0; e < 8; ++e) ss += xv[j][e] * xv[j][e];
        const float rstd = __builtin_amdgcn_rsqf(wave_sum(ss) * (1.f / D) + EPS);
#pragma unroll
        for (int j = 0; j < 2; ++j) { const int c0 = 512 * j + 8 * lane; float hv[8];
            const f32x4 g0 = *(const f32x4*)(gpre + c0), g1 = *(const f32x4*)(gpre + c0 + 4), s0 = *(const f32x4*)(sc + c0), s1 = *(const f32x4*)(sc + c0 + 4), h0 = *(const f32x4*)(sh + c0), h1 = *(const f32x4*)(sh + c0 + 4);
#pragma unroll
            for (int e = 0; e < 4; ++e) { hv[e] = xv[j][e] * rstd * g0[e] * (1.f + s0[e]) + h0[e]; hv[4 + e] = xv[j][4 + e] * rstd * g1[e] * (1.f + s1[e]) + h1[e]; }
            u32x4 o; o.x = cvt_pk_bf16(hv[0], hv[1]); o.y = cvt_pk_bf16(hv[2], hv[3]); o.z = cvt_pk_bf16(hv[4], hv[5]); o.w = cvt_pk_bf16(hv[6], hv[7]);
            *(u32x4*)(hrow + c0) = o; }
    }
}
__device__ __forceinline__ int row_batch(int R) { return R < MP ? (R >> 12) : 16 + ((R - MP) >> 4); }

template <bool FULL>
__device__ __forceinline__ void hgrn_item(LAS unsigned char* lds, const bf16_t* P, bf16_t* AB, int L, int hd, const float* lbv, const float* anorm, const float* S0, const float* Dd, int ns, float* Sout, float* Dout) {
    int tid = threadIdx.x; asm volatile("" : "+v"(tid));
    const int w = tid >> 6, lane = tid & 63, q4 = lane >> 4, c16 = lane & 15;
    const int k = tid & 127, tq = tid >> 7;
    LAS bf16_t* Qt = (LAS bf16_t*)lds;
    LAS bf16_t* Kt = Qt + 16 * 136;
    LAS bf16_t* KhT = Kt + 16 * 136;
    LAS bf16_t* VsT = KhT + 128 * 20;
    LAS float* dvec = (LAS float*)(VsT + 128 * 20);
    LAS float* qsum = dvec + 128;
    LAS float* ssq = qsum + 512;
    const float lb = lbv[k], oml = 1.f - lb;
    const float an = FULL ? anorm[16 * w + c16] : 0.f;
    f32x4 accS[8];
#pragma unroll
    for (int mt = 0; mt < 8; ++mt) accS[mt] = (f32x4){0.f, 0.f, 0.f, 0.f};
    if (Dd) {
#pragma unroll 2
        for (int c = 0; c < ns; ++c) { const float* sc = S0 + (size_t)c * 16384 + tid;
#pragma unroll
            for (int mt = 0; mt < 8; ++mt) { const f32x4 d4 = *(const f32x4*)(Dd + c * 128 + 16 * mt + 4 * q4);
#pragma unroll
                for (int j = 0; j < 4; ++j) accS[mt][j] = accS[mt][j] * d4[j] + sc[(mt * 4 + j) * 512]; } }
    } else {
        for (int c = 0; c < ns; ++c) { const float* sc = S0 + (size_t)c * 16384 + 16 * w + c16;
#pragma unroll
            for (int mt = 0; mt < 8; ++mt)
#pragma unroll
                for (int j = 0; j < 4; ++j) accS[mt][j] = sc[(size_t)(16 * mt + 4 * q4 + j) * 128]; }
    }
    const bf16_t* pq = P + 128 * hd + k + (size_t)(4 * tq) * N1;
    const bf16_t* pz = pq + 512;
    const int vt = (tid >> 4) & 15, vc = tid & 15;
    const bf16_t* pv = P + 1024 + 128 * hd + 8 * vc + (size_t)vt * N1;
    const bf16_t* pg = P + 1536 + 128 * hd + 16 * w + c16 + (size_t)(4 * q4) * N1;
    bf16_t* po = AB + 128 * hd + 16 * w + c16 + (size_t)(4 * q4) * D;
    const int nsteps = L >> 4;
    float btot = 0.f;
    unsigned short zr[4], qr[4], grn[4]; u32x4 vr = (u32x4){0u, 0u, 0u, 0u};
#pragma unroll
    for (int i = 0; i < 4; ++i) { zr[i] = pz[(size_t)i * N1]; qr[i] = pq[(size_t)i * N1]; grn[i] = pg[(size_t)i * N1]; }
    if (tid < 256) vr = *(const u32x4*)pv;
    for (int n = 0; n < nsteps; ++n) {
        unsigned short zc[4], qc[4], gr[4]; const u32x4 vcur = vr;
#pragma unroll
        for (int i = 0; i < 4; ++i) { zc[i] = zr[i]; qc[i] = qr[i]; gr[i] = grn[i]; }
        const size_t roff = (size_t)(16 * n) * N1;
        {
            const size_t nro = (size_t)(16 * (n + 1 < nsteps ? n + 1 : n)) * N1;
#pragma unroll
            for (int i = 0; i < 4; ++i) { zr[i] = pz[nro + (size_t)i * N1]; qr[i] = pq[nro + (size_t)i * N1]; grn[i] = pg[nro + (size_t)i * N1]; }
            if (tid < 256) vr = *(const u32x4*)(pv + nro);
        }
        float cs[4], kk[4], qv[4];
        {
            float run = 0.f;
#pragma unroll
            for (int i = 0; i < 4; ++i) { float z = bf2f(zc[i]); z = fminf(fmaxf(z, -30.f), 30.f); const float e = __expf(-z), sg = __builtin_amdgcn_rcpf(1.f + e), sn = e * sg;
                const float f = lb + oml * sg; run += __builtin_amdgcn_logf(f) * 0.69314718056f; cs[i] = run; kk[i] = oml * sn; qv[i] = bf2f(qc[i]); }
            qsum[tq * 128 + k] = run;
        }
        __syncthreads();
        {
            float pre = 0.f, tot = 0.f;
#pragma unroll
            for (int j = 0; j < 4; ++j) { const float v = qsum[j * 128 + k]; tot += v; pre += (j < tq) ? v : 0.f; }
            btot += tot;
            float kh[4];
#pragma unroll
            for (int i = 0; i < 4; ++i) { const float b = pre + cs[i]; const float qt = qv[i] * __expf(b), kt = kk[i] * __expf(fminf(-b, 80.f)); kh[i] = kk[i] * __expf(tot - b);
                Qt[(4 * tq + i) * 136 + k] = (bf16_t)(cvt_pk_bf16(qt, 0.f) & 0xffffu); Kt[(4 * tq + i) * 136 + k] = (bf16_t)(cvt_pk_bf16(kt, 0.f) & 0xffffu); }
            u32x2 kp; kp.x = cvt_pk_bf16(kh[0], kh[1]); kp.y = cvt_pk_bf16(kh[2], kh[3]);
            *(LAS u32x2*)(KhT + k * 20 + 4 * tq) = kp;
            if (tq == 0) dvec[k] = __expf(tot);
            if (tid < 256) {
                VsT[(8 * vc + 0) * 20 + vt] = (bf16_t)(vcur.x & 0xffffu); VsT[(8 * vc + 1) * 20 + vt] = (bf16_t)(vcur.x >> 16);
                VsT[(8 * vc + 2) * 20 + vt] = (bf16_t)(vcur.y & 0xffffu); VsT[(8 * vc + 3) * 20 + vt] = (bf16_t)(vcur.y >> 16);
                VsT[(8 * vc + 4) * 20 + vt] = (bf16_t)(vcur.z & 0xffffu); VsT[(8 * vc + 5) * 20 + vt] = (bf16_t)(vcur.z >> 16);
                VsT[(8 * vc + 6) * 20 + vt] = (bf16_t)(vcur.w & 0xffffu); VsT[(8 * vc + 7) * 20 + vt] = (bf16_t)(vcur.w >> 16);
            }
        }
        __syncthreads();
        f32x4 acco = (f32x4){0.f, 0.f, 0.f, 0.f};
        {
            const u32x2 vv = *(const LAS u32x2*)(VsT + (16 * w + c16) * 20 + 4 * q4);
            const bf16x4 vf = __builtin_bit_cast(bf16x4, vv);
            if (FULL) {
            bf16x8 qf[4], kf[4];
#pragma unroll
            for (int kq = 0; kq < 4; ++kq) {
                const u32x2 a0 = *(const LAS u32x2*)(Qt + c16 * 136 + 32 * kq + 4 * q4), a1 = *(const LAS u32x2*)(Qt + c16 * 136 + 32 * kq + 16 + 4 * q4);
                const u32x2 b0 = *(const LAS u32x2*)(Kt + c16 * 136 + 32 * kq + 4 * q4), b1 = *(const LAS u32x2*)(Kt + c16 * 136 + 32 * kq + 16 + 4 * q4);
                u32x4 qa = (u32x4){a0.x, a0.y, a1.x, a1.y}, ka = (u32x4){b0.x, b0.y, b1.x, b1.y};
                qf[kq] = __builtin_bit_cast(bf16x8, qa); kf[kq] = __builtin_bit_cast(bf16x8, ka);
            }
            f32x4 accA = (f32x4){0.f, 0.f, 0.f, 0.f};
#pragma unroll
            for (int kq = 0; kq < 4; ++kq) accA = __builtin_amdgcn_mfma_f32_16x16x32_bf16(kf[kq], qf[kq], accA, 0, 0, 0);
#pragma unroll
            for (int j = 0; j < 4; ++j) accA[j] = (c16 >= 4 * q4 + j) ? accA[j] : 0.f;
            u32x2 pa; pa.x = cvt_pk_bf16(accA[0], accA[1]); pa.y = cvt_pk_bf16(accA[2], accA[3]);
            const bf16x4 pA = __builtin_bit_cast(bf16x4, pa);
            acco = __builtin_amdgcn_mfma_f32_16x16x16bf16_1k(pA, vf, (f32x4){0.f, 0.f, 0.f, 0.f}, 0, 0, 0);
#pragma unroll
            for (int kq = 0; kq < 4; ++kq) {
                u32x4 sp; sp.x = cvt_pk_bf16(accS[2 * kq][0], accS[2 * kq][1]); sp.y = cvt_pk_bf16(accS[2 * kq][2], accS[2 * kq][3]);
                sp.z = cvt_pk_bf16(accS[2 * kq + 1][0], accS[2 * kq + 1][1]); sp.w = cvt_pk_bf16(accS[2 * kq + 1][2], accS[2 * kq + 1][3]);
                acco = __builtin_amdgcn_mfma_f32_16x16x32_bf16(qf[kq], __builtin_bit_cast(bf16x8, sp), acco, 0, 0, 0);
            }
            }
#pragma unroll
            for (int mt = 0; mt < 8; ++mt) {
                const u32x2 kh2 = *(const LAS u32x2*)(KhT + (16 * mt + c16) * 20 + 4 * q4);
                const f32x4 d4 = *(const LAS f32x4*)(dvec + 16 * mt + 4 * q4);
                accS[mt] = accS[mt] * d4;
                accS[mt] = __builtin_amdgcn_mfma_f32_16x16x16bf16_1k(__builtin_bit_cast(bf16x4, kh2), vf, accS[mt], 0, 0, 0);
            }
            if (FULL) {
            const float s0 = sum16(acco[0] * acco[0]), s1 = sum16(acco[1] * acco[1]), s2 = sum16(acco[2] * acco[2]), s3 = sum16(acco[3] * acco[3]);
            if (c16 == 0) { *(LAS f32x4*)(ssq + w * 16 + 4 * q4) = (f32x4){s0, s1, s2, s3}; }
            }
        }
        if (FULL) __syncthreads();
        if (FULL) {
            f32x4 tot = (f32x4){0.f, 0.f, 0.f, 0.f};
#pragma unroll
            for (int ww = 0; ww < 8; ++ww) tot += *(const LAS f32x4*)(ssq + ww * 16 + 4 * q4);
#pragma unroll
            for (int j = 0; j < 4; ++j) { const float rstd = __builtin_amdgcn_rsqf(tot[j] * (1.f / 128.f) + EPS); const float o = acco[j] * rstd * an * bf2f(gr[j]);
                po[(size_t)(16 * n + j) * D] = (bf16_t)(cvt_pk_bf16(o, 0.f) & 0xffffu); }
        }
    }
    if (Sout) {
        if (Dout) {
#pragma unroll
            for (int mt = 0; mt < 8; ++mt)
#pragma unroll
                for (int j = 0; j < 4; ++j) Sout[(mt * 4 + j) * 512 + tid] = accS[mt][j];
        } else {
#pragma unroll
            for (int mt = 0; mt < 8; ++mt)
#pragma unroll
                for (int j = 0; j < 4; ++j) Sout[(size_t)(16 * mt + 4 * q4 + j) * 128 + 16 * w + c16] = accS[mt][j];
        }
    }
    if (Dout && tid < 128) Dout[tid] = __expf(btot);
    __syncthreads();
}

__device__ __forceinline__ void unpack8(const u32x4 w, float (&v)[8]) { v[0] = bflo(w.x); v[1] = bfhi(w.x); v[2] = bflo(w.y); v[3] = bfhi(w.y); v[4] = bflo(w.z); v[5] = bfhi(w.z); v[6] = bflo(w.w); v[7] = bfhi(w.w); }
__device__ __forceinline__ u32x4 pack8(const float (&v)[8]) { u32x4 o; o.x = cvt_pk_bf16(v[0], v[1]); o.y = cvt_pk_bf16(v[2], v[3]); o.z = cvt_pk_bf16(v[4], v[5]); o.w = cvt_pk_bf16(v[6], v[7]); return o; }
__device__ __forceinline__ void load8f(const float* p, float (&v)[8]) { const f32x4 a = *(const f32x4*)p, b = *(const f32x4*)(p + 4); v[0] = a[0]; v[1] = a[1]; v[2] = a[2]; v[3] = a[3]; v[4] = b[0]; v[5] = b[1]; v[6] = b[2]; v[7] = b[3]; }
__device__ __forceinline__ void store8f(float* p, const float (&v)[8]) { *(f32x4*)p = (f32x4){v[0], v[1], v[2], v[3]}; *(f32x4*)(p + 4) = (f32x4){v[4], v[5], v[6], v[7]}; }

__device__ __forceinline__ void shortconv_phase(const Args& a, int l, int R0, int MG, const bf16_t* P, bf16_t* AB, unsigned* ctr, volatile LAS unsigned* bcast) {
    const float* cw = a.in[17] + (size_t)l * 3 * BW;
    int tidc = threadIdx.x; asm volatile("" : "+v"(tidc));
    const int nconv = (MG / 8) * 64;
    for (;;) {
        __syncthreads();
        if (tidc == 0) *bcast = __hip_atomic_fetch_add(ctr, 512u, __ATOMIC_RELAXED, __HIP_MEMORY_SCOPE_AGENT);
        __syncthreads();
        const int it = (int)*bcast + tidc;
        if (it - tidc >= nconv) break;
        if (it >= nconv) continue;
        const int rb = it >> 6, ch = (it & 63) * 8, r0 = rb * 8, R = R0 + r0;
        int t0, Lq; const float* st_in = nullptr; float* st_out;
        if (R < MP) { t0 = R & (SEQ - 1); Lq = SEQ; st_out = a.out + O_SCP + (size_t)((l * 16 + (R >> 12)) * 2) * BW; }
        else { const int Rs = R - MP; t0 = Rs & 15; Lq = DSEQ; const int sq = Rs >> 4; st_in = a.in[3] + (size_t)((l * 16 + sq) * 2) * BW; st_out = a.out + O_SCS + (size_t)((l * 16 + sq) * 2) * BW; }
        float w0[8], w1[8], w2[8], p2[8], p1[8];
        load8f(cw + ch, w0); load8f(cw + BW + ch, w1); load8f(cw + 2 * BW + ch, w2);
        if (t0 == 0) {
            if (st_in) { load8f(st_in + ch, p2); load8f(st_in + BW + ch, p1); }
            else {
#pragma unroll
                for (int e = 0; e < 8; ++e) { p2[e] = 0.f; p1[e] = 0.f; } }
        } else {
            float c8[8], v8[8];
            unpack8(*(const u32x4*)(P + (size_t)(r0 - 2) * N1 + 2560 + ch), c8); unpack8(*(const u32x4*)(P + (size_t)(r0 - 2) * N1 + 3072 + ch), v8);
#pragma unroll
            for (int e = 0; e < 8; ++e) p2[e] = c8[e] * v8[e];
            unpack8(*(const u32x4*)(P + (size_t)(r0 - 1) * N1 + 2560 + ch), c8); unpack8(*(const u32x4*)(P + (size_t)(r0 - 1) * N1 + 3072 + ch), v8);
#pragma unroll
            for (int e = 0; e < 8; ++e) p1[e] = c8[e] * v8[e];
        }
#pragma unroll 2
        for (int i = 0; i < 8; ++i) {
            const bf16_t* pr = P + (size_t)(r0 + i) * N1;
            float b8[8], c8[8], v8[8], o8[8];
            unpack8(*(const u32x4*)(pr + 2048 + ch), b8); unpack8(*(const u32x4*)(pr + 2560 + ch), c8); unpack8(*(const u32x4*)(pr + 3072 + ch), v8);
#pragma unroll
            for (int e = 0; e < 8; ++e) { const float cv = c8[e] * v8[e]; o8[e] = b8[e] * (w0[e] * p2[e] + w1[e] * p1[e] + w2[e] * cv); p2[e] = p1[e]; p1[e] = cv; }
            *(u32x4*)(AB + (size_t)(r0 + i) * D + 512 + ch) = pack8(o8);
        }
        if (t0 + 8 == Lq) { store8f(st_out + ch, p2); store8f(st_out + BW + ch, p1); }
    }
}
#define XB_TMO      128
#define XB_XCNT(j)  (256  + 64 * (j))
#define XB_XSUB(j)  (1280 + 64 * (j))
#define XB_XGEN(j)  (2304 + 64 * (j))
#define XB_TOP      3328
#define XB_TOPGEN   3392
#define XCD_BAR_WORDS 3456
#define XB_SPIN_CAP (1u << 22)
__device__ __forceinline__ unsigned xb_ld(unsigned* p)              { return __hip_atomic_load(p, __ATOMIC_RELAXED, __HIP_MEMORY_SCOPE_AGENT); }
__device__ __forceinline__ unsigned xb_add(unsigned* p, unsigned v) { return __hip_atomic_fetch_add(p, v, __ATOMIC_RELAXED, __HIP_MEMORY_SCOPE_AGENT); }
__device__ __forceinline__ unsigned xb_xcc_id() { return (unsigned)__builtin_amdgcn_s_getreg((3 << 11) | 20) & 0xFu; }
#define XB_SPIN(cond, bar) do { unsigned _sp = 0; while (cond) { __builtin_amdgcn_s_sleep(1); \
    if ((++_sp & 255u) == 0u) { if (xb_ld(&(bar)[XB_TMO])) break; if (_sp > XB_SPIN_CAP) { atomicAdd(&(bar)[XB_TMO], 1u); break; } } } } while (0)
struct XcdBarrier { unsigned* bar; unsigned x; volatile LAS unsigned* st; };
__device__ __forceinline__ XcdBarrier xcd_barrier_post(unsigned* bar, volatile LAS unsigned* st) {
    XcdBarrier b; b.bar = bar; b.x = xb_xcc_id(); b.st = st;
    if (threadIdx.x == 0) (void)xb_add(&bar[XB_XCNT(b.x)], 1u);
    return b;
}
__device__ __forceinline__ void xcd_barrier_complete(unsigned* bar, unsigned x, unsigned& nloc, unsigned& nx) {
    const unsigned G = gridDim.x * gridDim.y * gridDim.z;
    unsigned sum, cnt, mine, sp = 0u;
    for (;;) {
        sum = 0u; cnt = 0u; mine = 0u;
#pragma unroll
        for (unsigned j = 0; j < 16; ++j) { const unsigned c = xb_ld(&bar[XB_XCNT(j)]); sum += c; cnt += (c > 0u) ? 1u : 0u; mine = (j == x) ? c : mine; }
        if (sum == G) break;
        __builtin_amdgcn_s_sleep(1);
        if ((++sp & 255u) == 0u) { if (xb_ld(&bar[XB_TMO])) break; if (sp > XB_SPIN_CAP) { atomicAdd(&bar[XB_TMO], 1u); break; } }
    }
    nloc = mine > 0u ? mine : 1u; nx = cnt > 0u ? cnt : 1u;
}
__device__ __forceinline__ void xcd_barrier(const XcdBarrier& b) {
    asm volatile("s_waitcnt vmcnt(0) lgkmcnt(0)" ::: "memory");
    __syncthreads();
    if (threadIdx.x == 0) {
        unsigned* bar = b.bar;
        __builtin_amdgcn_s_waitcnt(0);
        unsigned nloc = b.st[0], nx = b.st[1];
        if (nloc == 0u) { xcd_barrier_complete(bar, b.x, nloc, nx); b.st[0] = nloc; b.st[1] = nx; }
        const unsigned old = xb_add(&bar[XB_XSUB(b.x)], 1u);
        const unsigned gen = old / nloc;
        if (old + 1u == (gen + 1u) * nloc) {
            __builtin_amdgcn_fence(__ATOMIC_RELEASE, "agent");
            asm volatile("s_waitcnt vmcnt(0)" ::: "memory");
            const unsigned og = xb_add(&bar[XB_TOP], 1u);
            const unsigned tg = og / nx;
            if (og + 1u == (tg + 1u) * nx) xb_add(&bar[XB_TOPGEN], 1u);
            else XB_SPIN(xb_ld(&bar[XB_TOPGEN]) == tg, bar);
            __builtin_amdgcn_fence(__ATOMIC_ACQUIRE, "agent");
            xb_add(&bar[XB_XGEN(b.x)], 1u);
            asm volatile("s_waitcnt vmcnt(0)" ::: "memory");
        } else {
            XB_SPIN(xb_ld(&bar[XB_XGEN(b.x)]) == gen, bar);
            __builtin_amdgcn_fence(__ATOMIC_ACQUIRE, "agent");
            asm volatile("s_waitcnt vmcnt(0)" ::: "memory");
        }
    }
    __syncthreads();
}

#define GSYNC_CG() do { asm volatile("s_waitcnt vmcnt(0) lgkmcnt(0)" ::: "memory"); grid.sync(); } while (0)
#define GSYNC() xcd_barrier(xbar)
__global__ void __launch_bounds__(512, 2) fwd_megakernel(Args a) {
    extern __shared__ __attribute__((aligned(16))) unsigned char lds_raw[];
    LAS unsigned char* lds = (LAS unsigned char*)lds_raw;
    cg::grid_group grid = cg::this_grid();
    const int tid = threadIdx.x, lane = tid & 63, wave = __builtin_amdgcn_readfirstlane(tid >> 6);
    const int G = gridDim.x, wg = blockIdx.x;
    unsigned char* ws = a.ws;
    volatile LAS unsigned* MISC = (volatile LAS unsigned*)(lds + 131072 + 320);
    if (tid < 32) MISC[tid] = 0u;
    __syncthreads();
    const XcdBarrier xbar = xcd_barrier_post((unsigned*)ws + 4096, MISC + 8);
    float* ADA = (float*)(ws + WS_ADA);
    float* LB = (float*)(ws + WS_LB);
    bf16_t* Hb = (bf16_t*)(ws + WS_H);
    bf16_t* ABb = (bf16_t*)(ws + WS_AB);
    bf16_t* Pb = (bf16_t*)(ws + WS_P);
    bf16_t* ACTb = (bf16_t*)(ws + WS_ACT);
    bf16_t* XBb = (bf16_t*)(ws + WS_XB);

    if (wg < 192) {
        LAS float* csT = (LAS float*)lds;
        for (int i = tid; i < 32 * 1024; i += 512) { const int b = i >> 10, kx = i & 1023; const float c = (b < 16) ? a.in[5][(size_t)b * D + kx] : a.in[6][(size_t)(b - 16) * D + kx]; csT[kx * 32 + b] = c * fsigmoid(c); }
        __syncthreads();
        const int cc = tid & 127, kq = tid >> 7;
        const int col = wg * 128 + cc;
        const int l = col / 6144, n = col - l * 6144;
        const float* wp = a.in[7] + (size_t)l * D * 6144 + n;
        float acc[32];
#pragma unroll
        for (int b = 0; b < 32; ++b) acc[b] = 0.f;
#pragma unroll 4
        for (int kx = 256 * kq; kx < 256 * kq + 256; ++kx) { const float wv = wp[(size_t)kx * 6144];
#pragma unroll
            for (int b4 = 0; b4 < 8; ++b4) { const f32x4 c4 = *(const LAS f32x4*)(csT + kx * 32 + 4 * b4); acc[4 * b4] += c4[0] * wv; acc[4 * b4 + 1] += c4[1] * wv; acc[4 * b4 + 2] += c4[2] * wv; acc[4 * b4 + 3] += c4[3] * wv; } }
        __syncthreads();
        LAS float* red = (LAS float*)lds;
#pragma unroll
        for (int b = 0; b < 32; ++b) red[(kq * 32 + b) * 128 + cc] = acc[b];
        __syncthreads();
#pragma unroll
        for (int i = 0; i < 8; ++i) { const int o = tid + 512 * i, b = o >> 7, c2 = o & 127; const int col2 = wg * 128 + c2, n2 = col2 - l * 6144;
            const float v = red[(0 * 32 + b) * 128 + c2] + red[(1 * 32 + b) * 128 + c2] + red[(2 * 32 + b) * 128 + c2] + red[(3 * 32 + b) * 128 + c2];
            ADA[((size_t)l * 32 + b) * 6144 + n2] = v + a.in[8][(size_t)l * 6144 + n2]; }
        __syncthreads();
    }
    if (wg == 192) {
        const float x0 = a.in[14][tid], x1 = a.in[14][512 + tid], x2 = a.in[14][1024 + tid], x3 = a.in[14][1536 + tid];
        const float mx = fmaxf(fmaxf(x0, x1), fmaxf(x2, x3));
        const float e0 = __expf(x0 - mx), e1 = __expf(x1 - mx), e2 = __expf(x2 - mx), e3 = __expf(x3 - mx), inv = 1.f / (e0 + e1 + e2 + e3);
        LB[tid] = 0.f; LB[512 + tid] = e1 * inv; LB[1024 + tid] = (e1 + e2) * inv; LB[1536 + tid] = (e1 + e2 + e3) * inv;
    }
    {
        LAS float* scr = (LAS float*)(lds + wave * 16384);
        const int gw = wg * 8 + wave, NGW = G * 8;
        constexpr int I_IN = 16 * (NIN / 32), I_BG = 16 * (2048 / 32), I_PA = 8 * 32, I_PB = 8 * 32, I_O = 16 * 32, I_UP = 16 * (NUP / 32), I_DN = (DFF / 64) * 32;
        constexpr int I_LAYER = I_IN + I_BG + I_PA + I_PB + I_O + I_UP + I_DN;
        for (int it = gw; it < 4 * I_LAYER; it += NGW) {
            const int l = it / I_LAYER; int r = it - l * I_LAYER;
            bf16_t* wl = (bf16_t*)(ws + WS_W + (size_t)l * LAYER_W);
            if (r < I_IN) { transpose_item(a.in[13] + (size_t)l * D * NIN, D, NIN, wl + W1_OFF / 2, 0, scr, r, lane); continue; } r -= I_IN;
            if (r < I_BG) { transpose_item(a.in[19] + (size_t)l * D * 2048, D, 2048, wl + W1_OFF / 2, NIN, scr, r, lane); continue; } r -= I_BG;
            if (r < I_PA) { transpose_item(a.in[16] + (size_t)l * AW * D, AW, D, wl + WPA_OFF / 2, 0, scr, r, lane); continue; } r -= I_PA;
            if (r < I_PB) { transpose_item(a.in[18] + (size_t)l * BW * D, BW, D, wl + WPB_OFF / 2, 0, scr, r, lane); continue; } r -= I_PB;
            if (r < I_O) { transpose_item(a.in[20] + (size_t)l * D * D, D, D, wl + WO_OFF / 2, 0, scr, r, lane); continue; } r -= I_O;
            if (r < I_UP) { const int n0 = 32 * (r % (NUP / 32));
                const int jj = n0 < DFF ? n0 : n0 - DFF, rowb = 256 * (jj >> 7) + (n0 < DFF ? 0 : 128) + (jj & 127);
                transpose_item(a.in[21] + (size_t)l * D * NUP, D, NUP, wl + WUP_OFF / 2, rowb - n0, scr, r, lane); continue; } r -= I_UP;
            transpose_item(a.in[23] + (size_t)l * DFF * D, DFF, D, wl + WDN_OFF / 2, 0, scr, r, lane);
        }
    }
    GSYNC_CG();

    for (int grp = 0; grp < 2; ++grp) {
        const int R0 = grp ? MG0 : 0, MG = grp ? MG1 : MG0, nM = MG / 256;
        int tid = threadIdx.x; asm volatile("" : "+v"(tid));
        const int lane = tid & 63, wave = __builtin_amdgcn_readfirstlane(tid >> 6);
        for (int r = wg * 8 + wave; r < MG; r += G * 8) {
            const int R = R0 + r; const float* xin = (R < MP) ? a.in[0] + (size_t)R * D : a.in[1] + (size_t)(R - MP) * D;
            const float* ad = ADA + (size_t)row_batch(R) * 6144;
            row_pass(nullptr, xin, nullptr, nullptr, nullptr, nullptr, nullptr, Hb + (size_t)r * D, a.in[9], ad + 1024, ad, lane);
        }
        GSYNC();
        for (int l = 0; l < DEPTH; ++l) {
            int tid = threadIdx.x; asm volatile("" : "+v"(tid));
            const int lane = tid & 63, wave = __builtin_amdgcn_readfirstlane(tid >> 6);
            const bf16_t* wl = (const bf16_t*)(ws + WS_W + (size_t)l * LAYER_W);
            { pg8::Gemm g{Hb, wl + W1_OFF / 2, D, D, D}; pg8::StaticOrder S; S.init(nM, N1 / 256, G, wg); pg8::EpiStore E{Pb, N1, 1}; pg8::gemm_phase(lds, g, S, E); }
            GSYNC();
            {
                int tidb = threadIdx.x; asm volatile("" : "+v"(tidb));
                const int chain = wg >> 3, chunk = wg & 7, sqg = chain >> 2, hd = chain & 3;
                const int lrow = sqg * SEQ + chunk * 512;
                float* DS = (float*)(ws + WS_DS) + (size_t)(chain * 8) * 16384;
                float* DD = (float*)(ws + WS_DD) + (size_t)(chain * 8) * 128;
                float* SS = (float*)(ws + WS_SS) + (size_t)wg * 16384;
                const float* lbv = LB + l * 512 + hd * 128;
                const float* anv = a.in[15] + l * 128;
                if (wg < 256 && chunk < 7)
                    hgrn_item<false>(lds, Pb + (size_t)lrow * N1, ABb + (size_t)lrow * D, 512, hd, lbv, anv, nullptr, nullptr, 0, DS + (size_t)chunk * 16384, DD + chunk * 128);
                shortconv_phase(a, l, R0, MG, Pb, ABb, (unsigned*)ws + 1024 + 64 * (grp * 4 + l), MISC + 16);
                GSYNC();
                if (wg < 256)
                    hgrn_item<true>(lds, Pb + (size_t)lrow * N1, ABb + (size_t)lrow * D, 512, hd, lbv, anv, DS, DD, chunk,
                              chunk == 7 ? a.out + O_SHP + (size_t)((l * 16 + 8 * grp + sqg) * 4 + hd) * 16384 : nullptr, nullptr);
                if (grp == 1 && wg < 64) {
                    const int sq = wg >> 2, hs = wg & 3; const int srow = MG0 + sq * DSEQ;
                    hgrn_item<true>(lds, Pb + (size_t)srow * N1, ABb + (size_t)srow * D, DSEQ, hs, LB + l * 512 + hs * 128, anv,
                              a.in[2] + (size_t)((l * 16 + sq) * 4 + hs) * 16384, nullptr, 1, a.out + O_SHS + (size_t)((l * 16 + sq) * 4 + hs) * 16384, nullptr);
                }
            }
            GSYNC();
            { pg8::Gemm g{ABb, wl + WPA_OFF / 2, D, AW, AW}; pg8::StaticOrder S; S.init(nM, D / 256, G, wg); pg8::EpiGate E{Hb, Pb + NIN, 0}; pg8::gemm_phase(lds, g, S, E); }
            { pg8::Gemm g{ABb + AW, wl + WPB_OFF / 2, D, BW, BW}; pg8::StaticOrder S; S.init(nM, D / 256, G, wg); pg8::EpiGate E{Hb, Pb + NIN + D, 1}; pg8::gemm_phase(lds, g, S, E); }
            GSYNC();
            { pg8::Gemm g{Hb, wl + WO_OFF / 2, D, D, D}; pg8::StaticOrder S; S.init(nM, D / 256, G, wg); pg8::EpiStore E{ABb, D, 0}; pg8::gemm_phase(lds, g, S, E); }
            GSYNC();
            for (int r = wg * 8 + wave; r < MG; r += G * 8) {
                const int R = R0 + r; const float* xin = (R < MP) ? a.in[0] + (size_t)R * D : a.in[1] + (size_t)(R - MP) * D;
                const float* ad = ADA + ((size_t)l * 32 + row_batch(R)) * 6144;
                row_pass(ABb + (size_t)r * D, xin, (l == 0) ? nullptr : XBb + (size_t)r * D, nullptr, XBb + (size_t)r * D, a.in[10] + l * D, ad + 2048, Hb + (size_t)r * D, a.in[11] + l * D, ad + 4096, ad + 3072, lane);
            }
            GSYNC();
            { pg8::Gemm g{Hb, wl + WUP_OFF / 2, D, D, D, 254, -2}; pg8::StaticOrder S; S.init((MG + 253) / 254, NUP / 256, G, wg);
              pg8::EpiFfn E{ACTb, a.in[22] + (size_t)l * 3 * DFF, a.in[4], a.out + O_SFP, a.out + O_SFS, R0, MG, l, (LAS float*)(lds + 131072 + 1024)};
              pg8::gemm_phase(lds, g, S, E); }
            GSYNC();
            { pg8::Gemm g{ACTb, wl + WDN_OFF / 2, DFF, DFF, DFF}; pg8::StaticOrder S; S.init(nM, D / 256, G, wg); pg8::EpiStore E{ABb, D, 0}; pg8::gemm_phase(lds, g, S, E); }
            GSYNC();
            for (int r = wg * 8 + wave; r < MG; r += G * 8) {
                const int R = R0 + r;
                const float* ad = ADA + ((size_t)l * 32 + row_batch(R)) * 6144;
                const float* adn = ADA + ((size_t)(l + 1 < DEPTH ? l + 1 : l) * 32 + row_batch(R)) * 6144;
                row_pass(ABb + (size_t)r * D, nullptr, XBb + (size_t)r * D, a.out + (size_t)R * D, (l + 1 < DEPTH) ? XBb + (size_t)r * D : nullptr, a.in[12] + l * D, ad + 5120, (l + 1 < DEPTH) ? Hb + (size_t)r * D : nullptr,
                         a.in[9] + (l + 1 < DEPTH ? l + 1 : l) * D, adn + 1024, adn, lane);
            }
            if (l + 1 < DEPTH) GSYNC();
        }
    }
}

extern "C" void kernel_launch(void* const* d_in, const int* in_sizes, int n_in, void* d_out, int out_size, void* d_ws, size_t ws_size, hipStream_t stream) {
    static int grid = 0;
    if (grid == 0) {
        if (n_in != 24 || ws_size < WS_END) { fprintf(stderr, "kernel_launch: unexpected n_in %d / ws_size %zu (need %zu)\n", n_in, ws_size, (size_t)WS_END); grid = -1; return; }
        int dev = 0, cus = 0, per_cu = 0;
        hipGetDevice(&dev);
        hipDeviceGetAttribute(&cus, hipDeviceAttributeMultiprocessorCount, dev);
        if (hipFuncSetAttribute((const void*)fwd_megakernel, hipFuncAttributeMaxDynamicSharedMemorySize, LDS_BYTES) != hipSuccess) { fprintf(stderr, "kernel_launch: hipFuncSetAttribute failed\n"); }
        if (hipOccupancyMaxActiveBlocksPerMultiprocessor(&per_cu, (const void*)fwd_megakernel, 512, LDS_BYTES) != hipSuccess || per_cu < 1) { fprintf(stderr, "kernel_launch: occupancy query says %d\n", per_cu); per_cu = 1; }
        (void)hipGetLastError();
        grid = cus;
    }
    if (grid < 0) return;
    if (hipMemsetAsync(d_ws, 0, 65536, stream) != hipSuccess) { fprintf(stderr, "kernel_launch: hipMemsetAsync failed\n"); return; }
    Args a{};
    for (int i = 0; i < 24; ++i) a.in[i] = (const float*)d_in[i];
    a.out = (float*)d_out; a.ws = (unsigned char*)d_ws;
    void* args[] = {&a};
    hipError_t e = hipLaunchCooperativeKernel((const void*)fwd_megakernel, dim3(grid), dim3(512), args, LDS_BYTES, stream);
    if (e != hipSuccess) fprintf(stderr, "kernel_launch: cooperative launch failed: %s (grid %d)\n", hipGetErrorString(e), grid);
}
```

```cpp
#include <hip/hip_runtime.h>
#include <hip/hip_cooperative_groups.h>
#include <cstdio>
#include <cstdint>
namespace cg = cooperative_groups;

#define LAS __attribute__((address_space(3)))
typedef unsigned short bf16_t;
typedef short bf16x8 __attribute__((ext_vector_type(8)));
typedef short bf16x4 __attribute__((ext_vector_type(4)));
typedef float f32x4 __attribute__((ext_vector_type(4)));
typedef unsigned u32x4 __attribute__((ext_vector_type(4)));
typedef unsigned u32x2 __attribute__((ext_vector_type(2)));

constexpr int D = 1024, SEQ = 4096, NBATCH = 16, DEPTH = 4, DSEQ = 16;
constexpr int AW = 512, BW = 512, DFF = 2816, NIN = 3584, N1 = 5632, NUP = 5632;
constexpr int MP = NBATCH * SEQ;
constexpr int MS = NBATCH * DSEQ;
constexpr int MG0 = 32768, MG1 = 33024, MGMAX = 33024;
constexpr float EPS = 1e-6f;
constexpr size_t O_YP = 0, O_YS = 67108864, O_SHP = 67371008, O_SCP = 71565312, O_SFP = 71630848, O_SHS = 71991296, O_SCS = 76185600, O_SFS = 76251136;
constexpr size_t MiB = 1u << 20;
constexpr size_t WS_ADA = 1 * MiB;
constexpr size_t WS_LB = 5 * MiB;
constexpr size_t WS_W = 8 * MiB;
constexpr size_t W1_OFF = 0, WPA_OFF = (size_t)N1 * D * 2, WPB_OFF = WPA_OFF + (size_t)D * AW * 2, WO_OFF = WPB_OFF + (size_t)D * BW * 2,
                 WUP_OFF = WO_OFF + (size_t)D * D * 2, WDN_OFF = WUP_OFF + (size_t)NUP * D * 2, LAYER_W = WDN_OFF + (size_t)D * DFF * 2;
constexpr size_t WS_H = 136 * MiB;
constexpr size_t WS_AB = 202 * MiB;
constexpr size_t WS_P = 268 * MiB;
constexpr size_t WS_ACT = 624 * MiB;
constexpr size_t WS_DS = 804 * MiB;
constexpr size_t WS_DD = 822 * MiB;
constexpr size_t WS_SS = 824 * MiB;
constexpr size_t WS_DUMMY = 840 * MiB;
constexpr size_t WS_XB = 842 * MiB;
constexpr size_t WS_END = 908 * MiB;
static_assert(WS_W + 4 * LAYER_W <= WS_H && WS_H + (size_t)MGMAX * D * 2 <= WS_AB && WS_AB + (size_t)MGMAX * D * 2 <= WS_P && WS_P + (size_t)MGMAX * N1 * 2 <= WS_ACT && WS_ACT + (size_t)MGMAX * DFF * 2 <= WS_DS && WS_DS + (size_t)32 * 8 * 16384 * 4 <= WS_DD, "ws map");
constexpr int LDS_BYTES = 147456;

__device__ __forceinline__ unsigned cvt_pk_bf16(float lo, float hi) { unsigned r; asm volatile("v_cvt_pk_bf16_f32 %0, %1, %2" : "=v"(r) : "v"(lo), "v"(hi)); return r; }
__device__ __forceinline__ float bf2f(unsigned short b) { return __uint_as_float(((unsigned)b) << 16); }
__device__ __forceinline__ float bflo(unsigned w) { return __uint_as_float(w << 16); }
__device__ __forceinline__ float bfhi(unsigned w) { return __uint_as_float(w & 0xffff0000u); }
__device__ __forceinline__ float fsigmoid(float x) { return __builtin_amdgcn_rcpf(1.f + __expf(-x)); }
template <int CTRL> __device__ __forceinline__ float dpp_rot(float v) { return __builtin_bit_cast(float, __builtin_amdgcn_update_dpp(0, __builtin_bit_cast(int, v), CTRL, 0xf, 0xf, true)); }
__device__ __forceinline__ float sum16(float x) { x += dpp_rot<0x128>(x); x += dpp_rot<0x124>(x); x += dpp_rot<0x122>(x); x += dpp_rot<0x121>(x); return x; }
__device__ __forceinline__ float wave_sum(float v) { v = sum16(v); v += __shfl_xor(v, 16); v += __shfl_xor(v, 32); return v; }

namespace pg8 {
constexpr int BM = 256, BK = 64, HALF = 128, HTB = HALF * BK * 2, STAGE_BYTES = 8 * HTB, NXCD = 8, WGM = 8;
__host__ __device__ __forceinline__ int lds_byte(int r, int c) { const int st = (r >> 4) * 2 + (c >> 5), rr = r & 15, cc = c & 31, ob = rr * 64 + cc * 2; return st * 1024 + (ob ^ (((ob >> 9) & 1) << 5)); }
__host__ __device__ __forceinline__ void stage_rc(int b, int& R, int& C) { const int st = b / 1024, sb = b % 1024, swz = sb ^ (((sb >> 9) & 1) << 5); R = (st >> 1) * 16 + swz / 64; C = (st & 1) * 32 + (swz % 64) / 2; }
__host__ __device__ __forceinline__ int perm32(int rho) { const int n = rho >> 4, i = rho & 15; return 8 * (i >> 2) + 4 * n + (i & 3); }
struct Unit { int pm, pn; };
struct Gemm { const bf16_t* A; const bf16_t* Bt; int lda, ldb, K; int mstride = 256; int arow0 = 0; };
struct StaticOrder {
    int nM, nN, nwg, G, c;
    __device__ void init(int nM_, int nN_, int G_, int c_) { nM = nM_; nN = nN_; nwg = nM * nN; G = G_; c = c_; }
    __device__ bool next(int i, Unit& u) const {
        const long L = (long)i * G + c; if (L >= nwg) return false;
        int wgid = (int)L; { const int q = nwg / NXCD, r = nwg % NXCD, xcd = wgid % NXCD, off = wgid / NXCD; wgid = (xcd < r ? xcd * (q + 1) : r * (q + 1) + (xcd - r) * q) + off; }
        const int nig = WGM * nN, gid = wgid / nig, fm = gid * WGM, gsz = (nM - fm) < WGM ? (nM - fm) : WGM;
        u.pm = fm + ((wgid % nig) % gsz); u.pn = (wgid % nig) / gsz; return true;
    }
};
template <class Epi>
__device__ __forceinline__ void gemm_phase(LAS unsigned char* lds, const Gemm g, const StaticOrder& S, const Epi& E) {
    int tid = threadIdx.x; asm volatile("" : "+v"(tid));
    const int wid = __builtin_amdgcn_readfirstlane(tid >> 6), lane = tid & 63, wr = wid >> 2, wc = wid & 3, fr = lane & 15, fq = lane >> 4;
    const int K = g.K, nt = K / BK;
    unsigned voffA[2], voffB[2];
#pragma unroll
    for (int i = 0; i < 2; ++i) { int R, C; stage_rc(tid * 16 + i * 8192, R, C); const int Rb = (R & ~31) + perm32(R & 31);
        voffA[i] = (unsigned)(R * g.lda + C) * 2u; voffB[i] = (unsigned)(Rb * g.ldb + C) * 2u; }
    const size_t kstep = (size_t)(BK * 2);
    const size_t hstepA = (size_t)HALF * g.lda * 2, hstepB = (size_t)HALF * g.ldb * 2;
    const long tstepA = (long)g.mstride * g.lda * 2, tstepB = (long)(2 * hstepB); const long abase0 = (long)g.arow0 * g.lda * 2;
    const unsigned ldsw = (unsigned)wid * 1024u;
    const int aoff = lds_byte(wr * 64 + fr, fq * 8), boff = lds_byte(wc * 32 + fr, fq * 8);
#define PG8_SA(b, h) (((b) * 2 + (h)) * HTB)
#define PG8_SB(b, h) ((4 + (b) * 2 + (h)) * HTB)
#define PG8_STAGE(bufoff, gbase, voff) do { _Pragma("unroll") for (int _i = 0; _i < 2; ++_i) \
        __builtin_amdgcn_global_load_lds((const unsigned*)((const char*)(gbase) + (voff)[_i]), (LAS unsigned*)(lds + (bufoff) + ldsw + _i * 8192), 16, 0, 0); } while (0)
#define PG8_LDA(dst, b, h) do { _Pragma("unroll") for (int m = 0; m < 4; ++m) _Pragma("unroll") for (int k = 0; k < 2; ++k) dst[m][k] = *(const LAS bf16x8*)(lds + PG8_SA(b, h) + aoff + m * 2048 + k * 1024); } while (0)
#define PG8_LDB(dst, b, h) do { _Pragma("unroll") for (int n = 0; n < 2; ++n) _Pragma("unroll") for (int k = 0; k < 2; ++k) dst[n][k] = *(const LAS bf16x8*)(lds + PG8_SB(b, h) + boff + n * 2048 + k * 1024); } while (0)
#define PG8_MMA(ai, bj, At, Bt) do { __builtin_amdgcn_s_setprio(1); _Pragma("unroll") for (int m = 0; m < 4; ++m) _Pragma("unroll") for (int n = 0; n < 2; ++n) _Pragma("unroll") for (int k = 0; k < 2; ++k) \
        acc[ai][bj][m][n] = __builtin_amdgcn_mfma_f32_16x16x32_bf16(Bt[n][k], At[m][k], acc[ai][bj][m][n], 0, 0, 0); __builtin_amdgcn_s_setprio(0); } while (0)
#define PG8_WAIT_V(n) asm volatile("s_waitcnt vmcnt(" #n ")" ::: "memory")
#define PG8_WAIT_L(n) asm volatile("s_waitcnt lgkmcnt(" #n ")" ::: "memory")
#define PG8_BAR __builtin_amdgcn_s_barrier()
#define PG8_SCHED __builtin_amdgcn_sched_barrier(0)
    Unit cur, nxt; int ui = 0;
    if (!S.next(0, cur)) return;
    f32x4 acc[2][2][4][2];
#pragma unroll
    for (int a = 0; a < 2; ++a)
#pragma unroll
        for (int b = 0; b < 2; ++b)
#pragma unroll
            for (int m = 0; m < 4; ++m)
#pragma unroll
                for (int n = 0; n < 2; ++n) acc[a][b][m][n] = (f32x4){0.f, 0.f, 0.f, 0.f};
    bf16x8 At[4][2], B0[2][2], B1[2][2];
    const char* cA = (const char*)g.A + abase0 + (long)cur.pm * tstepA; const char* cB = (const char*)g.Bt + (long)cur.pn * tstepB;
    PG8_STAGE(PG8_SB(0, 0), cB, voffB); PG8_STAGE(PG8_SB(0, 1), cB + hstepB, voffB); PG8_STAGE(PG8_SA(0, 0), cA, voffA); PG8_STAGE(PG8_SA(0, 1), cA + hstepA, voffA);
    if (wr == 1) PG8_BAR;
    PG8_WAIT_V(2); PG8_BAR;
    PG8_STAGE(PG8_SB(1, 0), cB + kstep, voffB); PG8_STAGE(PG8_SA(1, 0), cA + kstep, voffA); PG8_STAGE(PG8_SB(1, 1), cB + hstepB + kstep, voffB);
    PG8_WAIT_V(6); PG8_BAR;
    for (;;) {
        const bool has_next = S.next(ui + 1, nxt);
        const char* nA = has_next ? (const char*)g.A + abase0 + (long)nxt.pm * tstepA : cA; const char* nB = has_next ? (const char*)g.Bt + (long)nxt.pn * tstepB : cB;
        for (int t = 0; t < nt; t += 2) {
            const bool last = (t == nt - 2);
            const char* a1 = cA + (size_t)(t + 1) * kstep;
            const char* a2 = last ? nA : cA + (size_t)(t + 2) * kstep; const char* b2 = last ? nB : cB + (size_t)(t + 2) * kstep;
            const char* a3 = a2 + kstep; const char* b3 = b2 + kstep;
            PG8_LDB(B0, 0, 0); PG8_LDB(B1, 0, 1); PG8_SCHED; PG8_LDA(At, 0, 0); PG8_STAGE(PG8_SA(1, 1), a1 + hstepA, voffA);
            PG8_WAIT_V(8); PG8_WAIT_L(0); PG8_BAR; PG8_MMA(0, 0, At, B0); PG8_MMA(0, 1, At, B1); PG8_BAR; PG8_SCHED;
            PG8_LDA(At, 0, 1); PG8_STAGE(PG8_SB(0, 0), b2, voffB); PG8_STAGE(PG8_SB(0, 1), b2 + hstepB, voffB); PG8_STAGE(PG8_SA(0, 0), a2, voffA);
            PG8_WAIT_V(8); PG8_WAIT_L(0); PG8_BAR; PG8_MMA(1, 0, At, B0); PG8_MMA(1, 1, At, B1); PG8_BAR; PG8_SCHED;
            PG8_LDB(B0, 1, 0); PG8_LDB(B1, 1, 1); PG8_SCHED; PG8_LDA(At, 1, 0); PG8_STAGE(PG8_SA(0, 1), a2 + hstepA, voffA);
            PG8_WAIT_V(8); PG8_WAIT_L(0); PG8_BAR; PG8_MMA(0, 0, At, B0); PG8_MMA(0, 1, At, B1); PG8_BAR; PG8_SCHED;
            PG8_LDA(At, 1, 1); PG8_STAGE(PG8_SB(1, 0), b3, voffB); PG8_STAGE(PG8_SB(1, 1), b3 + hstepB, voffB); PG8_STAGE(PG8_SA(1, 0), a3, voffA);
            PG8_WAIT_V(8); PG8_WAIT_L(0); PG8_BAR; PG8_MMA(1, 0, At, B0); PG8_MMA(1, 1, At, B1); PG8_BAR; PG8_SCHED;
        }
        if (wr == 0) PG8_BAR;
        E(acc, cur, wr, wc, fr, fq);
        if (!has_next) break;
#pragma unroll
        for (int a = 0; a < 2; ++a)
#pragma unroll
            for (int b = 0; b < 2; ++b)
#pragma unroll
                for (int m = 0; m < 4; ++m)
#pragma unroll
                    for (int n = 0; n < 2; ++n) acc[a][b][m][n] = (f32x4){0.f, 0.f, 0.f, 0.f};
        cur = nxt; cA = nA; cB = nB; ++ui;
        if (wr == 1) PG8_BAR;
    }
    PG8_WAIT_V(0);
    PG8_BAR;
#undef PG8_SA
#undef PG8_SB
#undef PG8_STAGE
#undef PG8_LDA
#undef PG8_LDB
#undef PG8_MMA
#undef PG8_WAIT_V
#undef PG8_WAIT_L
#undef PG8_BAR
#undef PG8_SCHED
}

struct EpiStore {
    bf16_t* O; int ldc; int kind;
    __device__ __forceinline__ void operator()(const f32x4 (&acc)[2][2][4][2], const Unit& u, int wr, int wc, int fr, int fq) const {
        const int row0 = u.pm * BM + wr * 64 + fr, col0 = u.pn * BM + wc * 32 + 8 * fq;
        int act = 0;
        if (kind == 1) { const int pn = u.pn; act = (pn < 2 || pn == 6 || pn == 7) ? 1 : (pn >= 14 ? 2 : 0); }
#pragma unroll
        for (int ai = 0; ai < 2; ++ai)
#pragma unroll
            for (int m = 0; m < 4; ++m) { bf16_t* rowp = O + (size_t)(row0 + ai * HALF + m * 16) * ldc + col0;
#pragma unroll
                for (int bj = 0; bj < 2; ++bj) { f32x4 v0 = acc[ai][bj][m][0], v1 = acc[ai][bj][m][1];
                    if (act) {
#pragma unroll
                        for (int e = 0; e < 4; ++e) { const float s0 = fsigmoid(v0[e]), s1 = fsigmoid(v1[e]); v0[e] = (act == 1) ? v0[e] * s0 : s0; v1[e] = (act == 1) ? v1[e] * s1 : s1; }
                    }
                    u32x4 o; o.x = cvt_pk_bf16(v0[0], v0[1]); o.y = cvt_pk_bf16(v0[2], v0[3]); o.z = cvt_pk_bf16(v1[0], v1[1]); o.w = cvt_pk_bf16(v1[2], v1[3]);
                    *(u32x4*)(rowp + bj * HALF) = o; } }
    }
};
struct EpiGate {
    bf16_t* O; const bf16_t* Gt; int accum;
    __device__ __forceinline__ void operator()(const f32x4 (&acc)[2][2][4][2], const Unit& u, int wr, int wc, int fr, int fq) const {
        const int row0 = u.pm * BM + wr * 64 + fr, col0 = u.pn * BM + wc * 32 + 8 * fq;
#pragma unroll
        for (int ai = 0; ai < 2; ++ai) {
            u32x4 gv[4][2], ov[4][2];
#pragma unroll
            for (int m = 0; m < 4; ++m)
#pragma unroll
                for (int bj = 0; bj < 2; ++bj) { const size_t r = (size_t)(row0 + ai * HALF + m * 16); const int c = col0 + bj * HALF;
                    gv[m][bj] = *(const u32x4*)(Gt + r * N1 + c); ov[m][bj] = accum ? *(const u32x4*)(O + r * D + c) : (u32x4){0u, 0u, 0u, 0u}; }
#pragma unroll
            for (int m = 0; m < 4; ++m)
#pragma unroll
                for (int bj = 0; bj < 2; ++bj) { const size_t r = (size_t)(row0 + ai * HALF + m * 16); const int c = col0 + bj * HALF;
                    const u32x4 g = gv[m][bj], o0 = ov[m][bj];
                    f32x4 v0 = acc[ai][bj][m][0], v1 = acc[ai][bj][m][1];
                    v0[0] = v0[0] * bflo(g.x) + bflo(o0.x); v0[1] = v0[1] * bfhi(g.x) + bfhi(o0.x); v0[2] = v0[2] * bflo(g.y) + bflo(o0.y); v0[3] = v0[3] * bfhi(g.y) + bfhi(o0.y);
                    v1[0] = v1[0] * bflo(g.z) + bflo(o0.z); v1[1] = v1[1] * bfhi(g.z) + bfhi(o0.z); v1[2] = v1[2] * bflo(g.w) + bflo(o0.w); v1[3] = v1[3] * bfhi(g.w) + bfhi(o0.w);
                    u32x4 o; o.x = cvt_pk_bf16(v0[0], v0[1]); o.y = cvt_pk_bf16(v0[2], v0[3]); o.z = cvt_pk_bf16(v1[0], v1[1]); o.w = cvt_pk_bf16(v1[2], v1[3]);
                    *(u32x4*)(O + r * D + c) = o; }
        }
    }
};

struct EpiFfn {
    bf16_t* ACT; const float* cw; const float* stin; float* stout_p; float* stout_s; int R0, MG, l; LAS float* halo;
    __device__ __forceinline__ void operator()(const f32x4 (&acc)[2][2][4][2], const Unit& u, int wr, int wc, int fr, int fq) const {
        const int colg = u.pn * 128 + wc * 32 + 8 * fq;
        if (fr >= 14) {
#pragma unroll
            for (int ai = 0; ai < 2; ++ai) { LAS float* hp = halo + ((ai * 2 + wr) * 2 + (fr - 14)) * 128 + wc * 32 + 8 * fq; *(LAS f32x4*)hp = acc[ai][0][3][0]; *(LAS f32x4*)(hp + 4) = acc[ai][0][3][1]; }
        }
        asm volatile("s_waitcnt lgkmcnt(0)" ::: "memory"); __builtin_amdgcn_s_barrier(); asm volatile("" ::: "memory");
        const int lane = fq * 16 + fr, src1 = (lane & 48) | ((fr + 15) & 15), src2 = (lane & 48) | ((fr + 14) & 15);
#pragma unroll
        for (int n = 0; n < 2; ++n) {
            const int col = colg + 4 * n;
            const f32x4 w0 = *(const f32x4*)(cw + col), w1 = *(const f32x4*)(cw + DFF + col), w2 = *(const f32x4*)(cw + 2 * DFF + col);
#pragma unroll
            for (int ai = 0; ai < 2; ++ai)
#pragma unroll
                for (int m = 0; m < 4; ++m) {
                    const int rho = 128 * ai + 64 * wr + 16 * m + fr, Rl = u.pm * 254 - 2 + rho, R = R0 + Rl;
                    const bool valid = (rho >= 2) && (Rl < MG);
                    int t, Lq, sq; const bool smp = (R >= MP);
                    if (!smp) { t = R & (SEQ - 1); Lq = SEQ; sq = R >> 12; } else { const int Rs = R - MP; t = Rs & 15; Lq = DSEQ; sq = Rs >> 4; }
                    const f32x4 g4 = acc[ai][0][m][n];
                    const f32x4 gm = acc[ai][0][m > 0 ? m - 1 : 0][n];
                    f32x4 p1, p2;
#pragma unroll
                    for (int e = 0; e < 4; ++e) { const float s1 = (m > 0 && fr == 15) ? gm[e] : g4[e], s2 = (m > 0 && fr >= 14) ? gm[e] : g4[e]; p1[e] = dpp_rot<0x121>(s1); p2[e] = dpp_rot<0x122>(s2); }
                    if (m == 0) { const int pb = ai * 2 + wr - 1;
                        if (pb >= 0 && fr < 2) { const LAS float* h0 = halo + (pb * 2) * 128 + wc * 32 + 8 * fq + 4 * n;
                            const f32x4 x0 = *(const LAS f32x4*)h0, y0 = *(const LAS f32x4*)(h0 + 128);
                            if (fr == 0) { p1 = y0; p2 = x0; } else { p2 = y0; } } }
                    if (valid && t < 2) {
                        f32x4 s0v = (f32x4){0.f, 0.f, 0.f, 0.f}, s1v = s0v;
                        if (smp) { const float* sp = stin + (size_t)((l * 16 + sq) * 2) * DFF + col; s0v = *(const f32x4*)sp; s1v = *(const f32x4*)(sp + DFF); }
                        if (t == 0) { p1 = s1v; p2 = s0v; } else { p2 = s1v; }
                    }
                    if (valid) {
                        const f32x4 v4 = acc[ai][1][m][n];
                        float o[4];
#pragma unroll
                        for (int e = 0; e < 4; ++e) { const float y = w0[e] * p2[e] + w1[e] * p1[e] + w2[e] * g4[e]; o[e] = y * fsigmoid(y) * v4[e]; }
                        u32x2 ov; ov.x = cvt_pk_bf16(o[0], o[1]); ov.y = cvt_pk_bf16(o[2], o[3]);
                        *(u32x2*)(ACT + (size_t)Rl * DFF + col) = ov;
                        if (t >= Lq - 2) *(f32x4*)((smp ? stout_s : stout_p) + (size_t)((l * 16 + sq) * 2 + (t - (Lq - 2))) * DFF + col) = g4;
                    }
                }
        }
    }
};
}

struct Args { const float* in[24]; float* out; unsigned char* ws; };

__device__ __forceinline__ void transpose_item(const float* W, int K, int N, bf16_t* WT, int row_off, LAS float* scr, int item, int lane) {
    const int nblk = N / 32, kb = item / nblk, nb = item % nblk, k0 = 64 * kb, n0 = 32 * nb;
#pragma unroll 8
    for (int i = 0; i < 32; ++i) { const int kk = 2 * i + (lane >> 5); scr[kk * 33 + (lane & 31)] = W[(size_t)(k0 + kk) * N + n0 + (lane & 31)]; }
    asm volatile("s_waitcnt lgkmcnt(0)" ::: "memory");
    const int c = lane & 7;
#pragma unroll
    for (int j = 0; j < 4; ++j) { const int n = (lane >> 3) + 8 * j; const LAS float* s = scr + (8 * c) * 33 + n;
        u32x4 o; o.x = cvt_pk_bf16(s[0 * 33], s[1 * 33]); o.y = cvt_pk_bf16(s[2 * 33], s[3 * 33]); o.z = cvt_pk_bf16(s[4 * 33], s[5 * 33]); o.w = cvt_pk_bf16(s[6 * 33], s[7 * 33]);
        *(u32x4*)(WT + (size_t)(row_off + n0 + n) * K + k0 + 8 * c) = o; }
    asm volatile("s_waitcnt lgkmcnt(0)" ::: "memory");
}

struct RowVecs { f32x4 v[4]; };
__device__ __forceinline__ RowVecs load_vecs(const float* p, int lane) { RowVecs r;
#pragma unroll
    for (int j = 0; j < 2; ++j) { r.v[2 * j] = *(const f32x4*)(p + 512 * j + 8 * lane); r.v[2 * j + 1] = *(const f32x4*)(p + 512 * j + 8 * lane + 4); }
    return r; }
__device__ __forceinline__ void row_pass(const bf16_t* mrow  , const float* xin, const bf16_t* xin_b, float* xout, bf16_t* xout_b, const RowVecs& gpost, const RowVecs& gate,
                                         bf16_t* hrow  , const RowVecs& gpre, const RowVecs& sc, const RowVecs& sh, int lane) {
    float xv[2][8];
    if (xin_b) {
#pragma unroll
        for (int j = 0; j < 2; ++j) { const u32x4 w = *(const u32x4*)(xin_b + 512 * j + 8 * lane);
            xv[j][0] = bflo(w.x); xv[j][1] = bfhi(w.x); xv[j][2] = bflo(w.y); xv[j][3] = bfhi(w.y); xv[j][4] = bflo(w.z); xv[j][5] = bfhi(w.z); xv[j][6] = bflo(w.w); xv[j][7] = bfhi(w.w); }
    } else {
#pragma unroll
        for (int j = 0; j < 2; ++j) { const int c0 = 512 * j + 8 * lane; const f32x4 a = *(const f32x4*)(xin + c0), b = *(const f32x4*)(xin + c0 + 4);
            xv[j][0] = a[0]; xv[j][1] = a[1]; xv[j][2] = a[2]; xv[j][3] = a[3]; xv[j][4] = b[0]; xv[j][5] = b[1]; xv[j][6] = b[2]; xv[j][7] = b[3]; }
    }
    if (mrow) {
        float mv[2][8]; float ss = 0.f;
#pragma unroll
        for (int j = 0; j < 2; ++j) { const u32x4 w = *(const u32x4*)(mrow + 512 * j + 8 * lane);
            mv[j][0] = bflo(w.x); mv[j][1] = bfhi(w.x); mv[j][2] = bflo(w.y); mv[j][3] = bfhi(w.y); mv[j][4] = bflo(w.z); mv[j][5] = bfhi(w.z); mv[j][6] = bflo(w.w); mv[j][7] = bfhi(w.w);
#pragma unroll
            for (int e = 0; e < 8; ++e) ss += mv[j][e] * mv[j][e]; }
        const float rstd = __builtin_amdgcn_rsqf(wave_sum(ss) * (1.f / D) + EPS);
#pragma unroll
        for (int j = 0; j < 2; ++j) { const int c0 = 512 * j + 8 * lane;
            const f32x4 g0 = gpost.v[2 * j], g1 = gpost.v[2 * j + 1], t0 = gate.v[2 * j], t1 = gate.v[2 * j + 1];
#pragma unroll
            for (int e = 0; e < 4; ++e) { xv[j][e] += t0[e] * (mv[j][e] * rstd * g0[e]); xv[j][4 + e] += t1[e] * (mv[j][4 + e] * rstd * g1[e]); }
            if (xout_b) { u32x4 o; o.x = cvt_pk_bf16(xv[j][0], xv[j][1]); o.y = cvt_pk_bf16(xv[j][2], xv[j][3]); o.z = cvt_pk_bf16(xv[j][4], xv[j][5]); o.w = cvt_pk_bf16(xv[j][6], xv[j][7]); *(u32x4*)(xout_b + c0) = o;
            } else { *(f32x4*)(xout + c0) = (f32x4){xv[j][0], xv[j][1], xv[j][2], xv[j][3]}; *(f32x4*)(xout + c0 + 4) = (f32x4){xv[j][4], xv[j][5], xv[j][6], xv[j][7]}; } }
    }
    if (hrow) {
        float ss = 0.f;
#pragma unroll
        for (int j = 0; j < 2; ++j)
#pragma unroll
            for (int e = 0; e < 8; ++e) ss += xv[j][e] * xv[j][e];
        const float rstd = __builtin_amdgcn_rsqf(wave_sum(ss) * (1.f / D) + EPS);
#pragma unroll
        for (int j = 0; j < 2; ++j) { const int c0 = 512 * j + 8 * lane; float hv[8];
            const f32x4 g0 = gpre.v[2 * j], g1 = gpre.v[2 * j + 1], s0 = sc.v[2 * j], s1 = sc.v[2 * j + 1], h0 = sh.v[2 * j], h1 = sh.v[2 * j + 1];
#pragma unroll
            for (int e = 0; e < 4; ++e) { hv[e] = xv[j][e] * rstd * g0[e] * (1.f + s0[e]) + h0[e]; hv[4 + e] = xv[j][4 + e] * rstd * g1[e] * (1.f + s1[e]) + h1[e]; }
            u32x4 o; o.x = cvt_pk_bf16(hv[0], hv[1]); o.y = cvt_pk_bf16(hv[2], hv[3]); o.z = cvt_pk_bf16(hv[4], hv[5]); o.w = cvt_pk_bf16(hv[6], hv[7]);
            *(u32x4*)(hrow + c0) = o; }
    }
}
__device__ __forceinline__ int row_batch(int R) { return R < MP ? (R >> 12) : 16 + ((R - MP) >> 4); }

template <bool FULL>
__device__ __forceinline__ void hgrn_item(LAS unsigned char* lds, const bf16_t* P, bf16_t* AB, int L, int hd, const float* lbv, const float* anorm, const float* S0, const float* Dd, int ns, float* Sout, float* Dout) {
    int tid = threadIdx.x; asm volatile("" : "+v"(tid));
    const int w = tid >> 6, lane = tid & 63, q4 = lane >> 4, c16 = lane & 15;
    const int k = tid & 127, tq = tid >> 7;
    LAS bf16_t* Qt = (LAS bf16_t*)lds;
    LAS bf16_t* Kt = Qt + 16 * 136;
    LAS bf16_t* KhT = Kt + 16 * 136;
    LAS bf16_t* VsT = KhT + 128 * 20;
    LAS float* dvec = (LAS float*)(VsT + 128 * 20);
    LAS float* qsum = dvec + 128;
    LAS float* ssq = qsum + 512;
    const float lb = lbv[k], oml = 1.f - lb;
    const float an = FULL ? anorm[16 * w + c16] : 0.f;
    f32x4 accS[8];
#pragma unroll
    for (int mt = 0; mt < 8; ++mt) accS[mt] = (f32x4){0.f, 0.f, 0.f, 0.f};
    if (Dd) {
#pragma unroll 2
        for (int c = 0; c < ns; ++c) { const float* sc = S0 + (size_t)c * 16384 + tid;
#pragma unroll
            for (int mt = 0; mt < 8; ++mt) { const f32x4 d4 = *(const f32x4*)(Dd + c * 128 + 16 * mt + 4 * q4);
#pragma unroll
                for (int j = 0; j < 4; ++j) accS[mt][j] = accS[mt][j] * d4[j] + sc[(mt * 4 + j) * 512]; } }
    } else {
        for (int c = 0; c < ns; ++c) { const float* sc = S0 + (size_t)c * 16384 + 16 * w + c16;
#pragma unroll
            for (int mt = 0; mt < 8; ++mt)
#pragma unroll
                for (int j = 0; j < 4; ++j) accS[mt][j] = sc[(size_t)(16 * mt + 4 * q4 + j) * 128]; }
    }
    const bf16_t* pq = P + 128 * hd + k + (size_t)(4 * tq) * N1;
    const bf16_t* pz = pq + 512;
    const int vt = (tid >> 4) & 15, vc = tid & 15;
    const bf16_t* pv = P + 1024 + 128 * hd + 8 * vc + (size_t)vt * N1;
    const bf16_t* pg = P + 1536 + 128 * hd + 16 * w + c16 + (size_t)(4 * q4) * N1;
    bf16_t* po = AB + 128 * hd + 16 * w + c16 + (size_t)(4 * q4) * D;
    const int nsteps = L >> 4;
    float btot = 0.f;
    unsigned short zr[4], qr[4], grn[4]; u32x4 vr = (u32x4){0u, 0u, 0u, 0u};
#pragma unroll
    for (int i = 0; i < 4; ++i) { zr[i] = pz[(size_t)i * N1]; qr[i] = pq[(size_t)i * N1]; grn[i] = pg[(size_t)i * N1]; }
    if (tid < 256) vr = *(const u32x4*)pv;
    for (int n = 0; n < nsteps; ++n) {
        unsigned short zc[4], qc[4], gr[4]; const u32x4 vcur = vr;
#pragma unroll
        for (int i = 0; i < 4; ++i) { zc[i] = zr[i]; qc[i] = qr[i]; gr[i] = grn[i]; }
        const size_t roff = (size_t)(16 * n) * N1;
        {
            const size_t nro = (size_t)(16 * (n + 1 < nsteps ? n + 1 : n)) * N1;
#pragma unroll
            for (int i = 0; i < 4; ++i) { zr[i] = pz[nro + (size_t)i * N1]; qr[i] = pq[nro + (size_t)i * N1]; grn[i] = pg[nro + (size_t)i * N1]; }
            if (tid < 256) vr = *(const u32x4*)(pv + nro);
        }
        float cs[4], kk[4], qv[4];
        {
            float run = 0.f;
#pragma unroll
            for (int i = 0; i < 4; ++i) { float z = bf2f(zc[i]); z = fminf(fmaxf(z, -30.f), 30.f); const float e = __expf(-z), sg = __builtin_amdgcn_rcpf(1.f + e), sn = e * sg;
                const float f = lb + oml * sg; run += __builtin_amdgcn_logf(f) * 0.69314718056f; cs[i] = run; kk[i] = oml * sn; qv[i] = bf2f(qc[i]); }
            qsum[tq * 128 + k] = run;
        }
        __syncthreads();
        {
            float pre = 0.f, tot = 0.f;
#pragma unroll
            for (int j = 0; j < 4; ++j) { const float v = qsum[j * 128 + k]; tot += v; pre += (j < tq) ? v : 0.f; }
            btot += tot;
            float kh[4];
#pragma unroll
            for (int i = 0; i < 4; ++i) { const float b = pre + cs[i]; const float qt = qv[i] * __expf(b), kt = kk[i] * __expf(fminf(-b, 80.f)); kh[i] = kk[i] * __expf(tot - b);
                Qt[(4 * tq + i) * 136 + k] = (bf16_t)(cvt_pk_bf16(qt, 0.f) & 0xffffu); Kt[(4 * tq + i) * 136 + k] = (bf16_t)(cvt_pk_bf16(kt, 0.f) & 0xffffu); }
            u32x2 kp; kp.x = cvt_pk_bf16(kh[0], kh[1]); kp.y = cvt_pk_bf16(kh[2], kh[3]);
            *(LAS u32x2*)(KhT + k * 20 + 4 * tq) = kp;
            if (tq == 0) dvec[k] = __expf(tot);
            if (tid < 256) {
                VsT[(8 * vc + 0) * 20 + vt] = (bf16_t)(vcur.x & 0xffffu); VsT[(8 * vc + 1) * 20 + vt] = (bf16_t)(vcur.x >> 16);
                VsT[(8 * vc + 2) * 20 + vt] = (bf16_t)(vcur.y & 0xffffu); VsT[(8 * vc + 3) * 20 + vt] = (bf16_t)(vcur.y >> 16);
                VsT[(8 * vc + 4) * 20 + vt] = (bf16_t)(vcur.z & 0xffffu); VsT[(8 * vc + 5) * 20 + vt] = (bf16_t)(vcur.z >> 16);
                VsT[(8 * vc + 6) * 20 + vt] = (bf16_t)(vcur.w & 0xffffu); VsT[(8 * vc + 7) * 20 + vt] = (bf16_t)(vcur.w >> 16);
            }
        }
        __syncthreads();
        f32x4 acco = (f32x4){0.f, 0.f, 0.f, 0.f};
        {
            const u32x2 vv = *(const LAS u32x2*)(VsT + (16 * w + c16) * 20 + 4 * q4);
            const bf16x4 vf = __builtin_bit_cast(bf16x4, vv);
            if (FULL) {
            bf16x8 qf[4], kf[4];
#pragma unroll
            for (int kq = 0; kq < 4; ++kq) {
                const u32x2 a0 = *(const LAS u32x2*)(Qt + c16 * 136 + 32 * kq + 4 * q4), a1 = *(const LAS u32x2*)(Qt + c16 * 136 + 32 * kq + 16 + 4 * q4);
                const u32x2 b0 = *(const LAS u32x2*)(Kt + c16 * 136 + 32 * kq + 4 * q4), b1 = *(const LAS u32x2*)(Kt + c16 * 136 + 32 * kq + 16 + 4 * q4);
                u32x4 qa = (u32x4){a0.x, a0.y, a1.x, a1.y}, ka = (u32x4){b0.x, b0.y, b1.x, b1.y};
                qf[kq] = __builtin_bit_cast(bf16x8, qa); kf[kq] = __builtin_bit_cast(bf16x8, ka);
            }
            f32x4 accA = (f32x4){0.f, 0.f, 0.f, 0.f};
#pragma unroll
            for (int kq = 0; kq < 4; ++kq) accA = __builtin_amdgcn_mfma_f32_16x16x32_bf16(kf[kq], qf[kq], accA, 0, 0, 0);
#pragma unroll
            for (int j = 0; j < 4; ++j) accA[j] = (c16 >= 4 * q4 + j) ? accA[j] : 0.f;
            u32x2 pa; pa.x = cvt_pk_bf16(accA[0], accA[1]); pa.y = cvt_pk_bf16(accA[2], accA[3]);
            const bf16x4 pA = __builtin_bit_cast(bf16x4, pa);
            acco = __builtin_amdgcn_mfma_f32_16x16x16bf16_1k(pA, vf, (f32x4){0.f, 0.f, 0.f, 0.f}, 0, 0, 0);
#pragma unroll
            for (int kq = 0; kq < 4; ++kq) {
                u32x4 sp; sp.x = cvt_pk_bf16(accS[2 * kq][0], accS[2 * kq][1]); sp.y = cvt_pk_bf16(accS[2 * kq][2], accS[2 * kq][3]);
                sp.z = cvt_pk_bf16(accS[2 * kq + 1][0], accS[2 * kq + 1][1]); sp.w = cvt_pk_bf16(accS[2 * kq + 1][2], accS[2 * kq + 1][3]);
                acco = __builtin_amdgcn_mfma_f32_16x16x32_bf16(qf[kq], __builtin_bit_cast(bf16x8, sp), acco, 0, 0, 0);
            }
            }
#pragma unroll
            for (int mt = 0; mt < 8; ++mt) {
                const u32x2 kh2 = *(const LAS u32x2*)(KhT + (16 * mt + c16) * 20 + 4 * q4);
                const f32x4 d4 = *(const LAS f32x4*)(dvec + 16 * mt + 4 * q4);
                accS[mt] = accS[mt] * d4;
                accS[mt] = __builtin_amdgcn_mfma_f32_16x16x16bf16_1k(__builtin_bit_cast(bf16x4, kh2), vf, accS[mt], 0, 0, 0);
            }
            if (FULL) {
            const float s0 = sum16(acco[0] * acco[0]), s1 = sum16(acco[1] * acco[1]), s2 = sum16(acco[2] * acco[2]), s3 = sum16(acco[3] * acco[3]);
            if (c16 == 0) { *(LAS f32x4*)(ssq + w * 16 + 4 * q4) = (f32x4){s0, s1, s2, s3}; }
            }
        }
        if (FULL) __syncthreads();
        if (FULL) {
            f32x4 tot = (f32x4){0.f, 0.f, 0.f, 0.f};
#pragma unroll
            for (int ww = 0; ww < 8; ++ww) tot += *(const LAS f32x4*)(ssq + ww * 16 + 4 * q4);
#pragma unroll
            for (int j = 0; j < 4; ++j) { const float rstd = __builtin_amdgcn_rsqf(tot[j] * (1.f / 128.f) + EPS); const float o = acco[j] * rstd * an * bf2f(gr[j]);
                po[(size_t)(16 * n + j) * D] = (bf16_t)(cvt_pk_bf16(o, 0.f) & 0xffffu); }
        }
    }
    if (Sout) {
        if (Dout) {
#pragma unroll
            for (int mt = 0; mt < 8; ++mt)
#pragma unroll
                for (int j = 0; j < 4; ++j) Sout[(mt * 4 + j) * 512 + tid] = accS[mt][j];
        } else {
#pragma unroll
            for (int mt = 0; mt < 8; ++mt)
#pragma unroll
                for (int j = 0; j < 4; ++j) Sout[(size_t)(16 * mt + 4 * q4 + j) * 128 + 16 * w + c16] = accS[mt][j];
        }
    }
    if (Dout && tid < 128) Dout[tid] = __expf(btot);
    __syncthreads();
}

__device__ __forceinline__ void unpack8(const u32x4 w, float (&v)[8]) { v[0] = bflo(w.x); v[1] = bfhi(w.x); v[2] = bflo(w.y); v[3] = bfhi(w.y); v[4] = bflo(w.z); v[5] = bfhi(w.z); v[6] = bflo(w.w); v[7] = bfhi(w.w); }
__device__ __forceinline__ u32x4 pack8(const float (&v)[8]) { u32x4 o; o.x = cvt_pk_bf16(v[0], v[1]); o.y = cvt_pk_bf16(v[2], v[3]); o.z = cvt_pk_bf16(v[4], v[5]); o.w = cvt_pk_bf16(v[6], v[7]); return o; }
__device__ __forceinline__ void load8f(const float* p, float (&v)[8]) { const f32x4 a = *(const f32x4*)p, b = *(const f32x4*)(p + 4); v[0] = a[0]; v[1] = a[1]; v[2] = a[2]; v[3] = a[3]; v[4] = b[0]; v[5] = b[1]; v[6] = b[2]; v[7] = b[3]; }
__device__ __forceinline__ void store8f(float* p, const float (&v)[8]) { *(f32x4*)p = (f32x4){v[0], v[1], v[2], v[3]}; *(f32x4*)(p + 4) = (f32x4){v[4], v[5], v[6], v[7]}; }

__device__ __forceinline__ void shortconv_phase(const Args& a, int l, int R0, int MG, const bf16_t* P, bf16_t* AB, unsigned* ctr, volatile LAS unsigned* bcast) {
    const float* cw = a.in[17] + (size_t)l * 3 * BW;
    int tidc = threadIdx.x; asm volatile("" : "+v"(tidc));
    const int nconv = (MG / 8) * 64;
    for (;;) {
        __syncthreads();
        if (tidc == 0) *bcast = __hip_atomic_fetch_add(ctr, 512u, __ATOMIC_RELAXED, __HIP_MEMORY_SCOPE_AGENT);
        __syncthreads();
        const int it = (int)*bcast + tidc;
        if (it - tidc >= nconv) break;
        if (it >= nconv) continue;
        const int rb = it >> 6, ch = (it & 63) * 8, r0 = rb * 8, R = R0 + r0;
        int t0, Lq; const float* st_in = nullptr; float* st_out;
        if (R < MP) { t0 = R & (SEQ - 1); Lq = SEQ; st_out = a.out + O_SCP + (size_t)((l * 16 + (R >> 12)) * 2) * BW; }
        else { const int Rs = R - MP; t0 = Rs & 15; Lq = DSEQ; const int sq = Rs >> 4; st_in = a.in[3] + (size_t)((l * 16 + sq) * 2) * BW; st_out = a.out + O_SCS + (size_t)((l * 16 + sq) * 2) * BW; }
        float w0[8], w1[8], w2[8], p2[8], p1[8];
        load8f(cw + ch, w0); load8f(cw + BW + ch, w1); load8f(cw + 2 * BW + ch, w2);
        if (t0 == 0) {
            if (st_in) { load8f(st_in + ch, p2); load8f(st_in + BW + ch, p1); }
            else {
#pragma unroll
                for (int e = 0; e < 8; ++e) { p2[e] = 0.f; p1[e] = 0.f; } }
        } else {
            float c8[8], v8[8];
            unpack8(*(const u32x4*)(P + (size_t)(r0 - 2) * N1 + 2560 + ch), c8); unpack8(*(const u32x4*)(P + (size_t)(r0 - 2) * N1 + 3072 + ch), v8);
#pragma unroll
            for (int e = 0; e < 8; ++e) p2[e] = c8[e] * v8[e];
            unpack8(*(const u32x4*)(P + (size_t)(r0 - 1) * N1 + 2560 + ch), c8); unpack8(*(const u32x4*)(P + (size_t)(r0 - 1) * N1 + 3072 + ch), v8);
#pragma unroll
            for (int e = 0; e < 8; ++e) p1[e] = c8[e] * v8[e];
        }
#pragma unroll 2
        for (int i = 0; i < 8; ++i) {
            const bf16_t* pr = P + (size_t)(r0 + i) * N1;
            float b8[8], c8[8], v8[8], o8[8];
            unpack8(*(const u32x4*)(pr + 2048 + ch), b8); unpack8(*(const u32x4*)(pr + 2560 + ch), c8); unpack8(*(const u32x4*)(pr + 3072 + ch), v8);
#pragma unroll
            for (int e = 0; e < 8; ++e) { const float cv = c8[e] * v8[e]; o8[e] = b8[e] * (w0[e] * p2[e] + w1[e] * p1[e] + w2[e] * cv); p2[e] = p1[e]; p1[e] = cv; }
            *(u32x4*)(AB + (size_t)(r0 + i) * D + 512 + ch) = pack8(o8);
        }
        if (t0 + 8 == Lq) { store8f(st_out + ch, p2); store8f(st_out + BW + ch, p1); }
    }
}
#define XB_TMO      128
#define XB_XCNT(j)  (256  + 64 * (j))
#define XB_XSUB(j)  (1280 + 64 * (j))
#define XB_XGEN(j)  (2304 + 64 * (j))
#define XB_TOP      3328
#define XB_TOPGEN   3392
#define XCD_BAR_WORDS 3456
#define XB_SPIN_CAP (1u << 22)
__device__ __forceinline__ unsigned xb_ld(unsigned* p)              { return __hip_atomic_load(p, __ATOMIC_RELAXED, __HIP_MEMORY_SCOPE_AGENT); }
__device__ __forceinline__ unsigned xb_add(unsigned* p, unsigned v) { return __hip_atomic_fetch_add(p, v, __ATOMIC_RELAXED, __HIP_MEMORY_SCOPE_AGENT); }
__device__ __forceinline__ unsigned xb_xcc_id() { return (unsigned)__builtin_amdgcn_s_getreg((3 << 11) | 20) & 0xFu; }
#define XB_SPIN(cond, bar) do { unsigned _sp = 0; while (cond) { __builtin_amdgcn_s_sleep(1); \
    if ((++_sp & 255u) == 0u) { if (xb_ld(&(bar)[XB_TMO])) break; if (_sp > XB_SPIN_CAP) { atomicAdd(&(bar)[XB_TMO], 1u); break; } } } } while (0)
struct XcdBarrier { unsigned* bar; unsigned x; volatile LAS unsigned* st; };
__device__ __forceinline__ XcdBarrier xcd_barrier_post(unsigned* bar, volatile LAS unsigned* st) {
    XcdBarrier b; b.bar = bar; b.x = xb_xcc_id(); b.st = st;
    if (threadIdx.x == 0) (void)xb_add(&bar[XB_XCNT(b.x)], 1u);
    return b;
}
__device__ __forceinline__ void xcd_barrier_complete(unsigned* bar, unsigned x, unsigned& nloc, unsigned& nx) {
    const unsigned G = gridDim.x * gridDim.y * gridDim.z;
    unsigned sum, cnt, mine, sp = 0u;
    for (;;) {
        sum = 0u; cnt = 0u; mine = 0u;
#pragma unroll
        for (unsigned j = 0; j < 16; ++j) { const unsigned c = xb_ld(&bar[XB_XCNT(j)]); sum += c; cnt += (c > 0u) ? 1u : 0u; mine = (j == x) ? c : mine; }
        if (sum == G) break;
        __builtin_amdgcn_s_sleep(1);
        if ((++sp & 255u) == 0u) { if (xb_ld(&bar[XB_TMO])) break; if (sp > XB_SPIN_CAP) { atomicAdd(&bar[XB_TMO], 1u); break; } }
    }
    nloc = mine > 0u ? mine : 1u; nx = cnt > 0u ? cnt : 1u;
}
__device__ __forceinline__ void xcd_barrier(const XcdBarrier& b) {
    asm volatile("s_waitcnt vmcnt(0) lgkmcnt(0)" ::: "memory");
    __syncthreads();
    if (threadIdx.x == 0) {
        unsigned* bar = b.bar;
        __builtin_amdgcn_s_waitcnt(0);
        unsigned nloc = b.st[0], nx = b.st[1];
        if (nloc == 0u) { xcd_barrier_complete(bar, b.x, nloc, nx); b.st[0] = nloc; b.st[1] = nx; }
        const unsigned old = xb_add(&bar[XB_XSUB(b.x)], 1u);
        const unsigned gen = old / nloc;
        if (old + 1u == (gen + 1u) * nloc) {
            __builtin_amdgcn_fence(__ATOMIC_RELEASE, "agent");
            asm volatile("s_waitcnt vmcnt(0)" ::: "memory");
            const unsigned og = xb_add(&bar[XB_TOP], 1u);
            const unsigned tg = og / nx;
            if (og + 1u == (tg + 1u) * nx) xb_add(&bar[XB_TOPGEN], 1u);
            else XB_SPIN(xb_ld(&bar[XB_TOPGEN]) == tg, bar);
            __builtin_amdgcn_fence(__ATOMIC_ACQUIRE, "agent");
            xb_add(&bar[XB_XGEN(b.x)], 1u);
            asm volatile("s_waitcnt vmcnt(0)" ::: "memory");
        } else {
            XB_SPIN(xb_ld(&bar[XB_XGEN(b.x)]) == gen, bar);
            __builtin_amdgcn_fence(__ATOMIC_ACQUIRE, "agent");
            asm volatile("s_waitcnt vmcnt(0)" ::: "memory");
        }
    }
    __syncthreads();
}

#define GSYNC_CG() do { asm volatile("s_waitcnt vmcnt(0) lgkmcnt(0)" ::: "memory"); grid.sync(); } while (0)
#define GSYNC() xcd_barrier(xbar)
__global__ void __launch_bounds__(512, 2) fwd_megakernel(Args a) {
    extern __shared__ __attribute__((aligned(16))) unsigned char lds_raw[];
    LAS unsigned char* lds = (LAS unsigned char*)lds_raw;
    cg::grid_group grid = cg::this_grid();
    const int tid = threadIdx.x, lane = tid & 63, wave = __builtin_amdgcn_readfirstlane(tid >> 6);
    const int G = gridDim.x, wg = blockIdx.x;
    unsigned char* ws = a.ws;
    volatile LAS unsigned* MISC = (volatile LAS unsigned*)(lds + 131072 + 320);
    if (tid < 32) MISC[tid] = 0u;
    __syncthreads();
    const XcdBarrier xbar = xcd_barrier_post((unsigned*)ws + 4096, MISC + 8);
    float* ADA = (float*)(ws + WS_ADA);
    float* LB = (float*)(ws + WS_LB);
    bf16_t* Hb = (bf16_t*)(ws + WS_H);
    bf16_t* ABb = (bf16_t*)(ws + WS_AB);
    bf16_t* Pb = (bf16_t*)(ws + WS_P);
    bf16_t* ACTb = (bf16_t*)(ws + WS_ACT);
    bf16_t* XBb = (bf16_t*)(ws + WS_XB);

    if (wg < 192) {
        LAS float* csT = (LAS float*)lds;
        for (int i = tid; i < 32 * 1024; i += 512) { const int b = i >> 10, kx = i & 1023; const float c = (b < 16) ? a.in[5][(size_t)b * D + kx] : a.in[6][(size_t)(b - 16) * D + kx]; csT[kx * 32 + b] = c * fsigmoid(c); }
        __syncthreads();
        const int cc = tid & 127, kq = tid >> 7;
        const int col = wg * 128 + cc;
        const int l = col / 6144, n = col - l * 6144;
        const float* wp = a.in[7] + (size_t)l * D * 6144 + n;
        float acc[32];
#pragma unroll
        for (int b = 0; b < 32; ++b) acc[b] = 0.f;
#pragma unroll 4
        for (int kx = 256 * kq; kx < 256 * kq + 256; ++kx) { const float wv = wp[(size_t)kx * 6144];
#pragma unroll
            for (int b4 = 0; b4 < 8; ++b4) { const f32x4 c4 = *(const LAS f32x4*)(csT + kx * 32 + 4 * b4); acc[4 * b4] += c4[0] * wv; acc[4 * b4 + 1] += c4[1] * wv; acc[4 * b4 + 2] += c4[2] * wv; acc[4 * b4 + 3] += c4[3] * wv; } }
        __syncthreads();
        LAS float* red = (LAS float*)lds;
#pragma unroll
        for (int b = 0; b < 32; ++b) red[(kq * 32 + b) * 128 + cc] = acc[b];
        __syncthreads();
#pragma unroll
        for (int i = 0; i < 8; ++i) { const int o = tid + 512 * i, b = o >> 7, c2 = o & 127; const int col2 = wg * 128 + c2, n2 = col2 - l * 6144;
            const float v = red[(0 * 32 + b) * 128 + c2] + red[(1 * 32 + b) * 128 + c2] + red[(2 * 32 + b) * 128 + c2] + red[(3 * 32 + b) * 128 + c2];
            ADA[((size_t)l * 32 + b) * 6144 + n2] = v + a.in[8][(size_t)l * 6144 + n2]; }
        __syncthreads();
    }
    if (wg == 192) {
        const float x0 = a.in[14][tid], x1 = a.in[14][512 + tid], x2 = a.in[14][1024 + tid], x3 = a.in[14][1536 + tid];
        const float mx = fmaxf(fmaxf(x0, x1), fmaxf(x2, x3));
        const float e0 = __expf(x0 - mx), e1 = __expf(x1 - mx), e2 = __expf(x2 - mx), e3 = __expf(x3 - mx), inv = 1.f / (e0 + e1 + e2 + e3);
        LB[tid] = 0.f; LB[512 + tid] = e1 * inv; LB[1024 + tid] = (e1 + e2) * inv; LB[1536 + tid] = (e1 + e2 + e3) * inv;
    }
    {
        LAS float* scr = (LAS float*)(lds + wave * 16384);
        const int gw = wg * 8 + wave, NGW = G * 8;
        constexpr int I_IN = 16 * (NIN / 32), I_BG = 16 * (2048 / 32), I_PA = 8 * 32, I_PB = 8 * 32, I_O = 16 * 32, I_UP = 16 * (NUP / 32), I_DN = (DFF / 64) * 32;
        constexpr int I_LAYER = I_IN + I_BG + I_PA + I_PB + I_O + I_UP + I_DN;
        for (int it = gw; it < 4 * I_LAYER; it += NGW) {
            const int l = it / I_LAYER; int r = it - l * I_LAYER;
            bf16_t* wl = (bf16_t*)(ws + WS_W + (size_t)l * LAYER_W);
            if (r < I_IN) { transpose_item(a.in[13] + (size_t)l * D * NIN, D, NIN, wl + W1_OFF / 2, 0, scr, r, lane); continue; } r -= I_IN;
            if (r < I_BG) { transpose_item(a.in[19] + (size_t)l * D * 2048, D, 2048, wl + W1_OFF / 2, NIN, scr, r, lane); continue; } r -= I_BG;
            if (r < I_PA) { transpose_item(a.in[16] + (size_t)l * AW * D, AW, D, wl + WPA_OFF / 2, 0, scr, r, lane); continue; } r -= I_PA;
            if (r < I_PB) { transpose_item(a.in[18] + (size_t)l * BW * D, BW, D, wl + WPB_OFF / 2, 0, scr, r, lane); continue; } r -= I_PB;
            if (r < I_O) { transpose_item(a.in[20] + (size_t)l * D * D, D, D, wl + WO_OFF / 2, 0, scr, r, lane); continue; } r -= I_O;
            if (r < I_UP) { const int n0 = 32 * (r % (NUP / 32));
                const int jj = n0 < DFF ? n0 : n0 - DFF, rowb = 256 * (jj >> 7) + (n0 < DFF ? 0 : 128) + (jj & 127);
                transpose_item(a.in[21] + (size_t)l * D * NUP, D, NUP, wl + WUP_OFF / 2, rowb - n0, scr, r, lane); continue; } r -= I_UP;
            transpose_item(a.in[23] + (size_t)l * DFF * D, DFF, D, wl + WDN_OFF / 2, 0, scr, r, lane);
        }
    }
    GSYNC_CG();

    for (int grp = 0; grp < 2; ++grp) {
        const int R0 = grp ? MG0 : 0, MG = grp ? MG1 : MG0, nM = MG / 256;
        int tid = threadIdx.x; asm volatile("" : "+v"(tid));
        const int lane = tid & 63, wave = __builtin_amdgcn_readfirstlane(tid >> 6);
        const int rper = (MG + G * 8 - 1) / (G * 8);
        {
            const int r0 = (wg * 8 + wave) * rper, r1 = (r0 + rper < MG) ? r0 + rper : MG;
            const RowVecs gpr = load_vecs(a.in[9], lane); RowVecs vsc = gpr, vsh = gpr; int curb = -1;
            for (int r = r0; r < r1; ++r) {
                const int R = R0 + r, bb = row_batch(R); const float* xin = (R < MP) ? a.in[0] + (size_t)R * D : a.in[1] + (size_t)(R - MP) * D;
                if (bb != curb) { curb = bb; const float* ad = ADA + (size_t)bb * 6144; vsc = load_vecs(ad + 1024, lane); vsh = load_vecs(ad, lane); }
                row_pass(nullptr, xin, nullptr, nullptr, nullptr, gpr, gpr, Hb + (size_t)r * D, gpr, vsc, vsh, lane);
            }
        }
        GSYNC();
        for (int l = 0; l < DEPTH; ++l) {
            int tid = threadIdx.x; asm volatile("" : "+v"(tid));
            const int lane = tid & 63, wave = __builtin_amdgcn_readfirstlane(tid >> 6);
            const bf16_t* wl = (const bf16_t*)(ws + WS_W + (size_t)l * LAYER_W);
            { pg8::Gemm g{Hb, wl + W1_OFF / 2, D, D, D}; pg8::StaticOrder S; S.init(nM, N1 / 256, G, wg); pg8::EpiStore E{Pb, N1, 1}; pg8::gemm_phase(lds, g, S, E); }
            GSYNC();
            {
                int tidb = threadIdx.x; asm volatile("" : "+v"(tidb));
                const int chain = wg >> 3, chunk = wg & 7, sqg = chain >> 2, hd = chain & 3;
                const int lrow = sqg * SEQ + chunk * 512;
                float* DS = (float*)(ws + WS_DS) + (size_t)(chain * 8) * 16384;
                float* DD = (float*)(ws + WS_DD) + (size_t)(chain * 8) * 128;
                float* SS = (float*)(ws + WS_SS) + (size_t)wg * 16384;
                const float* lbv = LB + l * 512 + hd * 128;
                const float* anv = a.in[15] + l * 128;
                if (wg < 256 && chunk < 7)
                    hgrn_item<false>(lds, Pb + (size_t)lrow * N1, ABb + (size_t)lrow * D, 512, hd, lbv, anv, nullptr, nullptr, 0, DS + (size_t)chunk * 16384, DD + chunk * 128);
                shortconv_phase(a, l, R0, MG, Pb, ABb, (unsigned*)ws + 1024 + 64 * (grp * 4 + l), MISC + 16);
                GSYNC();
                if (wg < 256)
                    hgrn_item<true>(lds, Pb + (size_t)lrow * N1, ABb + (size_t)lrow * D, 512, hd, lbv, anv, DS, DD, chunk,
                              chunk == 7 ? a.out + O_SHP + (size_t)((l * 16 + 8 * grp + sqg) * 4 + hd) * 16384 : nullptr, nullptr);
                if (grp == 1 && wg < 64) {
                    const int sq = wg >> 2, hs = wg & 3; const int srow = MG0 + sq * DSEQ;
                    hgrn_item<true>(lds, Pb + (size_t)srow * N1, ABb + (size_t)srow * D, DSEQ, hs, LB + l * 512 + hs * 128, anv,
                              a.in[2] + (size_t)((l * 16 + sq) * 4 + hs) * 16384, nullptr, 1, a.out + O_SHS + (size_t)((l * 16 + sq) * 4 + hs) * 16384, nullptr);
                }
            }
            GSYNC();
            { pg8::Gemm g{ABb, wl + WPA_OFF / 2, D, AW, AW}; pg8::StaticOrder S; S.init(nM, D / 256, G, wg); pg8::EpiGate E{Hb, Pb + NIN, 0}; pg8::gemm_phase(lds, g, S, E); }
            { pg8::Gemm g{ABb + AW, wl + WPB_OFF / 2, D, BW, BW}; pg8::StaticOrder S; S.init(nM, D / 256, G, wg); pg8::EpiGate E{Hb, Pb + NIN + D, 1}; pg8::gemm_phase(lds, g, S, E); }
            GSYNC();
            { pg8::Gemm g{Hb, wl + WO_OFF / 2, D, D, D}; pg8::StaticOrder S; S.init(nM, D / 256, G, wg); pg8::EpiStore E{ABb, D, 0}; pg8::gemm_phase(lds, g, S, E); }
            GSYNC();
            {
                const int r0 = (wg * 8 + wave) * rper, r1 = (r0 + rper < MG) ? r0 + rper : MG;
                const RowVecs gpo = load_vecs(a.in[10] + l * D, lane), gpr = load_vecs(a.in[11] + l * D, lane); RowVecs vg = gpo, vsc = gpo, vsh = gpo; int curb = -1;
                for (int r = r0; r < r1; ++r) {
                    const int R = R0 + r, bb = row_batch(R); const float* xin = (R < MP) ? a.in[0] + (size_t)R * D : a.in[1] + (size_t)(R - MP) * D;
                    if (bb != curb) { curb = bb; const float* ad = ADA + ((size_t)l * 32 + bb) * 6144; vg = load_vecs(ad + 2048, lane); vsc = load_vecs(ad + 4096, lane); vsh = load_vecs(ad + 3072, lane); }
                    row_pass(ABb + (size_t)r * D, xin, (l == 0) ? nullptr : XBb + (size_t)r * D, nullptr, XBb + (size_t)r * D, gpo, vg, Hb + (size_t)r * D, gpr, vsc, vsh, lane);
                }
            }
            GSYNC();
            { pg8::Gemm g{Hb, wl + WUP_OFF / 2, D, D, D, 254, -2}; pg8::StaticOrder S; S.init((MG + 253) / 254, NUP / 256, G, wg);
              pg8::EpiFfn E{ACTb, a.in[22] + (size_t)l * 3 * DFF, a.in[4], a.out + O_SFP, a.out + O_SFS, R0, MG, l, (LAS float*)(lds + 131072 + 1024)};
              pg8::gemm_phase(lds, g, S, E); }
            GSYNC();
            { pg8::Gemm g{ACTb, wl + WDN_OFF / 2, DFF, DFF, DFF}; pg8::StaticOrder S; S.init(nM, D / 256, G, wg); pg8::EpiStore E{ABb, D, 0}; pg8::gemm_phase(lds, g, S, E); }
            GSYNC();
            {
                const int r0 = (wg * 8 + wave) * rper, r1 = (r0 + rper < MG) ? r0 + rper : MG; const int ln = (l + 1 < DEPTH) ? l + 1 : l;
                const RowVecs gpo = load_vecs(a.in[12] + l * D, lane), gpr = load_vecs(a.in[9] + ln * D, lane); RowVecs vg = gpo, vsc = gpo, vsh = gpo; int curb = -1;
                for (int r = r0; r < r1; ++r) {
                    const int R = R0 + r, bb = row_batch(R);
                    if (bb != curb) { curb = bb; const float* ad = ADA + ((size_t)l * 32 + bb) * 6144; const float* adn = ADA + ((size_t)ln * 32 + bb) * 6144;
                        vg = load_vecs(ad + 5120, lane); vsc = load_vecs(adn + 1024, lane); vsh = load_vecs(adn, lane); }
                    row_pass(ABb + (size_t)r * D, nullptr, XBb + (size_t)r * D, a.out + (size_t)R * D, (l + 1 < DEPTH) ? XBb + (size_t)r * D : nullptr, gpo, vg, (l + 1 < DEPTH) ? Hb + (size_t)r * D : nullptr, gpr, vsc, vsh, lane);
                }
            }
            if (l + 1 < DEPTH) GSYNC();
        }
    }
}

extern "C" void kernel_launch(void* const* d_in, const int* in_sizes, int n_in, void* d_out, int out_size, void* d_ws, size_t ws_size, hipStream_t stream) {
    static int grid = 0;
    if (grid == 0) {
        if (n_in != 24 || ws_size < WS_END) { fprintf(stderr, "kernel_launch: unexpected n_in %d / ws_size %zu (need %zu)\n", n_in, ws_size, (size_t)WS_END); grid = -1; return; }
        int dev = 0, cus = 0, per_cu = 0;
        hipGetDevice(&dev);
        hipDeviceGetAttribute(&cus, hipDeviceAttributeMultiprocessorCount, dev);
        if (hipFuncSetAttribute((const void*)fwd_megakernel, hipFuncAttributeMaxDynamicSharedMemorySize, LDS_BYTES) != hipSuccess) { fprintf(stderr, "kernel_launch: hipFuncSetAttribute failed\n"); }
        if (hipOccupancyMaxActiveBlocksPerMultiprocessor(&per_cu, (const void*)fwd_megakernel, 512, LDS_BYTES) != hipSuccess || per_cu < 1) { fprintf(stderr, "kernel_launch: occupancy query says %d\n", per_cu); per_cu = 1; }
        (void)hipGetLastError();
        grid = cus;
    }
    if (grid < 0) return;
    if (hipMemsetAsync(d_ws, 0, 65536, stream) != hipSuccess) { fprintf(stderr, "kernel_launch: hipMemsetAsync failed\n"); return; }
    Args a{};
    for (int i = 0; i < 24; ++i) a.in[i] = (const float*)d_in[i];
    a.out = (float*)d_out; a.ws = (unsigned char*)d_ws;
    void* args[] = {&a};
    hipError_t e = hipLaunchCooperativeKernel((const void*)fwd_megakernel, dim3(grid), dim3(512), args, LDS_BYTES, stream);
    if (e != hipSuccess) fprintf(stderr, "kernel_launch: cooperative launch failed: %s (grid %d)\n", hipGetErrorString(e), grid);
}
```

```cpp
#include <hip/hip_runtime.h>
#include <hip/hip_cooperative_groups.h>
#include <cstdio>
#include <cstdint>
namespace cg = cooperative_groups;

#define LAS __attribute__((address_space(3)))
typedef unsigned short bf16_t;
typedef short bf16x8 __attribute__((ext_vector_type(8)));
typedef short bf16x4 __attribute__((ext_vector_type(4)));
typedef float f32x4 __attribute__((ext_vector_type(4)));
typedef unsigned u32x4 __attribute__((ext_vector_type(4)));
typedef unsigned u32x2 __attribute__((ext_vector_type(2)));

constexpr int D = 1024, SEQ = 4096, NBATCH = 16, DEPTH = 4, DSEQ = 16;
constexpr int AW = 512, BW = 512, DFF = 2816, NIN = 3584, N1 = 5632, NUP = 5632;
constexpr int MP = NBATCH * SEQ;
constexpr int MS = NBATCH * DSEQ;
constexpr int MG0 = 32768, MG1 = 33024, MGMAX = 33024;
constexpr float EPS = 1e-6f;
constexpr size_t O_YP = 0, O_YS = 67108864, O_SHP = 67371008, O_SCP = 71565312, O_SFP = 71630848, O_SHS = 71991296, O_SCS = 76185600, O_SFS = 76251136;
constexpr size_t MiB = 1u << 20;
constexpr size_t WS_ADA = 1 * MiB;
constexpr size_t WS_LB = 5 * MiB;
constexpr size_t WS_W = 8 * MiB;
constexpr size_t W1_OFF = 0, WPA_OFF = (size_t)N1 * D * 2, WPB_OFF = WPA_OFF + (size_t)D * AW * 2, WO_OFF = WPB_OFF + (size_t)D * BW * 2,
                 WUP_OFF = WO_OFF + (size_t)D * D * 2, WDN_OFF = WUP_OFF + (size_t)NUP * D * 2, LAYER_W = WDN_OFF + (size_t)D * DFF * 2;
constexpr size_t WS_H = 136 * MiB;
constexpr size_t WS_AB = 202 * MiB;
constexpr size_t WS_P = 268 * MiB;
constexpr size_t WS_ACT = 624 * MiB;
constexpr size_t WS_DS = 804 * MiB;
constexpr size_t WS_DD = 822 * MiB;
constexpr size_t WS_SS = 824 * MiB;
constexpr size_t WS_DUMMY = 840 * MiB;
constexpr size_t WS_XB = 842 * MiB;
constexpr size_t WS_END = 908 * MiB;
static_assert(WS_W + 4 * LAYER_W <= WS_H && WS_H + (size_t)MGMAX * D * 2 <= WS_AB && WS_AB + (size_t)MGMAX * D * 2 <= WS_P && WS_P + (size_t)MGMAX * N1 * 2 <= WS_ACT && WS_ACT + (size_t)MGMAX * DFF * 2 <= WS_DS && WS_DS + (size_t)32 * 8 * 16384 * 4 <= WS_DD, "ws map");
constexpr int LDS_BYTES = 147456;

__device__ __forceinline__ unsigned cvt_pk_bf16(float lo, float hi) { unsigned r; asm volatile("v_cvt_pk_bf16_f32 %0, %1, %2" : "=v"(r) : "v"(lo), "v"(hi)); return r; }
__device__ __forceinline__ float bf2f(unsigned short b) { return __uint_as_float(((unsigned)b) << 16); }
__device__ __forceinline__ float bflo(unsigned w) { return __uint_as_float(w << 16); }
__device__ __forceinline__ float bfhi(unsigned w) { return __uint_as_float(w & 0xffff0000u); }
__device__ __forceinline__ float fsigmoid(float x) { return __builtin_amdgcn_rcpf(1.f + __expf(-x)); }
template <int CTRL> __device__ __forceinline__ float dpp_rot(float v) { return __builtin_bit_cast(float, __builtin_amdgcn_update_dpp(0, __builtin_bit_cast(int, v), CTRL, 0xf, 0xf, true)); }
__device__ __forceinline__ float sum16(float x) { x += dpp_rot<0x128>(x); x += dpp_rot<0x124>(x); x += dpp_rot<0x122>(x); x += dpp_rot<0x121>(x); return x; }
__device__ __forceinline__ float wave_sum(float v) { v = sum16(v); v += __shfl_xor(v, 16); v += __shfl_xor(v, 32); return v; }

namespace pg8 {
constexpr int BM = 256, BK = 64, HALF = 128, HTB = HALF * BK * 2, STAGE_BYTES = 8 * HTB, NXCD = 8, WGM = 8;
__host__ __device__ __forceinline__ int lds_byte(int r, int c) { const int st = (r >> 4) * 2 + (c >> 5), rr = r & 15, cc = c & 31, ob = rr * 64 + cc * 2; return st * 1024 + (ob ^ (((ob >> 9) & 1) << 5)); }
__host__ __device__ __forceinline__ void stage_rc(int b, int& R, int& C) { const int st = b / 1024, sb = b % 1024, swz = sb ^ (((sb >> 9) & 1) << 5); R = (st >> 1) * 16 + swz / 64; C = (st & 1) * 32 + (swz % 64) / 2; }
__host__ __device__ __forceinline__ int perm32(int rho) { const int n = rho >> 4, i = rho & 15; return 8 * (i >> 2) + 4 * n + (i & 3); }
struct Unit { int pm, pn; };
struct Gemm { const bf16_t* A; const bf16_t* Bt; int lda, ldb, K; int mstride = 256; int arow0 = 0; };
struct StaticOrder {
    int nM, nN, nwg, G, c;
    __device__ void init(int nM_, int nN_, int G_, int c_) { nM = nM_; nN = nN_; nwg = nM * nN; G = G_; c = c_; }
    __device__ bool next(int i, Unit& u) const {
        const long L = (long)i * G + c; if (L >= nwg) return false;
        int wgid = (int)L; { const int q = nwg / NXCD, r = nwg % NXCD, xcd = wgid % NXCD, off = wgid / NXCD; wgid = (xcd < r ? xcd * (q + 1) : r * (q + 1) + (xcd - r) * q) + off; }
        const int nig = WGM * nN, gid = wgid / nig, fm = gid * WGM, gsz = (nM - fm) < WGM ? (nM - fm) : WGM;
        u.pm = fm + ((wgid % nig) % gsz); u.pn = (wgid % nig) / gsz; return true;
    }
};
template <class Epi>
__device__ __forceinline__ void gemm_phase(LAS unsigned char* lds, const Gemm g, const StaticOrder& S, const Epi& E) {
    int tid = threadIdx.x; asm volatile("" : "+v"(tid));
    const int wid = __builtin_amdgcn_readfirstlane(tid >> 6), lane = tid & 63, wr = wid >> 2, wc = wid & 3, fr = lane & 15, fq = lane >> 4;
    const int K = g.K, nt = K / BK;
    unsigned voffA[2], voffB[2];
#pragma unroll
    for (int i = 0; i < 2; ++i) { int R, C; stage_rc(tid * 16 + i * 8192, R, C); const int Rb = (R & ~31) + perm32(R & 31);
        voffA[i] = (unsigned)(R * g.lda + C) * 2u; voffB[i] = (unsigned)(Rb * g.ldb + C) * 2u; }
    const size_t kstep = (size_t)(BK * 2);
    const size_t hstepA = (size_t)HALF * g.lda * 2, hstepB = (size_t)HALF * g.ldb * 2;
    const long tstepA = (long)g.mstride * g.lda * 2, tstepB = (long)(2 * hstepB); const long abase0 = (long)g.arow0 * g.lda * 2;
    const unsigned ldsw = (unsigned)wid * 1024u;
    const int aoff = lds_byte(wr * 64 + fr, fq * 8), boff = lds_byte(wc * 32 + fr, fq * 8);
#define PG8_SA(b, h) (((b) * 2 + (h)) * HTB)
#define PG8_SB(b, h) ((4 + (b) * 2 + (h)) * HTB)
#define PG8_STAGE(bufoff, gbase, voff) do { _Pragma("unroll") for (int _i = 0; _i < 2; ++_i) \
        __builtin_amdgcn_global_load_lds((const unsigned*)((const char*)(gbase) + (voff)[_i]), (LAS unsigned*)(lds + (bufoff) + ldsw + _i * 8192), 16, 0, 0); } while (0)
#define PG8_LDA(dst, b, h) do { _Pragma("unroll") for (int m = 0; m < 4; ++m) _Pragma("unroll") for (int k = 0; k < 2; ++k) dst[m][k] = *(const LAS bf16x8*)(lds + PG8_SA(b, h) + aoff + m * 2048 + k * 1024); } while (0)
#define PG8_LDB(dst, b, h) do { _Pragma("unroll") for (int n = 0; n < 2; ++n) _Pragma("unroll") for (int k = 0; k < 2; ++k) dst[n][k] = *(const LAS bf16x8*)(lds + PG8_SB(b, h) + boff + n * 2048 + k * 1024); } while (0)
#define PG8_MMA(ai, bj, At, Bt) do { __builtin_amdgcn_s_setprio(1); _Pragma("unroll") for (int m = 0; m < 4; ++m) _Pragma("unroll") for (int n = 0; n < 2; ++n) _Pragma("unroll") for (int k = 0; k < 2; ++k) \
        acc[ai][bj][m][n] = __builtin_amdgcn_mfma_f32_16x16x32_bf16(Bt[n][k], At[m][k], acc[ai][bj][m][n], 0, 0, 0); __builtin_amdgcn_s_setprio(0); } while (0)
#define PG8_WAIT_V(n) asm volatile("s_waitcnt vmcnt(" #n ")" ::: "memory")
#define PG8_WAIT_L(n) asm volatile("s_waitcnt lgkmcnt(" #n ")" ::: "memory")
#define PG8_BAR __builtin_amdgcn_s_barrier()
#define PG8_SCHED __builtin_amdgcn_sched_barrier(0)
    Unit cur, nxt; int ui = 0;
    if (!S.next(0, cur)) return;
    f32x4 acc[2][2][4][2];
#pragma unroll
    for (int a = 0; a < 2; ++a)
#pragma unroll
        for (int b = 0; b < 2; ++b)
#pragma unroll
            for (int m = 0; m < 4; ++m)
#pragma unroll
                for (int n = 0; n < 2; ++n) acc[a][b][m][n] = (f32x4){0.f, 0.f, 0.f, 0.f};
    bf16x8 At[4][2], B0[2][2], B1[2][2];
    const char* cA = (const char*)g.A + abase0 + (long)cur.pm * tstepA; const char* cB = (const char*)g.Bt + (long)cur.pn * tstepB;
    PG8_STAGE(PG8_SB(0, 0), cB, voffB); PG8_STAGE(PG8_SB(0, 1), cB + hstepB, voffB); PG8_STAGE(PG8_SA(0, 0), cA, voffA); PG8_STAGE(PG8_SA(0, 1), cA + hstepA, voffA);
    if (wr == 1) PG8_BAR;
    PG8_WAIT_V(2); PG8_BAR;
    PG8_STAGE(PG8_SB(1, 0), cB + kstep, voffB); PG8_STAGE(PG8_SA(1, 0), cA + kstep, voffA); PG8_STAGE(PG8_SB(1, 1), cB + hstepB + kstep, voffB);
    PG8_WAIT_V(6); PG8_BAR;
    for (;;) {
        const bool has_next = S.next(ui + 1, nxt);
        const char* nA = has_next ? (const char*)g.A + abase0 + (long)nxt.pm * tstepA : cA; const char* nB = has_next ? (const char*)g.Bt + (long)nxt.pn * tstepB : cB;
        for (int t = 0; t < nt; t += 2) {
            const bool last = (t == nt - 2);
            const char* a1 = cA + (size_t)(t + 1) * kstep;
            const char* a2 = last ? nA : cA + (size_t)(t + 2) * kstep; const char* b2 = last ? nB : cB + (size_t)(t + 2) * kstep;
            const char* a3 = a2 + kstep; const char* b3 = b2 + kstep;
            PG8_LDB(B0, 0, 0); PG8_LDB(B1, 0, 1); PG8_SCHED; PG8_LDA(At, 0, 0); PG8_STAGE(PG8_SA(1, 1), a1 + hstepA, voffA);
            PG8_WAIT_V(8); PG8_WAIT_L(0); PG8_BAR; PG8_MMA(0, 0, At, B0); PG8_MMA(0, 1, At, B1); PG8_BAR; PG8_SCHED;
            PG8_LDA(At, 0, 1); PG8_STAGE(PG8_SB(0, 0), b2, voffB); PG8_STAGE(PG8_SB(0, 1), b2 + hstepB, voffB); PG8_STAGE(PG8_SA(0, 0), a2, voffA);
            PG8_WAIT_V(8); PG8_WAIT_L(0); PG8_BAR; PG8_MMA(1, 0, At, B0); PG8_MMA(1, 1, At, B1); PG8_BAR; PG8_SCHED;
            PG8_LDB(B0, 1, 0); PG8_LDB(B1, 1, 1); PG8_SCHED; PG8_LDA(At, 1, 0); PG8_STAGE(PG8_SA(0, 1), a2 + hstepA, voffA);
            PG8_WAIT_V(8); PG8_WAIT_L(0); PG8_BAR; PG8_MMA(0, 0, At, B0); PG8_MMA(0, 1, At, B1); PG8_BAR; PG8_SCHED;
            PG8_LDA(At, 1, 1); PG8_STAGE(PG8_SB(1, 0), b3, voffB); PG8_STAGE(PG8_SB(1, 1), b3 + hstepB, voffB); PG8_STAGE(PG8_SA(1, 0), a3, voffA);
            PG8_WAIT_V(8); PG8_WAIT_L(0); PG8_BAR; PG8_MMA(1, 0, At, B0); PG8_MMA(1, 1, At, B1); PG8_BAR; PG8_SCHED;
        }
        if (wr == 0) PG8_BAR;
        E(acc, cur, wr, wc, fr, fq);
        if (!has_next) break;
#pragma unroll
        for (int a = 0; a < 2; ++a)
#pragma unroll
            for (int b = 0; b < 2; ++b)
#pragma unroll
                for (int m = 0; m < 4; ++m)
#pragma unroll
                    for (int n = 0; n < 2; ++n) acc[a][b][m][n] = (f32x4){0.f, 0.f, 0.f, 0.f};
        cur = nxt; cA = nA; cB = nB; ++ui;
        if (wr == 1) PG8_BAR;
    }
    PG8_WAIT_V(0);
    PG8_BAR;
#undef PG8_SA
#undef PG8_SB
#undef PG8_STAGE
#undef PG8_LDA
#undef PG8_LDB
#undef PG8_MMA
#undef PG8_WAIT_V
#undef PG8_WAIT_L
#undef PG8_BAR
#undef PG8_SCHED
}

struct EpiStore {
    bf16_t* O; int ldc; int kind;
    __device__ __forceinline__ void operator()(const f32x4 (&acc)[2][2][4][2], const Unit& u, int wr, int wc, int fr, int fq) const {
        const int row0 = u.pm * BM + wr * 64 + fr, col0 = u.pn * BM + wc * 32 + 8 * fq;
        int act = 0;
        if (kind == 1) { const int pn = u.pn; act = (pn < 2 || pn == 6 || pn == 7) ? 1 : (pn >= 14 ? 2 : 0); }
#pragma unroll
        for (int ai = 0; ai < 2; ++ai)
#pragma unroll
            for (int m = 0; m < 4; ++m) { bf16_t* rowp = O + (size_t)(row0 + ai * HALF + m * 16) * ldc + col0;
#pragma unroll
                for (int bj = 0; bj < 2; ++bj) { f32x4 v0 = acc[ai][bj][m][0], v1 = acc[ai][bj][m][1];
                    if (act) {
#pragma unroll
                        for (int e = 0; e < 4; ++e) { const float s0 = fsigmoid(v0[e]), s1 = fsigmoid(v1[e]); v0[e] = (act == 1) ? v0[e] * s0 : s0; v1[e] = (act == 1) ? v1[e] * s1 : s1; }
                    }
                    u32x4 o; o.x = cvt_pk_bf16(v0[0], v0[1]); o.y = cvt_pk_bf16(v0[2], v0[3]); o.z = cvt_pk_bf16(v1[0], v1[1]); o.w = cvt_pk_bf16(v1[2], v1[3]);
                    *(u32x4*)(rowp + bj * HALF) = o; } }
    }
};
struct EpiGate {
    bf16_t* O; const bf16_t* Gt; int accum;
    __device__ __forceinline__ void operator()(const f32x4 (&acc)[2][2][4][2], const Unit& u, int wr, int wc, int fr, int fq) const {
        const int row0 = u.pm * BM + wr * 64 + fr, col0 = u.pn * BM + wc * 32 + 8 * fq;
#pragma unroll
        for (int ai = 0; ai < 2; ++ai) {
            u32x4 gv[4][2], ov[4][2];
#pragma unroll
            for (int m = 0; m < 4; ++m)
#pragma unroll
                for (int bj = 0; bj < 2; ++bj) { const size_t r = (size_t)(row0 + ai * HALF + m * 16); const int c = col0 + bj * HALF;
                    gv[m][bj] = *(const u32x4*)(Gt + r * N1 + c); ov[m][bj] = accum ? *(const u32x4*)(O + r * D + c) : (u32x4){0u, 0u, 0u, 0u}; }
#pragma unroll
            for (int m = 0; m < 4; ++m)
#pragma unroll
                for (int bj = 0; bj < 2; ++bj) { const size_t r = (size_t)(row0 + ai * HALF + m * 16); const int c = col0 + bj * HALF;
                    const u32x4 g = gv[m][bj], o0 = ov[m][bj];
                    f32x4 v0 = acc[ai][bj][m][0], v1 = acc[ai][bj][m][1];
                    v0[0] = v0[0] * bflo(g.x) + bflo(o0.x); v0[1] = v0[1] * bfhi(g.x) + bfhi(o0.x); v0[2] = v0[2] * bflo(g.y) + bflo(o0.y); v0[3] = v0[3] * bfhi(g.y) + bfhi(o0.y);
                    v1[0] = v1[0] * bflo(g.z) + bflo(o0.z); v1[1] = v1[1] * bfhi(g.z) + bfhi(o0.z); v1[2] = v1[2] * bflo(g.w) + bflo(o0.w); v1[3] = v1[3] * bfhi(g.w) + bfhi(o0.w);
                    u32x4 o; o.x = cvt_pk_bf16(v0[0], v0[1]); o.y = cvt_pk_bf16(v0[2], v0[3]); o.z = cvt_pk_bf16(v1[0], v1[1]); o.w = cvt_pk_bf16(v1[2], v1[3]);
                    *(u32x4*)(O + r * D + c) = o; }
        }
    }
};

struct EpiFfn {
    bf16_t* ACT; const float* cw; const float* stin; float* stout_p; float* stout_s; int R0, MG, l; LAS float* halo;
    __device__ __forceinline__ void operator()(const f32x4 (&acc)[2][2][4][2], const Unit& u, int wr, int wc, int fr, int fq) const {
        const int colg = u.pn * 128 + wc * 32 + 8 * fq;
        if (fr >= 14) {
#pragma unroll
            for (int ai = 0; ai < 2; ++ai) { LAS float* hp = halo + ((ai * 2 + wr) * 2 + (fr - 14)) * 128 + wc * 32 + 8 * fq; *(LAS f32x4*)hp = acc[ai][0][3][0]; *(LAS f32x4*)(hp + 4) = acc[ai][0][3][1]; }
        }
        asm volatile("s_waitcnt lgkmcnt(0)" ::: "memory"); __builtin_amdgcn_s_barrier(); asm volatile("" ::: "memory");
        const int lane = fq * 16 + fr, src1 = (lane & 48) | ((fr + 15) & 15), src2 = (lane & 48) | ((fr + 14) & 15);
#pragma unroll
        for (int n = 0; n < 2; ++n) {
            const int col = colg + 4 * n;
            const f32x4 w0 = *(const f32x4*)(cw + col), w1 = *(const f32x4*)(cw + DFF + col), w2 = *(const f32x4*)(cw + 2 * DFF + col);
#pragma unroll
            for (int ai = 0; ai < 2; ++ai)
#pragma unroll
                for (int m = 0; m < 4; ++m) {
                    const int rho = 128 * ai + 64 * wr + 16 * m + fr, Rl = u.pm * 254 - 2 + rho, R = R0 + Rl;
                    const bool valid = (rho >= 2) && (Rl < MG);
                    int t, Lq, sq; const bool smp = (R >= MP);
                    if (!smp) { t = R & (SEQ - 1); Lq = SEQ; sq = R >> 12; } else { const int Rs = R - MP; t = Rs & 15; Lq = DSEQ; sq = Rs >> 4; }
                    const f32x4 g4 = acc[ai][0][m][n];
                    const f32x4 gm = acc[ai][0][m > 0 ? m - 1 : 0][n];
                    f32x4 p1, p2;
#pragma unroll
                    for (int e = 0; e < 4; ++e) { const float s1 = (m > 0 && fr == 15) ? gm[e] : g4[e], s2 = (m > 0 && fr >= 14) ? gm[e] : g4[e]; p1[e] = dpp_rot<0x121>(s1); p2[e] = dpp_rot<0x122>(s2); }
                    if (m == 0) { const int pb = ai * 2 + wr - 1;
                        if (pb >= 0 && fr < 2) { const LAS float* h0 = halo + (pb * 2) * 128 + wc * 32 + 8 * fq + 4 * n;
                            const f32x4 x0 = *(const LAS f32x4*)h0, y0 = *(const LAS f32x4*)(h0 + 128);
                            if (fr == 0) { p1 = y0; p2 = x0; } else { p2 = y0; } } }
                    if (valid && t < 2) {
                        f32x4 s0v = (f32x4){0.f, 0.f, 0.f, 0.f}, s1v = s0v;
                        if (smp) { const float* sp = stin + (size_t)((l * 16 + sq) * 2) * DFF + col; s0v = *(const f32x4*)sp; s1v = *(const f32x4*)(sp + DFF); }
                        if (t == 0) { p1 = s1v; p2 = s0v; } else { p2 = s1v; }
                    }
                    if (valid) {
                        const f32x4 v4 = acc[ai][1][m][n];
                        float o[4];
#pragma unroll
                        for (int e = 0; e < 4; ++e) { const float y = w0[e] * p2[e] + w1[e] * p1[e] + w2[e] * g4[e]; o[e] = y * fsigmoid(y) * v4[e]; }
                        u32x2 ov; ov.x = cvt_pk_bf16(o[0], o[1]); ov.y = cvt_pk_bf16(o[2], o[3]);
                        *(u32x2*)(ACT + (size_t)Rl * DFF + col) = ov;
                        if (t >= Lq - 2) *(f32x4*)((smp ? stout_s : stout_p) + (size_t)((l * 16 + sq) * 2 + (t - (Lq - 2))) * DFF + col) = g4;
                    }
                }
        }
    }
};
}

struct Args { const float* in[24]; float* out; unsigned char* ws; };

__device__ __forceinline__ void transpose_item(const float* W, int K, int N, bf16_t* WT, int row_off, LAS float* scr, int item, int lane) {
    const int nblk = N / 32, kb = item / nblk, nb = item % nblk, k0 = 64 * kb, n0 = 32 * nb;
#pragma unroll 8
    for (int i = 0; i < 32; ++i) { const int kk = 2 * i + (lane >> 5); scr[kk * 33 + (lane & 31)] = W[(size_t)(k0 + kk) * N + n0 + (lane & 31)]; }
    asm volatile("s_waitcnt lgkmcnt(0)" ::: "memory");
    const int c = lane & 7;
#pragma unroll
    for (int j = 0; j < 4; ++j) { const int n = (lane >> 3) + 8 * j; const LAS float* s = scr + (8 * c) * 33 + n;
        u32x4 o; o.x = cvt_pk_bf16(s[0 * 33], s[1 * 33]); o.y = cvt_pk_bf16(s[2 * 33], s[3 * 33]); o.z = cvt_pk_bf16(s[4 * 33], s[5 * 33]); o.w = cvt_pk_bf16(s[6 * 33], s[7 * 33]);
        *(u32x4*)(WT + (size_t)(row_off + n0 + n) * K + k0 + 8 * c) = o; }
    asm volatile("s_waitcnt lgkmcnt(0)" ::: "memory");
}

struct RowVecs { f32x4 v[4]; };
__device__ __forceinline__ RowVecs load_vecs(const float* p, int lane) { RowVecs r;
#pragma unroll
    for (int j = 0; j < 2; ++j) { r.v[2 * j] = *(const f32x4*)(p + 512 * j + 8 * lane); r.v[2 * j + 1] = *(const f32x4*)(p + 512 * j + 8 * lane + 4); }
    return r; }
struct RowData { u32x4 m[2]; u32x4 xb[2]; f32x4 xf[4]; };
__device__ __forceinline__ RowData load_row(const bf16_t* mrow, const float* xin, const bf16_t* xin_b, int lane) {
    RowData d;
#pragma unroll
    for (int j = 0; j < 2; ++j) { d.m[j] = mrow ? *(const u32x4*)(mrow + 512 * j + 8 * lane) : (u32x4){0u, 0u, 0u, 0u};
        d.xb[j] = xin_b ? *(const u32x4*)(xin_b + 512 * j + 8 * lane) : (u32x4){0u, 0u, 0u, 0u};
        d.xf[2 * j] = xin_b ? (f32x4){0.f, 0.f, 0.f, 0.f} : *(const f32x4*)(xin + 512 * j + 8 * lane); d.xf[2 * j + 1] = xin_b ? (f32x4){0.f, 0.f, 0.f, 0.f} : *(const f32x4*)(xin + 512 * j + 8 * lane + 4); }
    return d;
}
__device__ __forceinline__ void row_pass(const RowData& d, bool has_m, bool x_is_b, float* xout, bf16_t* xout_b, const RowVecs& gpost, const RowVecs& gate,
                                         bf16_t* hrow  , const RowVecs& gpre, const RowVecs& sc, const RowVecs& sh, int lane) {
    float xv[2][8];
    if (x_is_b) {
#pragma unroll
        for (int j = 0; j < 2; ++j) { const u32x4 w = d.xb[j];
            xv[j][0] = bflo(w.x); xv[j][1] = bfhi(w.x); xv[j][2] = bflo(w.y); xv[j][3] = bfhi(w.y); xv[j][4] = bflo(w.z); xv[j][5] = bfhi(w.z); xv[j][6] = bflo(w.w); xv[j][7] = bfhi(w.w); }
    } else {
#pragma unroll
        for (int j = 0; j < 2; ++j) { const f32x4 a = d.xf[2 * j], b = d.xf[2 * j + 1];
            xv[j][0] = a[0]; xv[j][1] = a[1]; xv[j][2] = a[2]; xv[j][3] = a[3]; xv[j][4] = b[0]; xv[j][5] = b[1]; xv[j][6] = b[2]; xv[j][7] = b[3]; }
    }
    if (has_m) {
        float mv[2][8]; float ss = 0.f;
#pragma unroll
        for (int j = 0; j < 2; ++j) { const u32x4 w = d.m[j];
            mv[j][0] = bflo(w.x); mv[j][1] = bfhi(w.x); mv[j][2] = bflo(w.y); mv[j][3] = bfhi(w.y); mv[j][4] = bflo(w.z); mv[j][5] = bfhi(w.z); mv[j][6] = bflo(w.w); mv[j][7] = bfhi(w.w);
#pragma unroll
            for (int e = 0; e < 8; ++e) ss += mv[j][e] * mv[j][e]; }
        const float rstd = __builtin_amdgcn_rsqf(wave_sum(ss) * (1.f / D) + EPS);
#pragma unroll
        for (int j = 0; j < 2; ++j) { const int c0 = 512 * j + 8 * lane;
            const f32x4 g0 = gpost.v[2 * j], g1 = gpost.v[2 * j + 1], t0 = gate.v[2 * j], t1 = gate.v[2 * j + 1];
#pragma unroll
            for (int e = 0; e < 4; ++e) { xv[j][e] += t0[e] * (mv[j][e] * rstd * g0[e]); xv[j][4 + e] += t1[e] * (mv[j][4 + e] * rstd * g1[e]); }
            if (xout_b) { u32x4 o; o.x = cvt_pk_bf16(xv[j][0], xv[j][1]); o.y = cvt_pk_bf16(xv[j][2], xv[j][3]); o.z = cvt_pk_bf16(xv[j][4], xv[j][5]); o.w = cvt_pk_bf16(xv[j][6], xv[j][7]); *(u32x4*)(xout_b + c0) = o;
            } else { *(f32x4*)(xout + c0) = (f32x4){xv[j][0], xv[j][1], xv[j][2], xv[j][3]}; *(f32x4*)(xout + c0 + 4) = (f32x4){xv[j][4], xv[j][5], xv[j][6], xv[j][7]}; } }
    }
    if (hrow) {
        float ss = 0.f;
#pragma unroll
        for (int j = 0; j < 2; ++j)
#pragma unroll
            for (int e = 0; e < 8; ++e) ss += xv[j][e] * xv[j][e];
        const float rstd = __builtin_amdgcn_rsqf(wave_sum(ss) * (1.f / D) + EPS);
#pragma unroll
        for (int j = 0; j < 2; ++j) { const int c0 = 512 * j + 8 * lane; float hv[8];
            const f32x4 g0 = gpre.v[2 * j], g1 = gpre.v[2 * j + 1], s0 = sc.v[2 * j], s1 = sc.v[2 * j + 1], h0 = sh.v[2 * j], h1 = sh.v[2 * j + 1];
#pragma unroll
            for (int e = 0; e < 4; ++e) { hv[e] = xv[j][e] * rstd * g0[e] * (1.f + s0[e]) + h0[e]; hv[4 + e] = xv[j][4 + e] * rstd * g1[e] * (1.f + s1[e]) + h1[e]; }
            u32x4 o; o.x = cvt_pk_bf16(hv[0], hv[1]); o.y = cvt_pk_bf16(hv[2], hv[3]); o.z = cvt_pk_bf16(hv[4], hv[5]); o.w = cvt_pk_bf16(hv[6], hv[7]);
            *(u32x4*)(hrow + c0) = o; }
    }
}
__device__ __forceinline__ int row_batch(int R) { return R < MP ? (R >> 12) : 16 + ((R - MP) >> 4); }

template <bool FULL>
__device__ __forceinline__ void hgrn_item(LAS unsigned char* lds, const bf16_t* P, bf16_t* AB, int L, int hd, const float* lbv, const float* anorm, const float* S0, const float* Dd, int ns, float* Sout, float* Dout) {
    int tid = threadIdx.x; asm volatile("" : "+v"(tid));
    const int w = tid >> 6, lane = tid & 63, q4 = lane >> 4, c16 = lane & 15;
    const int k = tid & 127, tq = tid >> 7;
    LAS bf16_t* Qt = (LAS bf16_t*)lds;
    LAS bf16_t* Kt = Qt + 16 * 136;
    LAS bf16_t* KhT = Kt + 16 * 136;
    LAS bf16_t* VsT = KhT + 128 * 20;
    LAS float* dvec = (LAS float*)(VsT + 128 * 20);
    LAS float* qsum = dvec + 128;
    LAS float* ssq = qsum + 512;
    const float lb = lbv[k], oml = 1.f - lb;
    const float an = FULL ? anorm[16 * w + c16] : 0.f;
    f32x4 accS[8];
#pragma unroll
    for (int mt = 0; mt < 8; ++mt) accS[mt] = (f32x4){0.f, 0.f, 0.f, 0.f};
    if (Dd) {
#pragma unroll 2
        for (int c = 0; c < ns; ++c) { const float* sc = S0 + (size_t)c * 16384 + tid;
#pragma unroll
            for (int mt = 0; mt < 8; ++mt) { const f32x4 d4 = *(const f32x4*)(Dd + c * 128 + 16 * mt + 4 * q4);
#pragma unroll
                for (int j = 0; j < 4; ++j) accS[mt][j] = accS[mt][j] * d4[j] + sc[(mt * 4 + j) * 512]; } }
    } else {
        for (int c = 0; c < ns; ++c) { const float* sc = S0 + (size_t)c * 16384 + 16 * w + c16;
#pragma unroll
            for (int mt = 0; mt < 8; ++mt)
#pragma unroll
                for (int j = 0; j < 4; ++j) accS[mt][j] = sc[(size_t)(16 * mt + 4 * q4 + j) * 128]; }
    }
    const bf16_t* pq = P + 128 * hd + k + (size_t)(4 * tq) * N1;
    const bf16_t* pz = pq + 512;
    const int vt = (tid >> 4) & 15, vc = tid & 15;
    const bf16_t* pv = P + 1024 + 128 * hd + 8 * vc + (size_t)vt * N1;
    const bf16_t* pg = P + 1536 + 128 * hd + 16 * w + c16 + (size_t)(4 * q4) * N1;
    bf16_t* po = AB + 128 * hd + 16 * w + c16 + (size_t)(4 * q4) * D;
    const int nsteps = L >> 4;
    float btot = 0.f;
    unsigned short zr[4], qr[4], grn[4]; u32x4 vr = (u32x4){0u, 0u, 0u, 0u};
#pragma unroll
    for (int i = 0; i < 4; ++i) { zr[i] = pz[(size_t)i * N1]; qr[i] = pq[(size_t)i * N1]; grn[i] = pg[(size_t)i * N1]; }
    if (tid < 256) vr = *(const u32x4*)pv;
    for (int n = 0; n < nsteps; ++n) {
        unsigned short zc[4], qc[4], gr[4]; const u32x4 vcur = vr;
#pragma unroll
        for (int i = 0; i < 4; ++i) { zc[i] = zr[i]; qc[i] = qr[i]; gr[i] = grn[i]; }
        const size_t roff = (size_t)(16 * n) * N1;
        {
            const size_t nro = (size_t)(16 * (n + 1 < nsteps ? n + 1 : n)) * N1;
#pragma unroll
            for (int i = 0; i < 4; ++i) { zr[i] = pz[nro + (size_t)i * N1]; qr[i] = pq[nro + (size_t)i * N1]; grn[i] = pg[nro + (size_t)i * N1]; }
            if (tid < 256) vr = *(const u32x4*)(pv + nro);
        }
        float cs[4], kk[4], qv[4];
        {
            float run = 0.f;
#pragma unroll
            for (int i = 0; i < 4; ++i) { float z = bf2f(zc[i]); z = fminf(fmaxf(z, -30.f), 30.f); const float e = __expf(-z), sg = __builtin_amdgcn_rcpf(1.f + e), sn = e * sg;
                const float f = lb + oml * sg; run += __builtin_amdgcn_logf(f) * 0.69314718056f; cs[i] = run; kk[i] = oml * sn; qv[i] = bf2f(qc[i]); }
            qsum[tq * 128 + k] = run;
        }
        __syncthreads();
        {
            float pre = 0.f, tot = 0.f;
#pragma unroll
            for (int j = 0; j < 4; ++j) { const float v = qsum[j * 128 + k]; tot += v; pre += (j < tq) ? v : 0.f; }
            btot += tot;
            float kh[4];
#pragma unroll
            for (int i = 0; i < 4; ++i) { const float b = pre + cs[i]; const float qt = qv[i] * __expf(b), kt = kk[i] * __expf(fminf(-b, 80.f)); kh[i] = kk[i] * __expf(tot - b);
                Qt[(4 * tq + i) * 136 + k] = (bf16_t)(cvt_pk_bf16(qt, 0.f) & 0xffffu); Kt[(4 * tq + i) * 136 + k] = (bf16_t)(cvt_pk_bf16(kt, 0.f) & 0xffffu); }
            u32x2 kp; kp.x = cvt_pk_bf16(kh[0], kh[1]); kp.y = cvt_pk_bf16(kh[2], kh[3]);
            *(LAS u32x2*)(KhT + k * 20 + 4 * tq) = kp;
            if (tq == 0) dvec[k] = __expf(tot);
            if (tid < 256) {
                VsT[(8 * vc + 0) * 20 + vt] = (bf16_t)(vcur.x & 0xffffu); VsT[(8 * vc + 1) * 20 + vt] = (bf16_t)(vcur.x >> 16);
                VsT[(8 * vc + 2) * 20 + vt] = (bf16_t)(vcur.y & 0xffffu); VsT[(8 * vc + 3) * 20 + vt] = (bf16_t)(vcur.y >> 16);
                VsT[(8 * vc + 4) * 20 + vt] = (bf16_t)(vcur.z & 0xffffu); VsT[(8 * vc + 5) * 20 + vt] = (bf16_t)(vcur.z >> 16);
                VsT[(8 * vc + 6) * 20 + vt] = (bf16_t)(vcur.w & 0xffffu); VsT[(8 * vc + 7) * 20 + vt] = (bf16_t)(vcur.w >> 16);
            }
        }
        __syncthreads();
        f32x4 acco = (f32x4){0.f, 0.f, 0.f, 0.f};
        {
            const u32x2 vv = *(const LAS u32x2*)(VsT + (16 * w + c16) * 20 + 4 * q4);
            const bf16x4 vf = __builtin_bit_cast(bf16x4, vv);
            if (FULL) {
            bf16x8 qf[4], kf[4];
#pragma unroll
            for (int kq = 0; kq < 4; ++kq) {
                const u32x2 a0 = *(const LAS u32x2*)(Qt + c16 * 136 + 32 * kq + 4 * q4), a1 = *(const LAS u32x2*)(Qt + c16 * 136 + 32 * kq + 16 + 4 * q4);
                const u32x2 b0 = *(const LAS u32x2*)(Kt + c16 * 136 + 32 * kq + 4 * q4), b1 = *(const LAS u32x2*)(Kt + c16 * 136 + 32 * kq + 16 + 4 * q4);
                u32x4 qa = (u32x4){a0.x, a0.y, a1.x, a1.y}, ka = (u32x4){b0.x, b0.y, b1.x, b1.y};
                qf[kq] = __builtin_bit_cast(bf16x8, qa); kf[kq] = __builtin_bit_cast(bf16x8, ka);
            }
            f32x4 accA = (f32x4){0.f, 0.f, 0.f, 0.f};
#pragma unroll
            for (int kq = 0; kq < 4; ++kq) accA = __builtin_amdgcn_mfma_f32_16x16x32_bf16(kf[kq], qf[kq], accA, 0, 0, 0);
#pragma unroll
            for (int j = 0; j < 4; ++j) accA[j] = (c16 >= 4 * q4 + j) ? accA[j] : 0.f;
            u32x2 pa; pa.x = cvt_pk_bf16(accA[0], accA[1]); pa.y = cvt_pk_bf16(accA[2], accA[3]);
            const bf16x4 pA = __builtin_bit_cast(bf16x4, pa);
            acco = __builtin_amdgcn_mfma_f32_16x16x16bf16_1k(pA, vf, (f32x4){0.f, 0.f, 0.f, 0.f}, 0, 0, 0);
#pragma unroll
            for (int kq = 0; kq < 4; ++kq) {
                u32x4 sp; sp.x = cvt_pk_bf16(accS[2 * kq][0], accS[2 * kq][1]); sp.y = cvt_pk_bf16(accS[2 * kq][2], accS[2 * kq][3]);
                sp.z = cvt_pk_bf16(accS[2 * kq + 1][0], accS[2 * kq + 1][1]); sp.w = cvt_pk_bf16(accS[2 * kq + 1][2], accS[2 * kq + 1][3]);
                acco = __builtin_amdgcn_mfma_f32_16x16x32_bf16(qf[kq], __builtin_bit_cast(bf16x8, sp), acco, 0, 0, 0);
            }
            }
#pragma unroll
            for (int mt = 0; mt < 8; ++mt) {
                const u32x2 kh2 = *(const LAS u32x2*)(KhT + (16 * mt + c16) * 20 + 4 * q4);
                const f32x4 d4 = *(const LAS f32x4*)(dvec + 16 * mt + 4 * q4);
                accS[mt] = accS[mt] * d4;
                accS[mt] = __builtin_amdgcn_mfma_f32_16x16x16bf16_1k(__builtin_bit_cast(bf16x4, kh2), vf, accS[mt], 0, 0, 0);
            }
            if (FULL) {
            const float s0 = sum16(acco[0] * acco[0]), s1 = sum16(acco[1] * acco[1]), s2 = sum16(acco[2] * acco[2]), s3 = sum16(acco[3] * acco[3]);
            if (c16 == 0) { *(LAS f32x4*)(ssq + w * 16 + 4 * q4) = (f32x4){s0, s1, s2, s3}; }
            }
        }
        if (FULL) __syncthreads();
        if (FULL) {
            f32x4 tot = (f32x4){0.f, 0.f, 0.f, 0.f};
#pragma unroll
            for (int ww = 0; ww < 8; ++ww) tot += *(const LAS f32x4*)(ssq + ww * 16 + 4 * q4);
#pragma unroll
            for (int j = 0; j < 4; ++j) { const float rstd = __builtin_amdgcn_rsqf(tot[j] * (1.f / 128.f) + EPS); const float o = acco[j] * rstd * an * bf2f(gr[j]);
                po[(size_t)(16 * n + j) * D] = (bf16_t)(cvt_pk_bf16(o, 0.f) & 0xffffu); }
        }
    }
    if (Sout) {
        if (Dout) {
#pragma unroll
            for (int mt = 0; mt < 8; ++mt)
#pragma unroll
                for (int j = 0; j < 4; ++j) Sout[(mt * 4 + j) * 512 + tid] = accS[mt][j];
        } else {
#pragma unroll
            for (int mt = 0; mt < 8; ++mt)
#pragma unroll
                for (int j = 0; j < 4; ++j) Sout[(size_t)(16 * mt + 4 * q4 + j) * 128 + 16 * w + c16] = accS[mt][j];
        }
    }
    if (Dout && tid < 128) Dout[tid] = __expf(btot);
    __syncthreads();
}

__device__ __forceinline__ void unpack8(const u32x4 w, float (&v)[8]) { v[0] = bflo(w.x); v[1] = bfhi(w.x); v[2] = bflo(w.y); v[3] = bfhi(w.y); v[4] = bflo(w.z); v[5] = bfhi(w.z); v[6] = bflo(w.w); v[7] = bfhi(w.w); }
__device__ __forceinline__ u32x4 pack8(const float (&v)[8]) { u32x4 o; o.x = cvt_pk_bf16(v[0], v[1]); o.y = cvt_pk_bf16(v[2], v[3]); o.z = cvt_pk_bf16(v[4], v[5]); o.w = cvt_pk_bf16(v[6], v[7]); return o; }
__device__ __forceinline__ void load8f(const float* p, float (&v)[8]) { const f32x4 a = *(const f32x4*)p, b = *(const f32x4*)(p + 4); v[0] = a[0]; v[1] = a[1]; v[2] = a[2]; v[3] = a[3]; v[4] = b[0]; v[5] = b[1]; v[6] = b[2]; v[7] = b[3]; }
__device__ __forceinline__ void store8f(float* p, const float (&v)[8]) { *(f32x4*)p = (f32x4){v[0], v[1], v[2], v[3]}; *(f32x4*)(p + 4) = (f32x4){v[4], v[5], v[6], v[7]}; }

__device__ __forceinline__ void shortconv_phase(const Args& a, int l, int R0, int MG, const bf16_t* P, bf16_t* AB, unsigned* ctr, volatile LAS unsigned* bcast) {
    const float* cw = a.in[17] + (size_t)l * 3 * BW;
    int tidc = threadIdx.x; asm volatile("" : "+v"(tidc));
    const int nconv = (MG / 8) * 64;
    for (;;) {
        __syncthreads();
        if (tidc == 0) *bcast = __hip_atomic_fetch_add(ctr, 512u, __ATOMIC_RELAXED, __HIP_MEMORY_SCOPE_AGENT);
        __syncthreads();
        const int it = (int)*bcast + tidc;
        if (it - tidc >= nconv) break;
        if (it >= nconv) continue;
        const int rb = it >> 6, ch = (it & 63) * 8, r0 = rb * 8, R = R0 + r0;
        int t0, Lq; const float* st_in = nullptr; float* st_out;
        if (R < MP) { t0 = R & (SEQ - 1); Lq = SEQ; st_out = a.out + O_SCP + (size_t)((l * 16 + (R >> 12)) * 2) * BW; }
        else { const int Rs = R - MP; t0 = Rs & 15; Lq = DSEQ; const int sq = Rs >> 4; st_in = a.in[3] + (size_t)((l * 16 + sq) * 2) * BW; st_out = a.out + O_SCS + (size_t)((l * 16 + sq) * 2) * BW; }
        float w0[8], w1[8], w2[8], p2[8], p1[8];
        load8f(cw + ch, w0); load8f(cw + BW + ch, w1); load8f(cw + 2 * BW + ch, w2);
        if (t0 == 0) {
            if (st_in) { load8f(st_in + ch, p2); load8f(st_in + BW + ch, p1); }
            else {
#pragma unroll
                for (int e = 0; e < 8; ++e) { p2[e] = 0.f; p1[e] = 0.f; } }
        } else {
            float c8[8], v8[8];
            unpack8(*(const u32x4*)(P + (size_t)(r0 - 2) * N1 + 2560 + ch), c8); unpack8(*(const u32x4*)(P + (size_t)(r0 - 2) * N1 + 3072 + ch), v8);
#pragma unroll
            for (int e = 0; e < 8; ++e) p2[e] = c8[e] * v8[e];
            unpack8(*(const u32x4*)(P + (size_t)(r0 - 1) * N1 + 2560 + ch), c8); unpack8(*(const u32x4*)(P + (size_t)(r0 - 1) * N1 + 3072 + ch), v8);
#pragma unroll
            for (int e = 0; e < 8; ++e) p1[e] = c8[e] * v8[e];
        }
#pragma unroll 2
        for (int i = 0; i < 8; ++i) {
            const bf16_t* pr = P + (size_t)(r0 + i) * N1;
            float b8[8], c8[8], v8[8], o8[8];
            unpack8(*(const u32x4*)(pr + 2048 + ch), b8); unpack8(*(const u32x4*)(pr + 2560 + ch), c8); unpack8(*(const u32x4*)(pr + 3072 + ch), v8);
#pragma unroll
            for (int e = 0; e < 8; ++e) { const float cv = c8[e] * v8[e]; o8[e] = b8[e] * (w0[e] * p2[e] + w1[e] * p1[e] + w2[e] * cv); p2[e] = p1[e]; p1[e] = cv; }
            *(u32x4*)(AB + (size_t)(r0 + i) * D + 512 + ch) = pack8(o8);
        }
        if (t0 + 8 == Lq) { store8f(st_out + ch, p2); store8f(st_out + BW + ch, p1); }
    }
}
#define XB_TMO      128
#define XB_XCNT(j)  (256  + 64 * (j))
#define XB_XSUB(j)  (1280 + 64 * (j))
#define XB_XGEN(j)  (2304 + 64 * (j))
#define XB_TOP      3328
#define XB_TOPGEN   3392
#define XCD_BAR_WORDS 3456
#define XB_SPIN_CAP (1u << 22)
__device__ __forceinline__ unsigned xb_ld(unsigned* p)              { return __hip_atomic_load(p, __ATOMIC_RELAXED, __HIP_MEMORY_SCOPE_AGENT); }
__device__ __forceinline__ unsigned xb_add(unsigned* p, unsigned v) { return __hip_atomic_fetch_add(p, v, __ATOMIC_RELAXED, __HIP_MEMORY_SCOPE_AGENT); }
__device__ __forceinline__ unsigned xb_xcc_id() { return (unsigned)__builtin_amdgcn_s_getreg((3 << 11) | 20) & 0xFu; }
#define XB_SPIN(cond, bar) do { unsigned _sp = 0; while (cond) { __builtin_amdgcn_s_sleep(1); \
    if ((++_sp & 255u) == 0u) { if (xb_ld(&(bar)[XB_TMO])) break; if (_sp > XB_SPIN_CAP) { atomicAdd(&(bar)[XB_TMO], 1u); break; } } } } while (0)
struct XcdBarrier { unsigned* bar; unsigned x; volatile LAS unsigned* st; };
__device__ __forceinline__ XcdBarrier xcd_barrier_post(unsigned* bar, volatile LAS unsigned* st) {
    XcdBarrier b; b.bar = bar; b.x = xb_xcc_id(); b.st = st;
    if (threadIdx.x == 0) (void)xb_add(&bar[XB_XCNT(b.x)], 1u);
    return b;
}
__device__ __forceinline__ void xcd_barrier_complete(unsigned* bar, unsigned x, unsigned& nloc, unsigned& nx) {
    const unsigned G = gridDim.x * gridDim.y * gridDim.z;
    unsigned sum, cnt, mine, sp = 0u;
    for (;;) {
        sum = 0u; cnt = 0u; mine = 0u;
#pragma unroll
        for (unsigned j = 0; j < 16; ++j) { const unsigned c = xb_ld(&bar[XB_XCNT(j)]); sum += c; cnt += (c > 0u) ? 1u : 0u; mine = (j == x) ? c : mine; }
        if (sum == G) break;
        __builtin_amdgcn_s_sleep(1);
        if ((++sp & 255u) == 0u) { if (xb_ld(&bar[XB_TMO])) break; if (sp > XB_SPIN_CAP) { atomicAdd(&bar[XB_TMO], 1u); break; } }
    }
    nloc = mine > 0u ? mine : 1u; nx = cnt > 0u ? cnt : 1u;
}
__device__ __forceinline__ void xcd_barrier(const XcdBarrier& b) {
    asm volatile("s_waitcnt vmcnt(0) lgkmcnt(0)" ::: "memory");
    __syncthreads();
    if (threadIdx.x == 0) {
        unsigned* bar = b.bar;
        __builtin_amdgcn_s_waitcnt(0);
        unsigned nloc = b.st[0], nx = b.st[1];
        if (nloc == 0u) { xcd_barrier_complete(bar, b.x, nloc, nx); b.st[0] = nloc; b.st[1] = nx; }
        const unsigned old = xb_add(&bar[XB_XSUB(b.x)], 1u);
        const unsigned gen = old / nloc;
        if (old + 1u == (gen + 1u) * nloc) {
            __builtin_amdgcn_fence(__ATOMIC_RELEASE, "agent");
            asm volatile("s_waitcnt vmcnt(0)" ::: "memory");
            const unsigned og = xb_add(&bar[XB_TOP], 1u);
            const unsigned tg = og / nx;
            if (og + 1u == (tg + 1u) * nx) xb_add(&bar[XB_TOPGEN], 1u);
            else XB_SPIN(xb_ld(&bar[XB_TOPGEN]) == tg, bar);
            __builtin_amdgcn_fence(__ATOMIC_ACQUIRE, "agent");
            xb_add(&bar[XB_XGEN(b.x)], 1u);
            asm volatile("s_waitcnt vmcnt(0)" ::: "memory");
        } else {
            XB_SPIN(xb_ld(&bar[XB_XGEN(b.x)]) == gen, bar);
            __builtin_amdgcn_fence(__ATOMIC_ACQUIRE, "agent");
            asm volatile("s_waitcnt vmcnt(0)" ::: "memory");
        }
    }
    __syncthreads();
}

#define GSYNC_CG() do { asm volatile("s_waitcnt vmcnt(0) lgkmcnt(0)" ::: "memory"); grid.sync(); } while (0)
#define GSYNC() xcd_barrier(xbar)
__global__ void __launch_bounds__(512, 2) fwd_megakernel(Args a) {
    extern __shared__ __attribute__((aligned(16))) unsigned char lds_raw[];
    LAS unsigned char* lds = (LAS unsigned char*)lds_raw;
    cg::grid_group grid = cg::this_grid();
    const int tid = threadIdx.x, lane = tid & 63, wave = __builtin_amdgcn_readfirstlane(tid >> 6);
    const int G = gridDim.x, wg = blockIdx.x;
    unsigned char* ws = a.ws;
    volatile LAS unsigned* MISC = (volatile LAS unsigned*)(lds + 131072 + 320);
    if (tid < 32) MISC[tid] = 0u;
    __syncthreads();
    const XcdBarrier xbar = xcd_barrier_post((unsigned*)ws + 4096, MISC + 8);
    float* ADA = (float*)(ws + WS_ADA);
    float* LB = (float*)(ws + WS_LB);
    bf16_t* Hb = (bf16_t*)(ws + WS_H);
    bf16_t* ABb = (bf16_t*)(ws + WS_AB);
    bf16_t* Pb = (bf16_t*)(ws + WS_P);
    bf16_t* ACTb = (bf16_t*)(ws + WS_ACT);
    bf16_t* XBb = (bf16_t*)(ws + WS_XB);

    if (wg < 192) {
        LAS float* csT = (LAS float*)lds;
        for (int i = tid; i < 32 * 1024; i += 512) { const int b = i >> 10, kx = i & 1023; const float c = (b < 16) ? a.in[5][(size_t)b * D + kx] : a.in[6][(size_t)(b - 16) * D + kx]; csT[kx * 32 + b] = c * fsigmoid(c); }
        __syncthreads();
        const int cc = tid & 127, kq = tid >> 7;
        const int col = wg * 128 + cc;
        const int l = col / 6144, n = col - l * 6144;
        const float* wp = a.in[7] + (size_t)l * D * 6144 + n;
        float acc[32];
#pragma unroll
        for (int b = 0; b < 32; ++b) acc[b] = 0.f;
#pragma unroll 4
        for (int kx = 256 * kq; kx < 256 * kq + 256; ++kx) { const float wv = wp[(size_t)kx * 6144];
#pragma unroll
            for (int b4 = 0; b4 < 8; ++b4) { const f32x4 c4 = *(const LAS f32x4*)(csT + kx * 32 + 4 * b4); acc[4 * b4] += c4[0] * wv; acc[4 * b4 + 1] += c4[1] * wv; acc[4 * b4 + 2] += c4[2] * wv; acc[4 * b4 + 3] += c4[3] * wv; } }
        __syncthreads();
        LAS float* red = (LAS float*)lds;
#pragma unroll
        for (int b = 0; b < 32; ++b) red[(kq * 32 + b) * 128 + cc] = acc[b];
        __syncthreads();
#pragma unroll
        for (int i = 0; i < 8; ++i) { const int o = tid + 512 * i, b = o >> 7, c2 = o & 127; const int col2 = wg * 128 + c2, n2 = col2 - l * 6144;
            const float v = red[(0 * 32 + b) * 128 + c2] + red[(1 * 32 + b) * 128 + c2] + red[(2 * 32 + b) * 128 + c2] + red[(3 * 32 + b) * 128 + c2];
            ADA[((size_t)l * 32 + b) * 6144 + n2] = v + a.in[8][(size_t)l * 6144 + n2]; }
        __syncthreads();
    }
    if (wg == 192) {
        const float x0 = a.in[14][tid], x1 = a.in[14][512 + tid], x2 = a.in[14][1024 + tid], x3 = a.in[14][1536 + tid];
        const float mx = fmaxf(fmaxf(x0, x1), fmaxf(x2, x3));
        const float e0 = __expf(x0 - mx), e1 = __expf(x1 - mx), e2 = __expf(x2 - mx), e3 = __expf(x3 - mx), inv = 1.f / (e0 + e1 + e2 + e3);
        LB[tid] = 0.f; LB[512 + tid] = e1 * inv; LB[1024 + tid] = (e1 + e2) * inv; LB[1536 + tid] = (e1 + e2 + e3) * inv;
    }
    {
        LAS float* scr = (LAS float*)(lds + wave * 16384);
        const int gw = wg * 8 + wave, NGW = G * 8;
        constexpr int I_IN = 16 * (NIN / 32), I_BG = 16 * (2048 / 32), I_PA = 8 * 32, I_PB = 8 * 32, I_O = 16 * 32, I_UP = 16 * (NUP / 32), I_DN = (DFF / 64) * 32;
        constexpr int I_LAYER = I_IN + I_BG + I_PA + I_PB + I_O + I_UP + I_DN;
        for (int it = gw; it < 4 * I_LAYER; it += NGW) {
            const int l = it / I_LAYER; int r = it - l * I_LAYER;
            bf16_t* wl = (bf16_t*)(ws + WS_W + (size_t)l * LAYER_W);
            if (r < I_IN) { transpose_item(a.in[13] + (size_t)l * D * NIN, D, NIN, wl + W1_OFF / 2, 0, scr, r, lane); continue; } r -= I_IN;
            if (r < I_BG) { transpose_item(a.in[19] + (size_t)l * D * 2048, D, 2048, wl + W1_OFF / 2, NIN, scr, r, lane); continue; } r -= I_BG;
            if (r < I_PA) { transpose_item(a.in[16] + (size_t)l * AW * D, AW, D, wl + WPA_OFF / 2, 0, scr, r, lane); continue; } r -= I_PA;
            if (r < I_PB) { transpose_item(a.in[18] + (size_t)l * BW * D, BW, D, wl + WPB_OFF / 2, 0, scr, r, lane); continue; } r -= I_PB;
            if (r < I_O) { transpose_item(a.in[20] + (size_t)l * D * D, D, D, wl + WO_OFF / 2, 0, scr, r, lane); continue; } r -= I_O;
            if (r < I_UP) { const int n0 = 32 * (r % (NUP / 32));
                const int jj = n0 < DFF ? n0 : n0 - DFF, rowb = 256 * (jj >> 7) + (n0 < DFF ? 0 : 128) + (jj & 127);
                transpose_item(a.in[21] + (size_t)l * D * NUP, D, NUP, wl + WUP_OFF / 2, rowb - n0, scr, r, lane); continue; } r -= I_UP;
            transpose_item(a.in[23] + (size_t)l * DFF * D, DFF, D, wl + WDN_OFF / 2, 0, scr, r, lane);
        }
    }
    GSYNC_CG();

    for (int grp = 0; grp < 2; ++grp) {
        const int R0 = grp ? MG0 : 0, MG = grp ? MG1 : MG0, nM = MG / 256;
        int tid = threadIdx.x; asm volatile("" : "+v"(tid));
        const int lane = tid & 63, wave = __builtin_amdgcn_readfirstlane(tid >> 6);
        const int rper = (MG + G * 8 - 1) / (G * 8);
        {
            const int r0 = (wg * 8 + wave) * rper, r1 = (r0 + rper < MG) ? r0 + rper : MG;
            const RowVecs gpr = load_vecs(a.in[9], lane); RowVecs vsc = gpr, vsh = gpr; int curb = -1;
#define XIN_ROW(R_) (((R_) < MP) ? a.in[0] + (size_t)(R_) * D : a.in[1] + (size_t)((R_) - MP) * D)
            RowData cur = load_row(nullptr, XIN_ROW(R0 + (r0 < r1 ? r0 : 0)), nullptr, lane);
            for (int r = r0; r < r1; ++r) {
                const int R = R0 + r, bb = row_batch(R), rn = (r + 1 < r1) ? r + 1 : r;
                const RowData nxt = load_row(nullptr, XIN_ROW(R0 + rn), nullptr, lane);
                if (bb != curb) { curb = bb; const float* ad = ADA + (size_t)bb * 6144; vsc = load_vecs(ad + 1024, lane); vsh = load_vecs(ad, lane); }
                row_pass(cur, false, false, nullptr, nullptr, gpr, gpr, Hb + (size_t)r * D, gpr, vsc, vsh, lane);
                cur = nxt;
            }
        }
        GSYNC();
        for (int l = 0; l < DEPTH; ++l) {
            int tid = threadIdx.x; asm volatile("" : "+v"(tid));
            const int lane = tid & 63, wave = __builtin_amdgcn_readfirstlane(tid >> 6);
            const bf16_t* wl = (const bf16_t*)(ws + WS_W + (size_t)l * LAYER_W);
            { pg8::Gemm g{Hb, wl + W1_OFF / 2, D, D, D}; pg8::StaticOrder S; S.init(nM, N1 / 256, G, wg); pg8::EpiStore E{Pb, N1, 1}; pg8::gemm_phase(lds, g, S, E); }
            GSYNC();
            {
                int tidb = threadIdx.x; asm volatile("" : "+v"(tidb));
                const int chain = wg >> 3, chunk = wg & 7, sqg = chain >> 2, hd = chain & 3;
                const int lrow = sqg * SEQ + chunk * 512;
                float* DS = (float*)(ws + WS_DS) + (size_t)(chain * 8) * 16384;
                float* DD = (float*)(ws + WS_DD) + (size_t)(chain * 8) * 128;
                float* SS = (float*)(ws + WS_SS) + (size_t)wg * 16384;
                const float* lbv = LB + l * 512 + hd * 128;
                const float* anv = a.in[15] + l * 128;
                if (wg < 256 && chunk < 7)
                    hgrn_item<false>(lds, Pb + (size_t)lrow * N1, ABb + (size_t)lrow * D, 512, hd, lbv, anv, nullptr, nullptr, 0, DS + (size_t)chunk * 16384, DD + chunk * 128);
                shortconv_phase(a, l, R0, MG, Pb, ABb, (unsigned*)ws + 1024 + 64 * (grp * 4 + l), MISC + 16);
                GSYNC();
                if (wg < 256)
                    hgrn_item<true>(lds, Pb + (size_t)lrow * N1, ABb + (size_t)lrow * D, 512, hd, lbv, anv, DS, DD, chunk,
                              chunk == 7 ? a.out + O_SHP + (size_t)((l * 16 + 8 * grp + sqg) * 4 + hd) * 16384 : nullptr, nullptr);
                if (grp == 1 && wg < 64) {
                    const int sq = wg >> 2, hs = wg & 3; const int srow = MG0 + sq * DSEQ;
                    hgrn_item<true>(lds, Pb + (size_t)srow * N1, ABb + (size_t)srow * D, DSEQ, hs, LB + l * 512 + hs * 128, anv,
                              a.in[2] + (size_t)((l * 16 + sq) * 4 + hs) * 16384, nullptr, 1, a.out + O_SHS + (size_t)((l * 16 + sq) * 4 + hs) * 16384, nullptr);
                }
            }
            GSYNC();
            { pg8::Gemm g{ABb, wl + WPA_OFF / 2, D, AW, AW}; pg8::StaticOrder S; S.init(nM, D / 256, G, wg); pg8::EpiGate E{Hb, Pb + NIN, 0}; pg8::gemm_phase(lds, g, S, E); }
            { pg8::Gemm g{ABb + AW, wl + WPB_OFF / 2, D, BW, BW}; pg8::StaticOrder S; S.init(nM, D / 256, G, wg); pg8::EpiGate E{Hb, Pb + NIN + D, 1}; pg8::gemm_phase(lds, g, S, E); }
            GSYNC();
            { pg8::Gemm g{Hb, wl + WO_OFF / 2, D, D, D}; pg8::StaticOrder S; S.init(nM, D / 256, G, wg); pg8::EpiStore E{ABb, D, 0}; pg8::gemm_phase(lds, g, S, E); }
            GSYNC();
            {
                const int r0 = (wg * 8 + wave) * rper, r1 = (r0 + rper < MG) ? r0 + rper : MG;
                const RowVecs gpo = load_vecs(a.in[10] + l * D, lane), gpr = load_vecs(a.in[11] + l * D, lane); RowVecs vg = gpo, vsc = gpo, vsh = gpo; int curb = -1;
                const int rs = (r0 < r1) ? r0 : 0;
                RowData cur = load_row(ABb + (size_t)rs * D, XIN_ROW(R0 + rs), (l == 0) ? nullptr : XBb + (size_t)rs * D, lane);
                for (int r = r0; r < r1; ++r) {
                    const int R = R0 + r, bb = row_batch(R), rn = (r + 1 < r1) ? r + 1 : r;
                    const RowData nxt = load_row(ABb + (size_t)rn * D, XIN_ROW(R0 + rn), (l == 0) ? nullptr : XBb + (size_t)rn * D, lane);
                    if (bb != curb) { curb = bb; const float* ad = ADA + ((size_t)l * 32 + bb) * 6144; vg = load_vecs(ad + 2048, lane); vsc = load_vecs(ad + 4096, lane); vsh = load_vecs(ad + 3072, lane); }
                    row_pass(cur, true, l != 0, nullptr, XBb + (size_t)r * D, gpo, vg, Hb + (size_t)r * D, gpr, vsc, vsh, lane);
                    cur = nxt;
                }
            }
            GSYNC();
            { pg8::Gemm g{Hb, wl + WUP_OFF / 2, D, D, D, 254, -2}; pg8::StaticOrder S; S.init((MG + 253) / 254, NUP / 256, G, wg);
              pg8::EpiFfn E{ACTb, a.in[22] + (size_t)l * 3 * DFF, a.in[4], a.out + O_SFP, a.out + O_SFS, R0, MG, l, (LAS float*)(lds + 131072 + 1024)};
              pg8::gemm_phase(lds, g, S, E); }
            GSYNC();
            { pg8::Gemm g{ACTb, wl + WDN_OFF / 2, DFF, DFF, DFF}; pg8::StaticOrder S; S.init(nM, D / 256, G, wg); pg8::EpiStore E{ABb, D, 0}; pg8::gemm_phase(lds, g, S, E); }
            GSYNC();
            {
                const int r0 = (wg * 8 + wave) * rper, r1 = (r0 + rper < MG) ? r0 + rper : MG; const int ln = (l + 1 < DEPTH) ? l + 1 : l;
                const RowVecs gpo = load_vecs(a.in[12] + l * D, lane), gpr = load_vecs(a.in[9] + ln * D, lane); RowVecs vg = gpo, vsc = gpo, vsh = gpo; int curb = -1;
                const int rs = (r0 < r1) ? r0 : 0;
                RowData cur = load_row(ABb + (size_t)rs * D, nullptr, XBb + (size_t)rs * D, lane);
                for (int r = r0; r < r1; ++r) {
                    const int R = R0 + r, bb = row_batch(R), rn = (r + 1 < r1) ? r + 1 : r;
                    const RowData nxt = load_row(ABb + (size_t)rn * D, nullptr, XBb + (size_t)rn * D, lane);
                    if (bb != curb) { curb = bb; const float* ad = ADA + ((size_t)l * 32 + bb) * 6144; const float* adn = ADA + ((size_t)ln * 32 + bb) * 6144;
                        vg = load_vecs(ad + 5120, lane); vsc = load_vecs(adn + 1024, lane); vsh = load_vecs(adn, lane); }
                    row_pass(cur, true, true, a.out + (size_t)R * D, (l + 1 < DEPTH) ? XBb + (size_t)r * D : nullptr, gpo, vg, (l + 1 < DEPTH) ? Hb + (size_t)r * D : nullptr, gpr, vsc, vsh, lane);
                    cur = nxt;
                }
            }
            if (l + 1 < DEPTH) GSYNC();
        }
    }
}

extern "C" void kernel_launch(void* const* d_in, const int* in_sizes, int n_in, void* d_out, int out_size, void* d_ws, size_t ws_size, hipStream_t stream) {
    static int grid = 0;
    if (grid == 0) {
        if (n_in != 24 || ws_size < WS_END) { fprintf(stderr, "kernel_launch: unexpected n_in %d / ws_size %zu (need %zu)\n", n_in, ws_size, (size_t)WS_END); grid = -1; return; }
        int dev = 0, cus = 0, per_cu = 0;
        hipGetDevice(&dev);
        hipDeviceGetAttribute(&cus, hipDeviceAttributeMultiprocessorCount, dev);
        if (hipFuncSetAttribute((const void*)fwd_megakernel, hipFuncAttributeMaxDynamicSharedMemorySize, LDS_BYTES) != hipSuccess) { fprintf(stderr, "kernel_launch: hipFuncSetAttribute failed\n"); }
        if (hipOccupancyMaxActiveBlocksPerMultiprocessor(&per_cu, (const void*)fwd_megakernel, 512, LDS_BYTES) != hipSuccess || per_cu < 1) { fprintf(stderr, "kernel_launch: occupancy query says %d\n", per_cu); per_cu = 1; }
        (void)hipGetLastError();
        grid = cus;
    }
    if (grid < 0) return;
    if (hipMemsetAsync(d_ws, 0, 65536, stream) != hipSuccess) { fprintf(stderr, "kernel_launch: hipMemsetAsync failed\n"); return; }
    Args a{};
    for (int i = 0; i < 24; ++i) a.in[i] = (const float*)d_in[i];
    a.out = (float*)d_out; a.ws = (unsigned char*)d_ws;
    void* args[] = {&a};
    hipError_t e = hipLaunchCooperativeKernel((const void*)fwd_megakernel, dim3(grid), dim3(512), args, LDS_BYTES, stream);
    if (e != hipSuccess) fprintf(stderr, "kernel_launch: cooperative launch failed: %s (grid %d)\n", hipGetErrorString(e), grid);
}
```
